# Optimizing an MI355X kernel written in HIP

```python
import jax, jax.numpy as jnp
from jax import lax
import numpy as np

D_MODEL = 1024
BATCH = 32
SEQ = 2048
DEPTH = 1

N_META = 16
GRID_W = 64
HEAD_DIM = 128
N_Q_HEADS = 8
N_KV_HEADS = 2
Q_GROUP = N_Q_HEADS // N_KV_HEADS
Q_WIDTH = N_Q_HEADS * HEAD_DIM
KV_WIDTH = N_KV_HEADS * HEAD_DIM
RNN_WIDTH = D_MODEL
RNN_BLOCKS = 8
RNN_BLOCK = RNN_WIDTH // RNN_BLOCKS
CONV_W = 4
CONV_PAD_L = CONV_W // 2
CONV_PAD_R = CONV_W - 1 - CONV_PAD_L
RG_C = 8.0
ROPE_THETA = 10000.0
ROPE_AXIS_DIM = HEAD_DIM // 2
ROPE_PAIRS = ROPE_AXIS_DIM // 2
Q_BLOCK = 128
D_FF = ((8 * D_MODEL + 3 * 256 - 1) // (3 * 256)) * 256
IN_WIDTH = Q_WIDTH + 2 * KV_WIDTH + 2 * RNN_WIDTH + 2 * D_MODEL
EPS = 1e-6

kernel_name = 'hybrid_rglru_axial_gqa_encoder_block'


def rmsnorm(x, g):
    xf = x.astype(jnp.float32)
    y = xf * lax.rsqrt(jnp.mean(xf * xf, axis=-1, keepdims=True) + EPS)
    return (y * g.astype(jnp.float32)).astype(x.dtype)


def axial_rope_tables(n_tok):
    rows = n_tok // GRID_W
    row = jnp.repeat(jnp.arange(rows, dtype=jnp.float32), GRID_W)
    col = jnp.tile(jnp.arange(GRID_W, dtype=jnp.float32), rows)
    zeros = jnp.zeros((N_META,), jnp.float32)
    row = jnp.concatenate([zeros, row])
    col = jnp.concatenate([zeros, col])
    inv_freq = jnp.exp(-jnp.log(jnp.float32(ROPE_THETA)) * jnp.arange(ROPE_PAIRS, dtype=jnp.float32) / ROPE_PAIRS)
    ang_r = row[:, None] * inv_freq[None, :]
    ang_c = col[:, None] * inv_freq[None, :]
    return jnp.cos(ang_r), jnp.sin(ang_r), jnp.cos(ang_c), jnp.sin(ang_c)


def rotate_half_axis(xh, cos, sin):
    c = cos[None, :, None, :]
    s = sin[None, :, None, :]
    x1, x2 = xh[..., :ROPE_PAIRS], xh[..., ROPE_PAIRS:]
    return jnp.concatenate([x1 * c - x2 * s, x2 * c + x1 * s], axis=-1)


def apply_axial_rope(x, tabs):
    cos_r, sin_r, cos_c, sin_c = tabs
    xf = x.astype(jnp.float32)
    xr = rotate_half_axis(xf[..., :ROPE_AXIS_DIM], cos_r, sin_r)
    xc = rotate_half_axis(xf[..., ROPE_AXIS_DIM:], cos_c, sin_c)
    return jnp.concatenate([xr, xc], axis=-1).astype(x.dtype)


def bidirectional_gqa(q, k, v):
    B, T = q.shape[0], q.shape[1]
    q = q.reshape(B, T, N_KV_HEADS, Q_GROUP, HEAD_DIM)
    scale = HEAD_DIM ** -0.5

    def block(qb):
        s = jnp.einsum('bqhgd,bkhd->bhgqk', qb, k, preferred_element_type=jnp.float32) * scale
        p = jax.nn.softmax(s, axis=-1)
        return jnp.einsum('bhgqk,bkhd->bqhgd', p.astype(v.dtype), v)

    q_meta, q_real = q[:, :N_META], q[:, N_META:]
    n_blk = q_real.shape[1] // Q_BLOCK
    qr = q_real.reshape(B, n_blk, Q_BLOCK, N_KV_HEADS, Q_GROUP, HEAD_DIM).transpose(1, 0, 2, 3, 4, 5)
    o_real = lax.map(block, qr)
    o_real = o_real.transpose(1, 0, 2, 3, 4, 5).reshape(B, n_blk * Q_BLOCK, Q_WIDTH)
    o_meta = block(q_meta).reshape(B, N_META, Q_WIDTH)
    return jnp.concatenate([o_meta, o_real], axis=1)


def centred_dwconv(x, w, b):
    T = x.shape[1]
    xp = jnp.pad(x, ((0, 0), (CONV_PAD_L, CONV_PAD_R), (0, 0)))
    y = b
    for j in range(CONV_W):
        y = y + xp[:, j:j + T] * w[j]
    return y


def _linear_recurrence_combine(e1, e2):
    a1, b1 = e1
    a2, b2 = e2
    return a1 * a2, a2 * b1 + b2


def rg_lru(xc, wa, ba, wx, bx, lam, reverse):
    B, T, C = xc.shape
    xf = xc.astype(jnp.float32)
    xb = xf.reshape(B, T, RNN_BLOCKS, RNN_BLOCK)
    r = jax.nn.sigmoid(jnp.einsum('btnc,ncd->btnd', xb, wa.astype(jnp.float32)).reshape(B, T, C) + ba.astype(jnp.float32))
    i = jax.nn.sigmoid(jnp.einsum('btnc,ncd->btnd', xb, wx.astype(jnp.float32)).reshape(B, T, C) + bx.astype(jnp.float32))
    log_a = RG_C * r * jax.nn.log_sigmoid(lam.astype(jnp.float32))
    a = jnp.exp(log_a)
    u = jnp.sqrt(-jnp.expm1(2.0 * log_a)) * (i * xf)
    _, h = lax.associative_scan(_linear_recurrence_combine, (a, u), axis=1, reverse=reverse)
    return h


def setup_inputs(seed: int = 0) -> dict:
    key = jax.random.key(seed)
    ks = jax.random.split(key, 20)
    f32 = jnp.float32

    def nrm(k, shape, fan_in):
        return jax.random.normal(k, shape, f32) * (fan_in ** -0.5)

    x = jax.random.normal(ks[0], (BATCH, SEQ, D_MODEL), f32)
    meta_tokens = jax.random.normal(ks[1], (N_META, D_MODEL), f32)
    norm1_g = 1.0 + 0.05 * jax.random.normal(ks[2], (DEPTH, D_MODEL), f32)
    w_in = nrm(ks[3], (DEPTH, D_MODEL, IN_WIDTH), D_MODEL)
    conv_w = nrm(ks[4], (DEPTH, CONV_W, RNN_WIDTH), CONV_W)
    conv_b = 0.02 * jax.random.normal(ks[5], (DEPTH, RNN_WIDTH), f32)
    rg_wa = nrm(ks[6], (DEPTH, 2, RNN_BLOCKS, RNN_BLOCK, RNN_BLOCK), RNN_BLOCK)
    rg_ba = 0.02 * jax.random.normal(ks[7], (DEPTH, 2, RNN_WIDTH), f32)
    rg_wx = nrm(ks[8], (DEPTH, 2, RNN_BLOCKS, RNN_BLOCK, RNN_BLOCK), RNN_BLOCK)
    rg_bx = 0.02 * jax.random.normal(ks[9], (DEPTH, 2, RNN_WIDTH), f32)
    a_c = jax.random.uniform(ks[10], (DEPTH, 2, RNN_WIDTH), f32, 0.9, 0.999)
    s = a_c ** (1.0 / RG_C)
    rg_lambda = jnp.log(s) - jnp.log1p(-s)
    q_norm_g = 1.0 + 0.05 * jax.random.normal(ks[11], (DEPTH, HEAD_DIM), f32)
    k_norm_g = 1.0 + 0.05 * jax.random.normal(ks[12], (DEPTH, HEAD_DIM), f32)
    w_out = nrm(ks[13], (DEPTH, D_MODEL, D_MODEL), D_MODEL)
    norm2_g = 1.0 + 0.05 * jax.random.normal(ks[14], (DEPTH, D_MODEL), f32)
    w_ffn_in = nrm(ks[15], (DEPTH, D_MODEL, 2 * D_FF), D_MODEL)
    w_ffn_out = nrm(ks[16], (DEPTH, D_FF, D_MODEL), D_FF)
    return {'x': x, 'meta_tokens': meta_tokens, 'norm1_g': norm1_g, 'w_in': w_in,
            'conv_w': conv_w, 'conv_b': conv_b, 'rg_wa': rg_wa, 'rg_ba': rg_ba,
            'rg_wx': rg_wx, 'rg_bx': rg_bx, 'rg_lambda': rg_lambda,
            'q_norm_g': q_norm_g, 'k_norm_g': k_norm_g, 'w_out': w_out,
            'norm2_g': norm2_g, 'w_ffn_in': w_ffn_in, 'w_ffn_out': w_ffn_out}


def reference(x, meta_tokens, norm1_g, w_in, conv_w, conv_b, rg_wa, rg_ba, rg_wx, rg_bx,
              rg_lambda, q_norm_g, k_norm_g, w_out, norm2_g, w_ffn_in, w_ffn_out):
    B, S, D = x.shape
    meta = jnp.broadcast_to(meta_tokens.astype(x.dtype)[None], (B, N_META, D))
    h = jnp.concatenate([meta, x], axis=1)
    T = h.shape[1]
    tabs = axial_rope_tables(S)
    splits = [Q_WIDTH, Q_WIDTH + KV_WIDTH, Q_WIDTH + 2 * KV_WIDTH,
              Q_WIDTH + 2 * KV_WIDTH + RNN_WIDTH, Q_WIDTH + 2 * KV_WIDTH + 2 * RNN_WIDTH]

    for l in range(DEPTH):
        xn = rmsnorm(h, norm1_g[l])
        proj = xn @ w_in[l]
        q, k, v, xr, gr, g_merge = jnp.split(proj, splits, axis=-1)

        q = q.reshape(B, T, N_Q_HEADS, HEAD_DIM)
        k = k.reshape(B, T, N_KV_HEADS, HEAD_DIM)
        v = v.reshape(B, T, N_KV_HEADS, HEAD_DIM)
        q = apply_axial_rope(rmsnorm(q, q_norm_g[l]), tabs)
        k = apply_axial_rope(rmsnorm(k, k_norm_g[l]), tabs)
        attn = bidirectional_gqa(q, k, v)

        xc = centred_dwconv(xr, conv_w[l], conv_b[l])
        rnn = (rg_lru(xc, rg_wa[l, 0], rg_ba[l, 0], rg_wx[l, 0], rg_bx[l, 0], rg_lambda[l, 0], False)
               + rg_lru(xc, rg_wa[l, 1], rg_ba[l, 1], rg_wx[l, 1], rg_bx[l, 1], rg_lambda[l, 1], True))
        rnn = rnn.astype(x.dtype) * jax.nn.gelu(gr)

        gates = jax.nn.sigmoid(g_merge)
        g_attn, g_rnn = gates[..., :D_MODEL], gates[..., D_MODEL:]
        mix = g_attn * attn + g_rnn * rnn
        h = h + mix @ w_out[l]

        hn = rmsnorm(h, norm2_g[l])
        gu = hn @ w_ffn_in[l]
        g, u = gu[..., :D_FF], gu[..., D_FF:]
        h = h + (jax.nn.silu(g) * u) @ w_ffn_out[l]

    return h[:, N_META:]
```

```cpp
#define MK_N_LAUNCHES 1
#include <hip/hip_runtime.h>
#include <hip/hip_bf16.h>
#include <hip/hip_cooperative_groups.h>
#include <cstdio>
#include <cstdint>
namespace cg = cooperative_groups;
namespace pg8 {
#define PG8_LAS __attribute__((address_space(3)))
typedef unsigned short bf16_t;
typedef short bf16x8 __attribute__((ext_vector_type(8)));
typedef float f32x4 __attribute__((ext_vector_type(4)));
typedef unsigned u32x4 __attribute__((ext_vector_type(4)));
constexpr int BM = 256, BK = 64, HALF = 128, HTB = HALF * BK * 2  , STAGE_BYTES = 8 * HTB, NXCD = 8, WGM = 8;

__host__ __device__ __forceinline__ int lds_byte(int r, int c) { const int st = (r >> 4) * 2 + (c >> 5), rr = r & 15, cc = c & 31, ob = rr * 64 + cc * 2; return st * 1024 + (ob ^ (((ob >> 9) & 1) << 5)); }
__host__ __device__ __forceinline__ void stage_rc(int b, int& R, int& C) { const int st = b / 1024, sb = b % 1024, swz = sb ^ (((sb >> 9) & 1) << 5); R = (st >> 1) * 16 + swz / 64; C = (st & 1) * 32 + (swz % 64) / 2; }
__host__ __device__ __forceinline__ int perm32(int rho) { const int n = rho >> 4, i = rho & 15; return 8 * (i >> 2) + 4 * n + (i & 3); }

struct Unit { int pm, pn; };
struct Gemm { const bf16_t* A; const bf16_t* Bt; int M, N, K; };

struct StaticOrder {
    int nM, nN, nwg, G, c;
    __host__ __device__ void init(int M, int N, int G_, int c_) { nM = M / BM; nN = N / BM; nwg = nM * nN; G = G_; c = c_; }
    __host__ __device__ bool next(int i, Unit& u) const {
        const long L = (long)i * G + c; if (L >= nwg) return false;
        int wgid = (int)L; { const int q = nwg / NXCD, r = nwg % NXCD, xcd = wgid % NXCD, off = wgid / NXCD; wgid = (xcd < r ? xcd * (q + 1) : r * (q + 1) + (xcd - r) * q) + off; }
        const int nig = WGM * nN, gid = wgid / nig, fm = gid * WGM, gsz = (nM - fm) < WGM ? (nM - fm) : WGM;
        u.pm = fm + ((wgid % nig) % gsz); u.pn = (wgid % nig) / gsz; return true;
    }
    __device__ __forceinline__ void a_ready(const Unit&) const {}
    __device__ __forceinline__ void done(const Unit&) const {}
};

__device__ __forceinline__ unsigned cvt_pk_bf16(float lo, float hi) { unsigned r; asm volatile("v_cvt_pk_bf16_f32 %0, %1, %2" : "=v"(r) : "v"(lo), "v"(hi)); return r; }
typedef float f32x2 __attribute__((ext_vector_type(2)));
template <class Epi, class Sched, bool ALIGN_EPI = false, bool SP2 = false>
__device__ __forceinline__ void gemm_phase(PG8_LAS unsigned char* lds, const Gemm g, const Sched& S, const Epi& E) {
    const int tid = threadIdx.x, wid = __builtin_amdgcn_readfirstlane(tid >> 6), lane = tid & 63, wr = wid >> 2, wc = wid & 3, fr = lane & 15, fq = lane >> 4;
    const int K = g.K, nt = K / BK;
    unsigned voffA[2], voffB[2];
#pragma unroll
    for (int i = 0; i < 2; ++i) { int R, C; stage_rc(tid * 16 + i * 8192, R, C); const int Rb = Epi::PERM ? ((R & ~31) + perm32(R & 31)) : R;
        voffA[i] = (unsigned)(R * K + C) * 2u; voffB[i] = (unsigned)(Rb * K + C) * 2u; }
    const size_t kstep = (size_t)(BK * 2);
    const size_t hstep = (size_t)HALF * K * 2;
    const size_t tstep = 2 * hstep;
    const unsigned ldsw = (unsigned)wid * 1024u;
    const int aoff = lds_byte(wr * 64 + fr, fq * 8), boff = lds_byte(wc * 32 + fr, fq * 8);
#define PG8_SA(b, h) (((b) * 2 + (h)) * HTB)
#define PG8_SB(b, h) ((4 + (b) * 2 + (h)) * HTB)
#define PG8_STAGE(bufoff, gbase, voff) do { _Pragma("unroll") for (int _i = 0; _i < 2; ++_i) \
        __builtin_amdgcn_global_load_lds((const unsigned*)((const char*)(gbase) + (voff)[_i]), (PG8_LAS unsigned*)(lds + (bufoff) + ldsw + _i * 8192), 16, 0, 0); } while (0)
#define PG8_LDA(dst, b, h) do { _Pragma("unroll") for (int m = 0; m < 4; ++m) _Pragma("unroll") for (int k = 0; k < 2; ++k) dst[m][k] = *(const PG8_LAS bf16x8*)(lds + PG8_SA(b, h) + aoff + m * 2048 + k * 1024); } while (0)
#define PG8_LDB(dst, b, h) do { _Pragma("unroll") for (int n = 0; n < 2; ++n) _Pragma("unroll") for (int k = 0; k < 2; ++k) dst[n][k] = *(const PG8_LAS bf16x8*)(lds + PG8_SB(b, h) + boff + n * 2048 + k * 1024); } while (0)
#define PG8_MMA(ai, bj, At, Bt) do { __builtin_amdgcn_s_setprio(1); _Pragma("unroll") for (int m = 0; m < 4; ++m) _Pragma("unroll") for (int n = 0; n < 2; ++n) _Pragma("unroll") for (int k = 0; k < 2; ++k) \
        acc[ai][bj][m][n] = __builtin_amdgcn_mfma_f32_16x16x32_bf16(Bt[n][k], At[m][k], acc[ai][bj][m][n], 0, 0, 0); __builtin_amdgcn_s_setprio(0); } while (0)
#define PG8_WAIT_V(n) asm volatile("s_waitcnt vmcnt(" #n ")" ::: "memory")
#define PG8_WAIT_L(n) asm volatile("s_waitcnt lgkmcnt(" #n ")" ::: "memory")
#define PG8_BAR __builtin_amdgcn_s_barrier()
#define PG8_SCHED __builtin_amdgcn_sched_barrier(0)
    Unit cur, nxt; int ui = 0;
    if (!S.next(0, cur)) return;
    f32x4 acc[2][2][4][2];
#pragma unroll
    for (int a = 0; a < 2; ++a)
#pragma unroll
        for (int b = 0; b < 2; ++b)
#pragma unroll
            for (int m = 0; m < 4; ++m)
#pragma unroll
                for (int n = 0; n < 2; ++n) acc[a][b][m][n] = (f32x4){0.f, 0.f, 0.f, 0.f};
    bf16x8 At[4][2], B0[2][2], B1[2][2];
    const char* cA = (const char*)g.A + (size_t)cur.pm * tstep; const char* cB = (const char*)g.Bt + (size_t)cur.pn * tstep;
    S.a_ready(cur);
    if constexpr (SP2) {
        PG8_STAGE(PG8_SB(0, 0), cB, voffB); PG8_STAGE(PG8_SB(0, 1), cB + hstep, voffB); PG8_STAGE(PG8_SA(0, 0), cA, voffA); PG8_STAGE(PG8_SA(0, 1), cA + hstep, voffA);
        if (wr == 1) PG8_BAR;
        PG8_WAIT_V(2); PG8_BAR;
        PG8_STAGE(PG8_SB(1, 0), cB + kstep, voffB); PG8_STAGE(PG8_SA(1, 0), cA + kstep, voffA); PG8_STAGE(PG8_SB(1, 1), cB + hstep + kstep, voffB);
        PG8_WAIT_V(6); PG8_BAR;
    } else {
        PG8_STAGE(PG8_SB(0, 0), cB, voffB); PG8_STAGE(PG8_SA(0, 0), cA, voffA); PG8_STAGE(PG8_SB(0, 1), cB + hstep, voffB); PG8_STAGE(PG8_SA(0, 1), cA + hstep, voffA);
        if (wr == 1) PG8_BAR;
        PG8_WAIT_V(4); PG8_BAR;
        PG8_STAGE(PG8_SB(1, 0), cB + kstep, voffB); PG8_STAGE(PG8_SA(1, 0), cA + kstep, voffA); PG8_STAGE(PG8_SB(1, 1), cB + hstep + kstep, voffB);
        PG8_WAIT_V(6); PG8_BAR;
    }
    for (;;) {
        const bool has_next = S.next(ui + 1, nxt);
        const char* nA = has_next ? (const char*)g.A + (size_t)nxt.pm * tstep : cA; const char* nB = has_next ? (const char*)g.Bt + (size_t)nxt.pn * tstep : cB;
        for (int t = 0; t < nt; t += 2) {
            const bool last = (t == nt - 2);
            const char* a1 = cA + (size_t)(t + 1) * kstep;
            const char* a2 = last ? nA : cA + (size_t)(t + 2) * kstep; const char* b2 = last ? nB : cB + (size_t)(t + 2) * kstep;
            const char* a3 = a2 + kstep; const char* b3 = b2 + kstep;
            if (last && has_next) S.a_ready(nxt);
            if constexpr (SP2) {
            PG8_LDB(B0, 0, 0); PG8_LDB(B1, 0, 1); PG8_SCHED; PG8_LDA(At, 0, 0); PG8_STAGE(PG8_SA(1, 1), a1 + hstep, voffA);
            PG8_WAIT_V(8); PG8_WAIT_L(0); PG8_BAR; PG8_MMA(0, 0, At, B0); PG8_MMA(0, 1, At, B1); PG8_BAR; PG8_SCHED;
            PG8_LDA(At, 0, 1); PG8_STAGE(PG8_SB(0, 0), b2, voffB); PG8_STAGE(PG8_SB(0, 1), b2 + hstep, voffB); PG8_STAGE(PG8_SA(0, 0), a2, voffA);
            PG8_WAIT_V(8); PG8_WAIT_L(0); PG8_BAR; PG8_MMA(1, 0, At, B0); PG8_MMA(1, 1, At, B1); PG8_BAR; PG8_SCHED;
            PG8_LDB(B0, 1, 0); PG8_LDB(B1, 1, 1); PG8_SCHED; PG8_LDA(At, 1, 0); PG8_STAGE(PG8_SA(0, 1), a2 + hstep, voffA);
            PG8_WAIT_V(8); PG8_WAIT_L(0); PG8_BAR; PG8_MMA(0, 0, At, B0); PG8_MMA(0, 1, At, B1); PG8_BAR; PG8_SCHED;
            PG8_LDA(At, 1, 1); PG8_STAGE(PG8_SB(1, 0), b3, voffB); PG8_STAGE(PG8_SB(1, 1), b3 + hstep, voffB); PG8_STAGE(PG8_SA(1, 0), a3, voffA);
            PG8_WAIT_V(8); PG8_WAIT_L(0); PG8_BAR; PG8_MMA(1, 0, At, B0); PG8_MMA(1, 1, At, B1); PG8_BAR; PG8_SCHED;
            } else {
            PG8_LDB(B0, 0, 0); PG8_SCHED; PG8_LDA(At, 0, 0); PG8_STAGE(PG8_SA(1, 1), a1 + hstep, voffA);
            PG8_WAIT_L(8); PG8_BAR; PG8_WAIT_L(0); PG8_MMA(0, 0, At, B0); PG8_BAR; PG8_SCHED;
            PG8_LDB(B1, 0, 1); PG8_STAGE(PG8_SB(0, 0), b2, voffB);
            PG8_BAR; PG8_WAIT_L(0); PG8_MMA(0, 1, At, B1); PG8_BAR;
            PG8_LDA(At, 0, 1); PG8_STAGE(PG8_SA(0, 0), a2, voffA);
            PG8_BAR; PG8_WAIT_L(0); PG8_MMA(1, 0, At, B0); PG8_BAR; PG8_SCHED;
            PG8_STAGE(PG8_SB(0, 1), b2 + hstep, voffB);
            PG8_WAIT_V(6); PG8_BAR; PG8_MMA(1, 1, At, B1); PG8_BAR;
            PG8_LDB(B0, 1, 0); PG8_SCHED; PG8_LDA(At, 1, 0); PG8_STAGE(PG8_SA(0, 1), a2 + hstep, voffA);
            PG8_WAIT_L(8); PG8_BAR; PG8_WAIT_L(0); PG8_MMA(0, 0, At, B0); PG8_BAR; PG8_SCHED;
            PG8_LDB(B1, 1, 1); PG8_STAGE(PG8_SB(1, 0), b3, voffB);
            PG8_BAR; PG8_WAIT_L(0); PG8_MMA(0, 1, At, B1); PG8_BAR;
            PG8_LDA(At, 1, 1); PG8_STAGE(PG8_SA(1, 0), a3, voffA);
            PG8_BAR; PG8_WAIT_L(0); PG8_MMA(1, 0, At, B0); PG8_BAR; PG8_SCHED;
            PG8_STAGE(PG8_SB(1, 1), b3 + hstep, voffB);
            PG8_WAIT_V(6); PG8_BAR; PG8_MMA(1, 1, At, B1); PG8_BAR;
            }
        }
        if constexpr (ALIGN_EPI) { if (wr == 0) PG8_BAR; }
        if constexpr (!Epi::AFTER_DRAIN) { E(acc, cur, wr, wc, fr, fq); S.done(cur); }
        if (!has_next) break;
#pragma unroll
        for (int a = 0; a < 2; ++a)
#pragma unroll
            for (int b = 0; b < 2; ++b)
#pragma unroll
                for (int m = 0; m < 4; ++m)
#pragma unroll
                    for (int n = 0; n < 2; ++n) acc[a][b][m][n] = (f32x4){0.f, 0.f, 0.f, 0.f};
        cur = nxt; cA = nA; cB = nB; ++ui;
        if constexpr (ALIGN_EPI) { if (wr == 1) PG8_BAR; }
    }
    PG8_WAIT_V(0);
    if constexpr (!ALIGN_EPI) { if (wr == 0) PG8_BAR; }
    PG8_BAR;
    if constexpr (Epi::AFTER_DRAIN) { E.fused(acc, cur, wr, wc, fr, fq, lds, wid, lane); S.done(cur); }
#undef PG8_SA
#undef PG8_SB
#undef PG8_STAGE
#undef PG8_LDA
#undef PG8_LDB
#undef PG8_MMA
#undef PG8_WAIT_V
#undef PG8_WAIT_L
#undef PG8_BAR
#undef PG8_SCHED
}
}

constexpr int BATCH = 32, SEQ = 2048, DM = 1024, M = BATCH * SEQ, NMETA = 16, TT = SEQ + NMETA;
constexpr int SKV = 2176, NPAD = SKV - TT;
constexpr int NIN = 5632, DFF = 2816, HD = 128;
constexpr float EPS = 1e-6f;
constexpr size_t MiB = 1u << 20;
constexpr size_t WS_WIN = 2 * MiB, WS_WOUT = 14 * MiB, WS_WFI = 16 * MiB, WS_WFO = 28 * MiB, WS_WG = 34 * MiB, WS_ROPE = 35 * MiB,
                 WS_METAP = 35 * MiB + 65536, WS_XRM = 35 * MiB + 262144, WS_SS = 36 * MiB,
                 WS_XN = 64 * MiB, WS_Q = 192 * MiB, WS_KRAW = 320 * MiB, WS_KF = 352 * MiB, WS_VF = 388 * MiB, WS_XR = 424 * MiB,
                 WS_GG = 552 * MiB, WS_GA = 680 * MiB, WS_HF = 808 * MiB, WS_END = 936 * MiB;
constexpr size_t WS_RT = WS_XN, WS_H1B = WS_XR, WS_ACT = WS_GG;
constexpr int LDS_BYTES = 147456;
#define LAS __attribute__((address_space(3)))
typedef unsigned short bf16_t;
typedef short bf16x8 __attribute__((ext_vector_type(8)));
typedef float f32x4 __attribute__((ext_vector_type(4)));
typedef float f32x2 __attribute__((ext_vector_type(2)));
typedef unsigned u32x4 __attribute__((ext_vector_type(4)));
typedef unsigned u32x2 __attribute__((ext_vector_type(2)));

__device__ __forceinline__ unsigned pk2(float lo, float hi) { unsigned r; asm volatile("v_cvt_pk_bf16_f32 %0, %1, %2" : "=v"(r) : "v"(lo), "v"(hi)); return r; }
__device__ __forceinline__ float bflo(unsigned w) { return __uint_as_float(w << 16); }
__device__ __forceinline__ float bfhi(unsigned w) { return __uint_as_float(w & 0xffff0000u); }
__device__ __forceinline__ float bf1(bf16_t v) { return __uint_as_float((unsigned)v << 16); }
__device__ __forceinline__ float sigm(float x) { return __builtin_amdgcn_rcpf(1.f + __builtin_amdgcn_exp2f(-1.4426950408889634f * x)); }
__device__ __forceinline__ float gelu_t(float x) { const float z = 1.5957691216057308f * (x + 0.044715f * x * x * x); return x * sigm(z); }
__device__ __forceinline__ float wave_sum(float v) {
#pragma unroll
    for (int o = 1; o < 64; o <<= 1) v += __shfl_xor(v, o);
    return v;
}
#define LDS_WAIT() asm volatile("s_waitcnt lgkmcnt(0)" ::: "memory")

struct Epi1 {
    static constexpr bool PERM = true, AFTER_DRAIN = false;
    bf16_t *Q, *KRAW, *VF, *XR, *GG, *GA;
    __device__ __forceinline__ void operator()(const pg8::f32x4 (&acc)[2][2][4][2], const pg8::Unit& u, int wr, int wc, int fr, int fq) const {
        const int pn = u.pn; const int row0 = u.pm * 256 + wr * 64 + fr; const int cl = wc * 32 + 8 * fq;
        if (pn >= 10 && pn < 18) {
#pragma unroll
            for (int ai = 0; ai < 2; ++ai)
#pragma unroll
                for (int m = 0; m < 4; ++m) { const size_t row = row0 + ai * 128 + m * 16;
                    float o[8];
#pragma unroll
                    for (int n = 0; n < 2; ++n)
#pragma unroll
                        for (int e = 0; e < 4; ++e) o[n * 4 + e] = gelu_t(acc[ai][0][m][n][e]) * sigm(acc[ai][1][m][n][e]);
                    u32x4 w; w.x = pk2(o[0], o[1]); w.y = pk2(o[2], o[3]); w.z = pk2(o[4], o[5]); w.w = pk2(o[6], o[7]);
                    *(u32x4*)(GG + row * 1024 + (pn - 10) * 128 + cl) = w; }
            return;
        }
        bf16_t* base; int ld, colb; bool sg = false;
        if (pn < 4) { base = Q; ld = 1024; colb = pn * 256; }
        else if (pn == 4) { base = KRAW; ld = 256; colb = 0; }
        else if (pn == 5) { const int b = (u.pm * 256) >> 11, s0 = (u.pm * 256) & 2047;
            base = VF + ((size_t)(b * 2) * SKV + 16 + s0) * 128 - (size_t)(u.pm * 256) * 128; ld = 128; colb = 0; }
        else if (pn < 10) { base = XR; ld = 1024; colb = (pn - 6) * 256; }
        else { base = GA; ld = 1024; colb = (pn - 18) * 256; sg = true; }
        const size_t bjstep = (pn == 5) ? (size_t)SKV * 128 : 128;
#pragma unroll
        for (int ai = 0; ai < 2; ++ai)
#pragma unroll
            for (int m = 0; m < 4; ++m) { const size_t row = row0 + ai * 128 + m * 16;
#pragma unroll
                for (int bj = 0; bj < 2; ++bj) { pg8::f32x4 v0 = acc[ai][bj][m][0], v1 = acc[ai][bj][m][1];
                    if (sg) { v0 = (pg8::f32x4){sigm(v0[0]), sigm(v0[1]), sigm(v0[2]), sigm(v0[3])}; v1 = (pg8::f32x4){sigm(v1[0]), sigm(v1[1]), sigm(v1[2]), sigm(v1[3])}; }
                    u32x4 w; w.x = pk2(v0[0], v0[1]); w.y = pk2(v0[2], v0[3]); w.z = pk2(v1[0], v1[1]); w.w = pk2(v1[2], v1[3]);
                    *(u32x4*)(base + row * ld + colb + bj * bjstep + cl) = w; } }
    }
};
struct Epi2 {
    static constexpr bool PERM = true, AFTER_DRAIN = false;
    const float* X; float* H1; bf16_t* H1B; float* SS;
    __device__ __forceinline__ void operator()(const pg8::f32x4 (&acc)[2][2][4][2], const pg8::Unit& u, int wr, int wc, int fr, int fq) const {
        const int row0 = u.pm * 256 + wr * 64 + fr; const int c0 = u.pn * 256 + wc * 32 + 8 * fq;
#pragma unroll
        for (int ai = 0; ai < 2; ++ai)
#pragma unroll
            for (int m = 0; m < 4; ++m) { const size_t row = row0 + ai * 128 + m * 16; float ss = 0.f;
#pragma unroll
                for (int bj = 0; bj < 2; ++bj) { const size_t off = row * 1024 + c0 + bj * 128;
                    const pg8::f32x4 x0 = *(const pg8::f32x4*)(X + off), x1 = *(const pg8::f32x4*)(X + off + 4);
                    const pg8::f32x4 v0 = acc[ai][bj][m][0] + x0, v1 = acc[ai][bj][m][1] + x1;
                    *(pg8::f32x4*)(H1 + off) = v0; *(pg8::f32x4*)(H1 + off + 4) = v1;
                    u32x4 w; w.x = pk2(v0[0], v0[1]); w.y = pk2(v0[2], v0[3]); w.z = pk2(v1[0], v1[1]); w.w = pk2(v1[2], v1[3]);
                    *(u32x4*)(H1B + off) = w;
                    ss += (v0[0] * v0[0] + v0[1] * v0[1]) + (v0[2] * v0[2] + v0[3] * v0[3]) + (v1[0] * v1[0] + v1[1] * v1[1]) + (v1[2] * v1[2] + v1[3] * v1[3]); }
                ss += __shfl_xor(ss, 16); ss += __shfl_xor(ss, 32);
                if (fq == 0) SS[row * 16 + u.pn * 4 + wc] = ss;
                if (m & 1) asm volatile("" ::: "memory"); }
    }
};
struct Epi3 {
    static constexpr bool PERM = true, AFTER_DRAIN = false;
    const float* SS; bf16_t* ACT;
    __device__ __forceinline__ void operator()(const pg8::f32x4 (&acc)[2][2][4][2], const pg8::Unit& u, int wr, int wc, int fr, int fq) const {
        const int row0 = u.pm * 256 + wr * 64 + fr; const int c0 = u.pn * 128 + wc * 32 + 8 * fq;
#pragma unroll
        for (int ai = 0; ai < 2; ++ai)
#pragma unroll
            for (int m = 0; m < 4; ++m) { const size_t row = row0 + ai * 128 + m * 16;
                const pg8::f32x4* sp = (const pg8::f32x4*)(SS + row * 16); const pg8::f32x4 s0 = sp[0], s1 = sp[1], s2 = sp[2], s3 = sp[3];
                const float tot = ((s0[0] + s0[1]) + (s0[2] + s0[3])) + ((s1[0] + s1[1]) + (s1[2] + s1[3])) + ((s2[0] + s2[1]) + (s2[2] + s2[3])) + ((s3[0] + s3[1]) + (s3[2] + s3[3]));
                const float rstd = __builtin_amdgcn_rsqf(tot * (1.f / 1024.f) + EPS);
                float o[8];
#pragma unroll
                for (int n = 0; n < 2; ++n)
#pragma unroll
                    for (int e = 0; e < 4; ++e) { const float g = acc[ai][0][m][n][e] * rstd, uu = acc[ai][1][m][n][e] * rstd; o[n * 4 + e] = g * sigm(g) * uu; }
                u32x4 w; w.x = pk2(o[0], o[1]); w.y = pk2(o[2], o[3]); w.z = pk2(o[4], o[5]); w.w = pk2(o[6], o[7]);
                *(u32x4*)(ACT + row * DFF + c0) = w; }
    }
};
struct Epi4 {
    static constexpr bool PERM = true, AFTER_DRAIN = false;
    float* H1;
    __device__ __forceinline__ void operator()(const pg8::f32x4 (&acc)[2][2][4][2], const pg8::Unit& u, int wr, int wc, int fr, int fq) const {
        const int row0 = u.pm * 256 + wr * 64 + fr; const int c0 = u.pn * 256 + wc * 32 + 8 * fq;
#pragma unroll
        for (int ai = 0; ai < 2; ++ai)
#pragma unroll
            for (int m = 0; m < 4; ++m) { const size_t row = row0 + ai * 128 + m * 16;
#pragma unroll
                for (int bj = 0; bj < 2; ++bj) { const size_t off = row * 1024 + c0 + bj * 128;
                    const pg8::f32x4 x0 = *(const pg8::f32x4*)(H1 + off), x1 = *(const pg8::f32x4*)(H1 + off + 4);
                    *(pg8::f32x4*)(H1 + off) = acc[ai][bj][m][0] + x0; *(pg8::f32x4*)(H1 + off + 4) = acc[ai][bj][m][1] + x1; }
                if (m & 1) asm volatile("" ::: "memory"); }
    }
};

struct P {
    const float *x, *meta, *g1, *w_in, *conv_w, *conv_b, *rg_wa, *rg_ba, *rg_wx, *rg_bx, *rg_lam, *qg, *kg, *w_out, *g2, *w_fi, *w_fo;
    float* out; unsigned char* ws;
};
__device__ __forceinline__ void tr_item(const float* W, int K, int N, bf16_t* WT, int k0, int n0s, int n0d, const float* ksc, LAS float* scr, int lane) {
#pragma unroll 8
    for (int i = 0; i < 32; ++i) { const int kk = 2 * i + (lane >> 5); float v = W[(size_t)(k0 + kk) * N + n0s + (lane & 31)]; if (ksc) v *= ksc[k0 + kk]; scr[kk * 33 + (lane & 31)] = v; }
    LDS_WAIT(); asm volatile("" ::: "memory");
    const int c = lane & 7;
#pragma unroll
    for (int j = 0; j < 4; ++j) { const int n = (lane >> 3) + 8 * j; const LAS float* s = scr + (8 * c) * 33 + n;
        u32x4 o; o.x = pk2(s[0 * 33], s[1 * 33]); o.y = pk2(s[2 * 33], s[3 * 33]); o.z = pk2(s[4 * 33], s[5 * 33]); o.w = pk2(s[6 * 33], s[7 * 33]);
        *(u32x4*)(WT + (size_t)(n0d + n) * K + k0 + 8 * c) = o; }
    LDS_WAIT(); asm volatile("" ::: "memory");
}
__device__ __forceinline__ int win_src_col(int nd) {
    if (nd < 2560) return nd;
    if (nd < 4608) { const int r = nd - 2560, t = r >> 8, half = (r >> 7) & 1, c = r & 127; return (half ? 4608 : 2560) + 128 * t + c; }
    return 3584 + (nd - 4608);
}
__device__ __forceinline__ void p0_prologue(const P& p, unsigned char* ldsg, int vcu, int G) {
    const int tid = threadIdx.x, lane = tid & 63, wave = tid >> 6;
    unsigned char* ws = p.ws;
    if (blockIdx.x < 24) {
        float* xm = (float*)ldsg;
        float* red = (float*)(ldsg + 65536);
        for (int r = wave * 2; r < wave * 2 + 2; ++r) {
            const f32x4* xr = (const f32x4*)(p.meta + r * 1024) + lane; f32x4 v[4]; float s = 0.f;
#pragma unroll
            for (int j = 0; j < 4; ++j) { v[j] = xr[64 * j]; s += (v[j][0] * v[j][0] + v[j][1] * v[j][1]) + (v[j][2] * v[j][2] + v[j][3] * v[j][3]); }
            const float rstd = __builtin_amdgcn_rsqf(wave_sum(s) * (1.f / 1024.f) + EPS);
#pragma unroll
            for (int j = 0; j < 4; ++j) { const f32x4 g = ((const f32x4*)p.g1)[lane + 64 * j]; ((f32x4*)(xm + r * 1024))[lane + 64 * j] = v[j] * rstd * g; }
        }
        __syncthreads();
        const int col = blockIdx.x * 64 + lane; float acc[16];
#pragma unroll
        for (int r = 0; r < 16; ++r) acc[r] = 0.f;
        for (int k = wave * 128; k < wave * 128 + 128; ++k) { const float w = p.w_in[(size_t)k * NIN + 1024 + col];
#pragma unroll
            for (int r = 0; r < 16; ++r) acc[r] += xm[r * 1024 + k] * w; }
#pragma unroll
        for (int r = 0; r < 16; ++r) red[(wave * 16 + r) * 64 + lane] = acc[r];
        __syncthreads();
        float* METAP = (float*)(ws + WS_METAP); bf16_t* XRM = (bf16_t*)(ws + WS_XRM);
        for (int o = tid; o < 1024; o += 512) { const int r = o >> 6, c = o & 63; float s = 0.f;
#pragma unroll
            for (int w = 0; w < 8; ++w) s += red[(w * 16 + r) * 64 + c];
            const int cc = blockIdx.x * 64 + c; METAP[r * 1536 + cc] = s;
            if (cc >= 512) XRM[r * 1024 + cc - 512] = (bf16_t)(pk2(s, s) & 0xffffu); }
        __syncthreads();
    }
    if (blockIdx.x == (unsigned)(G - 1)) {
        f32x2* ROPE = (f32x2*)(ws + WS_ROPE);
        for (int idx = tid; idx < 2048; idx += 512) { const int pos = idx >> 5, i = idx & 31;
            double invf = 1.0; for (int q = 0; q < i; ++q) invf *= 0.74989420933245582730;
            const double a = (double)pos * invf; const double nq = __builtin_rint(a * 0.63661977236758134308); const double r = (a - nq * 1.57079632679489655800) - nq * 6.123233995736766e-17;
            const double r2 = r * r;
            const double sn = r * (1.0 + r2 * (-1.0 / 6 + r2 * (1.0 / 120 + r2 * (-1.0 / 5040 + r2 * (1.0 / 362880 + r2 * (-1.0 / 39916800 + r2 * (1.0 / 6227020800.0)))))));
            const double cs = 1.0 + r2 * (-0.5 + r2 * (1.0 / 24 + r2 * (-1.0 / 720 + r2 * (1.0 / 40320 + r2 * (-1.0 / 3628800 + r2 * (1.0 / 479001600.0))))));
            const int qd = ((int)nq) & 3; double c, s;
            if (qd == 0) { c = cs; s = sn; } else if (qd == 1) { c = -sn; s = cs; } else if (qd == 2) { c = -cs; s = -sn; } else { c = sn; s = -cs; }
            ROPE[idx] = (f32x2){(float)c, (float)s}; }
    }
    LAS float* scr = (LAS float*)((LAS unsigned char*)ldsg + wave * 16384);
    const int gw = vcu * 8 + wave, NGW = G * 8;
    constexpr int I_IN = 16 * 176, I_OUT = 16 * 32, I_FI = 16 * 176, I_FO = 44 * 32, I_G = 32 * 8;
    constexpr int NITEMS = I_IN + I_OUT + I_FI + I_FO + I_G;
    for (int it = gw; it < NITEMS; it += NGW) {
        int r = it;
        if (r < I_IN) { const int kb = r / 176, nb = r % 176; tr_item(p.w_in, 1024, NIN, (bf16_t*)(ws + WS_WIN), 64 * kb, win_src_col(32 * nb), 32 * nb, nullptr, scr, lane); continue; } r -= I_IN;
        if (r < I_OUT) { const int kb = r / 32, nb = r % 32; tr_item(p.w_out, 1024, 1024, (bf16_t*)(ws + WS_WOUT), 64 * kb, 32 * nb, 32 * nb, nullptr, scr, lane); continue; } r -= I_OUT;
        if (r < I_FI) { const int kb = r / 176, nb = r % 176, nd = 32 * nb, t = nd >> 8, half = (nd >> 7) & 1, c = nd & 127;
            tr_item(p.w_fi, 1024, 2 * DFF, (bf16_t*)(ws + WS_WFI), 64 * kb, (half ? DFF : 0) + 128 * t + c, nd, p.g2, scr, lane); continue; } r -= I_FI;
        if (r < I_FO) { const int kb = r / 32, nb = r % 32; tr_item(p.w_fo, DFF, 1024, (bf16_t*)(ws + WS_WFO), 64 * kb, 32 * nb, 32 * nb, nullptr, scr, lane); continue; } r -= I_FO;
        { const int mi = r >> 3, sub = r & 7, gate = mi >> 4, dir = (mi >> 3) & 1, n = mi & 7, kb = sub >> 2, nb = sub & 3;
          const float* src = (gate ? p.rg_wx : p.rg_wa) + (size_t)(dir * 8 + n) * 16384;
          tr_item(src, 128, 128, (bf16_t*)(ws + WS_WG) + (size_t)((dir * 2 + gate) * 8 + n) * 16384, 64 * kb, 32 * nb, 32 * nb, nullptr, scr, lane); }
    }
    bf16_t* XN = (bf16_t*)(ws + WS_XN);
    f32x4 g[4];
#pragma unroll
    for (int j = 0; j < 4; ++j) g[j] = ((const f32x4*)p.g1)[lane + 64 * j];
    for (int m = gw; m < M; m += NGW) {
        const f32x4* xr = (const f32x4*)(p.x + (size_t)m * 1024) + lane; f32x4 v[4]; float s = 0.f;
#pragma unroll
        for (int j = 0; j < 4; ++j) { v[j] = __builtin_nontemporal_load(xr + 64 * j); s += (v[j][0] * v[j][0] + v[j][1] * v[j][1]) + (v[j][2] * v[j][2] + v[j][3] * v[j][3]); }
        const float rstd = __builtin_amdgcn_rsqf(wave_sum(s) * (1.f / 1024.f) + EPS);
        u32x2* o8 = (u32x2*)(XN + (size_t)m * 1024) + lane;
#pragma unroll
        for (int j = 0; j < 4; ++j) { const f32x4 y = v[j] * rstd * g[j]; o8[64 * j] = (u32x2){pk2(y[0], y[1]), pk2(y[2], y[3])}; }
    }
}

__device__ __forceinline__ void p2_kpass(const P& p, int vcu, int G) {
    unsigned char* ws = p.ws;
    const int tid = threadIdx.x, j = tid & 15;
    const int gidx = vcu * 32 + (tid >> 4), NG = G * 32;
    const bf16_t* KRAW = (const bf16_t*)(ws + WS_KRAW); bf16_t* KF = (bf16_t*)(ws + WS_KF); bf16_t* VF = (bf16_t*)(ws + WS_VF);
    const f32x2* ROPE = (const f32x2*)(ws + WS_ROPE); const float* METAP = (const float*)(ws + WS_METAP);
    float kg[8];
#pragma unroll
    for (int e = 0; e < 8; ++e) kg[e] = p.kg[8 * j + e];
    for (int task = gidx; task < 2 * M; task += NG) {
        const int row = task >> 1, h = task & 1, b = row >> 11, s = row & 2047;
        const u32x4 raw = *(const u32x4*)(KRAW + (size_t)row * 256 + h * 128 + 8 * j);
        float y[8] = {bflo(raw.x), bfhi(raw.x), bflo(raw.y), bfhi(raw.y), bflo(raw.z), bfhi(raw.z), bflo(raw.w), bfhi(raw.w)};
        float ss = 0.f;
#pragma unroll
        for (int e = 0; e < 8; ++e) ss += y[e] * y[e];
        ss += __shfl_xor(ss, 1); ss += __shfl_xor(ss, 2); ss += __shfl_xor(ss, 4); ss += __shfl_xor(ss, 8);
        const float rstd = __builtin_amdgcn_rsqf(ss * (1.f / 128.f) + EPS);
        const int pos = (j >> 3) ? (s & 63) : (s >> 6);
        const f32x4* cs = (const f32x4*)(ROPE + pos * 32 + 8 * (j & 3));
        float o[8];
#pragma unroll
        for (int e2 = 0; e2 < 4; ++e2) { const f32x4 c2 = cs[e2];
#pragma unroll
            for (int q = 0; q < 2; ++q) { const int e = 2 * e2 + q; const float v = y[e] * rstd * kg[e]; const float pr = __shfl_xor(v, 4);
                const float c = c2[2 * q], sn = c2[2 * q + 1]; o[e] = (j & 4) ? (v * c + pr * sn) : (v * c - pr * sn); } }
        u32x4 w; w.x = pk2(o[0], o[1]); w.y = pk2(o[2], o[3]); w.z = pk2(o[4], o[5]); w.w = pk2(o[6], o[7]);
        *(u32x4*)(KF + ((size_t)(b * 2 + h) * SKV + 16 + s) * 128 + 8 * j) = w;
    }
    for (int task = gidx; task < BATCH * 2 * 128; task += NG) {
        const int bh = task >> 7, pp = task & 127, h = bh & 1;
        u32x4 wk = (u32x4){0u, 0u, 0u, 0u}, wv = wk; int prow;
        if (pp < 16) { prow = pp;
            const float* mk = METAP + pp * 1536 + h * 128 + 8 * j; const float* mv = mk + 256;
            float y[8]; float ss = 0.f;
#pragma unroll
            for (int e = 0; e < 8; ++e) { y[e] = mk[e]; ss += y[e] * y[e]; }
            ss += __shfl_xor(ss, 1); ss += __shfl_xor(ss, 2); ss += __shfl_xor(ss, 4); ss += __shfl_xor(ss, 8);
            const float rstd = __builtin_amdgcn_rsqf(ss * (1.f / 128.f) + EPS);
#pragma unroll
            for (int e = 0; e < 8; ++e) y[e] = y[e] * rstd * kg[e];
            wk.x = pk2(y[0], y[1]); wk.y = pk2(y[2], y[3]); wk.z = pk2(y[4], y[5]); wk.w = pk2(y[6], y[7]);
            wv.x = pk2(mv[0], mv[1]); wv.y = pk2(mv[2], mv[3]); wv.z = pk2(mv[4], mv[5]); wv.w = pk2(mv[6], mv[7]);
        } else { prow = TT + (pp - 16); }
        *(u32x4*)(KF + ((size_t)bh * SKV + prow) * 128 + 8 * j) = wk;
        *(u32x4*)(VF + ((size_t)bh * SKV + prow) * 128 + 8 * j) = wv;
    }
}

constexpr int R_XC = 0, R_AS = 17408, R_US = R_AS + 33792, R_SEG = R_US + 33792, R_ST = R_SEG + 4096, R_CW = R_ST + 1024, R_END = R_CW + 2560;
__device__ __forceinline__ bf16x8 rnn_ld_row(const bf16_t* XRb, const bf16_t* XRMn, int pidx, int coff) {
    bf16x8 z = {0, 0, 0, 0, 0, 0, 0, 0};
    if (pidx < 0 || pidx >= TT) return z;
    if (pidx < NMETA) return *(const bf16x8*)(XRMn + pidx * 1024 + coff);
    return *(const bf16x8*)(XRb + (size_t)(pidx - NMETA) * 1024 + coff);
}
__device__ __forceinline__ void rnn_item(const P& p, unsigned char* ldsg, int b, int n) {
    unsigned char* ws = p.ws;
    const int tid = threadIdx.x, lane = tid & 63, w = tid >> 6, fr = lane & 15, fq = lane >> 4;
    bf16_t* XC = (bf16_t*)(ldsg + R_XC); float* AS = (float*)(ldsg + R_AS); float* US = (float*)(ldsg + R_US);
    float* SEG = (float*)(ldsg + R_SEG); float* ST = (float*)(ldsg + R_ST); float* CW = (float*)(ldsg + R_CW);
    const bf16_t* XRb = (const bf16_t*)(ws + WS_XR) + (size_t)b * SEQ * 1024 + 128 * n;
    const bf16_t* XRMn = (const bf16_t*)(ws + WS_XRM) + 128 * n;
    bf16_t* HF = (bf16_t*)(ws + WS_HF) + (size_t)b * SEQ * 1024 + 128 * n;
    const bf16_t* GG = (const bf16_t*)(ws + WS_GG) + (size_t)b * SEQ * 1024 + 128 * n;
    bf16_t* RT = (bf16_t*)(ws + WS_RT) + (size_t)b * SEQ * 1024 + 128 * n;
    const bf16_t* WG = (const bf16_t*)(ws + WS_WG);
    for (int i = tid; i < 640; i += 512) CW[i] = (i < 512) ? p.conv_w[(i >> 7) * 1024 + 128 * n + (i & 127)] : p.conv_b[128 * n + (i - 512)];
    const int tg = tid >> 4, cgp = tid & 15, coff = 8 * cgp;
    const int ch = tid & 127, sg = tid >> 7;
    for (int dir = 0; dir < 2; ++dir) {
        bf16x8 bfr[2][4];
#pragma unroll
        for (int gate = 0; gate < 2; ++gate)
#pragma unroll
            for (int ks = 0; ks < 4; ++ks) bfr[gate][ks] = *(const bf16x8*)(WG + ((size_t)((dir * 2 + gate) * 8 + n) * 128 + 16 * w + fr) * 128 + 32 * ks + 8 * fq);
        float ba4[4], bx4[4], ls4[4];
#pragma unroll
        for (int r = 0; r < 4; ++r) { const int cgl = dir * 1024 + 128 * n + 16 * w + 4 * fq + r; ba4[r] = p.rg_ba[cgl]; bx4[r] = p.rg_bx[cgl];
            const float lam = p.rg_lam[cgl]; const float y = __builtin_amdgcn_exp2f(-1.4426950408889634f * lam);
            float l1p; if (y < 0.05f) l1p = y * (1.f + y * (-0.5f + y * (1.f / 3 + y * (-0.25f + y * (0.2f + y * (-1.f / 6)))))); else l1p = __logf(1.f + y);
            ls4[r] = -8.f * l1p; }
        if (tid < 128) ST[tid] = 0.f;
        __syncthreads();
        const int nch = dir == 0 ? 33 : 32;
        bf16x8 rows[5];
        { const int ci0 = dir == 0 ? 0 : 32; const int p00 = ci0 == 0 ? -48 : 16 + 64 * (ci0 - 1);
#pragma unroll
          for (int q = 0; q < 5; ++q) rows[q] = rnn_ld_row(XRb, XRMn, p00 + 2 * tg - 2 + q, coff); }
        for (int c = 0; c < nch; ++c) {
            const int ci = dir == 0 ? c : 32 - c; const int p0 = ci == 0 ? -48 : 16 + 64 * (ci - 1);
            { float xf[5][8];
#pragma unroll
              for (int q = 0; q < 5; ++q)
#pragma unroll
                  for (int e = 0; e < 8; ++e) xf[q][e] = bf1((bf16_t)rows[q][e]);
              float o0[8], o1[8];
#pragma unroll
              for (int e = 0; e < 8; ++e) { const float w0 = CW[coff + e], w1 = CW[128 + coff + e], w2 = CW[256 + coff + e], w3 = CW[384 + coff + e], cb = CW[512 + coff + e];
                  o0[e] = cb + w0 * xf[0][e] + w1 * xf[1][e] + w2 * xf[2][e] + w3 * xf[3][e];
                  o1[e] = cb + w0 * xf[1][e] + w1 * xf[2][e] + w2 * xf[3][e] + w3 * xf[4][e]; }
              u32x4 a0, a1; a0.x = pk2(o0[0], o0[1]); a0.y = pk2(o0[2], o0[3]); a0.z = pk2(o0[4], o0[5]); a0.w = pk2(o0[6], o0[7]);
              a1.x = pk2(o1[0], o1[1]); a1.y = pk2(o1[2], o1[3]); a1.z = pk2(o1[4], o1[5]); a1.w = pk2(o1[6], o1[7]);
              *(u32x4*)(XC + (2 * tg) * 136 + coff) = a0; *(u32x4*)(XC + (2 * tg + 1) * 136 + coff) = a1; }
            if (c + 1 < nch) { const int cin = dir == 0 ? c + 1 : 32 - (c + 1); const int pn0 = cin == 0 ? -48 : 16 + 64 * (cin - 1);
#pragma unroll
                for (int q = 0; q < 5; ++q) rows[q] = rnn_ld_row(XRb, XRMn, pn0 + 2 * tg - 2 + q, coff); }
            __syncthreads();
            f32x4 accA[4], accX[4];
#pragma unroll
            for (int tb = 0; tb < 4; ++tb) { accA[tb] = (f32x4){0.f, 0.f, 0.f, 0.f}; accX[tb] = accA[tb];
#pragma unroll
                for (int ks = 0; ks < 4; ++ks) { const bf16x8 yv = *(const bf16x8*)(XC + (16 * tb + fr) * 136 + 32 * ks + 8 * fq);
                    accA[tb] = __builtin_amdgcn_mfma_f32_16x16x32_bf16(bfr[0][ks], yv, accA[tb], 0, 0, 0);
                    accX[tb] = __builtin_amdgcn_mfma_f32_16x16x32_bf16(bfr[1][ks], yv, accX[tb], 0, 0, 0); } }
#pragma unroll
            for (int tb = 0; tb < 4; ++tb) { const int tok = 16 * tb + fr; const u32x2 xw = *(const u32x2*)(XC + tok * 136 + 16 * w + 4 * fq);
                const float xc4[4] = {bflo(xw.x), bfhi(xw.x), bflo(xw.y), bfhi(xw.y)}; f32x4 av, uv;
#pragma unroll
                for (int r = 0; r < 4; ++r) { const float rr = sigm(accA[tb][r] + ba4[r]), ii = sigm(accX[tb][r] + bx4[r]); const float la = rr * ls4[r];
                    const float a = __builtin_amdgcn_exp2f(1.4426950408889634f * la); const float x2 = 2.f * la;
                    const float om = -x2 * (1.f + x2 * (0.5f + x2 * (1.f / 6 + x2 * (1.f / 24 + x2 * (1.f / 120 + x2 * (1.f / 720))))));
                    av[r] = a; uv[r] = __builtin_amdgcn_sqrtf(fmaxf(om, 0.f)) * ii * xc4[r]; }
                if (p0 + tok < 0) { av = (f32x4){1.f, 1.f, 1.f, 1.f}; uv = (f32x4){0.f, 0.f, 0.f, 0.f}; }
                *(f32x4*)(AS + tok * 132 + 16 * w + 4 * fq) = av; *(f32x4*)(US + tok * 132 + 16 * w + 4 * fq) = uv; }
            __syncthreads();
            float hl[16], ac[16]; float hh = 0.f, aa = 1.f;
#pragma unroll
            for (int i = 0; i < 16; ++i) { const int t = dir == 0 ? 16 * sg + i : 63 - (16 * sg + i); const float a = AS[t * 132 + ch], u = US[t * 132 + ch]; hh = a * hh + u; aa *= a; hl[i] = hh; ac[i] = aa; }
            SEG[sg * 128 + ch] = aa; SEG[512 + sg * 128 + ch] = hh;
            __syncthreads();
            float carry = ST[(c & 1) * 128 + ch];
#pragma unroll
            for (int s2 = 0; s2 < 3; ++s2) if (s2 < sg) carry = SEG[s2 * 128 + ch] * carry + SEG[512 + s2 * 128 + ch];
            if (sg == 3) ST[((c + 1) & 1) * 128 + ch] = aa * carry + hh;
            if (ci > 0) {
                const size_t rb = (size_t)(p0 - NMETA);
                if (dir == 0) {
#pragma unroll
                    for (int i = 0; i < 16; ++i) { const int t = 16 * sg + i; const float hv = hl[i] + ac[i] * carry; HF[(rb + t) * 1024 + ch] = (bf16_t)(pk2(hv, hv) & 0xffffu); }
                } else {
#pragma unroll
                    for (int i = 0; i < 16; ++i) { const int t = 63 - (16 * sg + i); const float hv = hl[i] + ac[i] * carry;
                        const float hf = bf1(HF[(rb + t) * 1024 + ch]), gg = bf1(GG[(rb + t) * 1024 + ch]); const float o = (hf + hv) * gg;
                        RT[(rb + t) * 1024 + ch] = (bf16_t)(pk2(o, o) & 0xffffu); }
                }
            }
        }
        __syncthreads();
    }
}

namespace att {
using bf16 = __hip_bfloat16;
constexpr int   D = 128, NW = 8, QBLK = 32, KVBLK = 64;
constexpr float SCALE = 0.088388347648318440f;
constexpr float THR = 8.f;
constexpr int SDEPTH = 2;
constexpr int NPADK = NPAD;
constexpr size_t SHM_V = KVBLK * D * 2, SHM_K = KVBLK * D * 2, SHM_ATTN = 2 * SHM_V + 2 * SHM_K + NW * 64 * 4;
using bf16x8 = __attribute__((ext_vector_type(8))) short;
using s16x4  = __attribute__((ext_vector_type(4))) short;
using f32x16 = __attribute__((ext_vector_type(16))) float;
using f32x8  = __attribute__((ext_vector_type(8))) float;
using u32x4  = __attribute__((ext_vector_type(4))) unsigned;
#define KSWZ(row, colB) ((row) * 256 + ((colB) ^ (((row) & 7) << 4)))
#define SBAR() __builtin_amdgcn_sched_barrier(0)
__device__ __forceinline__ int crow(int r, int hi) { return (r & 3) + 8 * (r >> 2) + 4 * hi; }
__device__ __forceinline__ unsigned cvtpk(float lo, float hi) {
  unsigned r; asm volatile("v_cvt_pk_bf16_f32 %0, %1, %2" : "=v"(r) : "v"(lo), "v"(hi)); return r;
}
template <typename TIn> struct Stage;
template <> struct Stage<bf16>  { using T = bf16x8;
  __device__ static __forceinline__ T ld8(const bf16* p) { return *reinterpret_cast<const bf16x8*>(p); }
  __device__ static __forceinline__ bf16x8 tobf(T x) { return x; } };
template <> struct Stage<float> { using T = f32x8;
  __device__ static __forceinline__ T ld8(const float* p) { return *reinterpret_cast<const f32x8*>(p); }
  __device__ static __forceinline__ bf16x8 tobf(T x) {
    u32x4 w = {cvtpk(x[0], x[1]), cvtpk(x[2], x[3]), cvtpk(x[4], x[5]), cvtpk(x[6], x[7])}; return *reinterpret_cast<bf16x8*>(&w); } };

__device__ __forceinline__ void partialSM(f32x16& p0, f32x16& p1, float& m_reg, float& mn, float& alpha) {
  constexpr float C = SCALE * 1.4426950408889634f;
  float pmax = p0[0]; for (int r = 1; r < 16; ++r) pmax = fmaxf(pmax, p0[r]); for (int r = 0; r < 16; ++r) pmax = fmaxf(pmax, p1[r]);
  { auto rr = __builtin_amdgcn_permlane32_swap(__float_as_uint(pmax), __float_as_uint(pmax), false, false);
    pmax = fmaxf(__uint_as_float(rr[0]), __uint_as_float(rr[1])); }
  if (__builtin_expect(__all(pmax - m_reg <= THR / SCALE), 1)) { mn = m_reg; alpha = 1.f; }
  else { mn = fmaxf(m_reg, pmax); alpha = __builtin_amdgcn_exp2f((m_reg - mn) * C); m_reg = mn; }
  float mnC = -mn * C;
  for (int r = 0; r < 16; ++r) p0[r] = fmaf(p0[r], C, mnC); for (int r = 0; r < 16; ++r) p1[r] = fmaf(p1[r], C, mnC);
  for (int r = 0; r < 16; ++r) p0[r] = __builtin_amdgcn_exp2f(p0[r]);
}
__device__ __forceinline__ void finishSM(f32x16& p0, f32x16& p1, float alpha, float& l_reg, bf16x8& pa0, bf16x8& pa1, bf16x8& pa2, bf16x8& pa3) {
  for (int r = 0; r < 16; ++r) p1[r] = __builtin_amdgcn_exp2f(p1[r]);
  float ps = 0; for (int r = 0; r < 16; ++r) ps += p0[r]; for (int r = 0; r < 16; ++r) ps += p1[r];
  { auto rr = __builtin_amdgcn_permlane32_swap(__float_as_uint(ps), __float_as_uint(ps), false, false);
    ps = __uint_as_float(rr[0]) + __uint_as_float(rr[1]); }
  l_reg = l_reg * alpha + ps;
#define PK4(P, BASE, OUT) do { unsigned a0 = cvtpk(P[BASE + 0], P[BASE + 1]), a1 = cvtpk(P[BASE + 2], P[BASE + 3]);   \
    unsigned b0 = cvtpk(P[BASE + 4], P[BASE + 5]), b1 = cvtpk(P[BASE + 6], P[BASE + 7]);                              \
    auto r0 = __builtin_amdgcn_permlane32_swap(a0, b0, false, false); auto r1 = __builtin_amdgcn_permlane32_swap(a1, b1, false, false); \
    u32x4 w = {r0[0], r1[0], r0[1], r1[1]}; OUT = *reinterpret_cast<bf16x8*>(&w); } while (0)
  PK4(p0, 0, pa0); PK4(p0, 8, pa1); PK4(p1, 0, pa2); PK4(p1, 8, pa3);
#undef PK4
}
__device__ __forceinline__ void qkt(f32x16& p0, f32x16& p1, const bf16* Ks, const bf16x8* qr, int r32, int hi) {
  p0 = f32x16{}; p1 = f32x16{};
  for (int d0 = 0; d0 < 8; ++d0) { int cb = (d0 * 16 + hi * 8) * 2;
    bf16x8 b0 = *reinterpret_cast<const bf16x8*>((const char*)Ks + KSWZ(r32, cb));
    bf16x8 b1 = *reinterpret_cast<const bf16x8*>((const char*)Ks + KSWZ(32 + r32, cb));
    p0 = __builtin_amdgcn_mfma_f32_32x32x16_bf16(b0, qr[d0], p0, 0, 0, 0);
    p1 = __builtin_amdgcn_mfma_f32_32x32x16_bf16(b1, qr[d0], p1, 0, 0, 0); }
}
__device__ __forceinline__ int v_st(int k, int c) { const int kk = (k & ~0xC) | ((k & 4) << 1) | ((k & 8) >> 1); return ((kk >> 3) * 4 + (c >> 5)) * 512 + ((kk & 7) * 32 + (c & 31)) * 2; }
__device__ __forceinline__ int v_rd_base(int lane) { return ((lane & 3) << 3) | (((lane >> 2) & 3) << 6) | (((lane >> 4) & 1) << 5) | (((lane >> 5) & 1) << 8); }
constexpr int v_rd_off(int d0, int ks, int half) { return d0 * 512 + ks * 4096 + half * 2048; }
template <int OFF> __device__ __forceinline__ s16x4 tr_read(int vb) {
  s16x4 r; asm volatile("ds_read_b64_tr_b16 %0, %1 offset:%2" : "=&v"(r) : "v"(vb), "i"(OFF) : "memory"); return r;
}
template <int D0> __device__ __forceinline__ void pv_one(f32x16& od, int vb, bf16x8 pa0, bf16x8 pa1, bf16x8 pa2, bf16x8 pa3) {
  const s16x4 l0 = tr_read<v_rd_off(D0, 0, 0)>(vb), h0 = tr_read<v_rd_off(D0, 0, 1)>(vb), l1 = tr_read<v_rd_off(D0, 1, 0)>(vb), h1 = tr_read<v_rd_off(D0, 1, 1)>(vb);
  const s16x4 l2 = tr_read<v_rd_off(D0, 2, 0)>(vb), h2 = tr_read<v_rd_off(D0, 2, 1)>(vb), l3 = tr_read<v_rd_off(D0, 3, 0)>(vb), h3 = tr_read<v_rd_off(D0, 3, 1)>(vb);
  asm volatile("s_waitcnt lgkmcnt(0)" ::: "memory"); SBAR();
#define PK(L, H) (bf16x8){L[0], L[1], L[2], L[3], H[0], H[1], H[2], H[3]}
  od = __builtin_amdgcn_mfma_f32_32x32x16_bf16(pa0, PK(l0, h0), od, 0, 0, 0);
  od = __builtin_amdgcn_mfma_f32_32x32x16_bf16(pa1, PK(l1, h1), od, 0, 0, 0);
  od = __builtin_amdgcn_mfma_f32_32x32x16_bf16(pa2, PK(l2, h2), od, 0, 0, 0);
  od = __builtin_amdgcn_mfma_f32_32x32x16_bf16(pa3, PK(l3, h3), od, 0, 0, 0);
#undef PK
}
__device__ __forceinline__ void pv_d0(f32x16* o, int vb, bf16x8 pa0, bf16x8 pa1, bf16x8 pa2, bf16x8 pa3) {
  pv_one<0>(o[0], vb, pa0, pa1, pa2, pa3); pv_one<1>(o[1], vb, pa0, pa1, pa2, pa3); pv_one<2>(o[2], vb, pa0, pa1, pa2, pa3); pv_one<3>(o[3], vb, pa0, pa1, pa2, pa3);
}

constexpr int LDQ = 1024, LDK = 128;
constexpr int OS_OFF = (int)SHM_ATTN, OS_WAVE = 32 * 136 * 2;
__device__ __forceinline__ void attn_unit(const bf16* __restrict__ Qb, const bf16* __restrict__ Kh, const bf16* __restrict__ Vh,
                                          const unsigned short* __restrict__ GAb, const unsigned short* __restrict__ RTb, unsigned short* __restrict__ MIXb,
                                          const float* __restrict__ qg, const float* __restrict__ ROPE, int s_base, int seq, char* lds) {
  using St = Stage<bf16>;
  int tid_o = threadIdx.x; asm volatile("" : "+v"(tid_o));
  const int tid = tid_o, wid = tid >> 6, lane = tid & 63, r32 = lane & 31, hi = lane >> 5;
  bf16* V_lds = (bf16*)lds; bf16* K_lds = (bf16*)(lds + 2 * SHM_V);
  float* ws = (float*)(lds + 2 * SHM_V + 2 * SHM_K) + wid * 64; float* li_l = ws; float* al_l = ws + 32;
  float m_reg = -1e30f, l_reg = 0; f32x16 o[4] = {}; bf16x8 qr[8];
  {
    const bf16* Qw = Qb + (long)(wid * QBLK + r32) * LDQ + hi * 8;
    float xf[8][8]; float ss = 0.f;
#pragma unroll
    for (int d0 = 0; d0 < 8; ++d0) { const bf16x8 raw = *reinterpret_cast<const bf16x8*>(Qw + d0 * 16);
#pragma unroll
      for (int e = 0; e < 8; ++e) { xf[d0][e] = __uint_as_float((unsigned)(unsigned short)raw[e] << 16); ss += xf[d0][e] * xf[d0][e]; } }
    ss += __shfl_xor(ss, 32);
    const float rstd = __builtin_amdgcn_rsqf(ss * (1.f / 128.f) + 1e-6f);
#pragma unroll
    for (int d0 = 0; d0 < 8; ++d0) { const float4 g0 = *reinterpret_cast<const float4*>(qg + d0 * 16 + hi * 8), g1 = *reinterpret_cast<const float4*>(qg + d0 * 16 + hi * 8 + 4);
      xf[d0][0] *= rstd * g0.x; xf[d0][1] *= rstd * g0.y; xf[d0][2] *= rstd * g0.z; xf[d0][3] *= rstd * g0.w;
      xf[d0][4] *= rstd * g1.x; xf[d0][5] *= rstd * g1.y; xf[d0][6] *= rstd * g1.z; xf[d0][7] *= rstd * g1.w; }
    const int s = s_base + wid * QBLK + r32;
#pragma unroll
    for (int ax = 0; ax < 2; ++ax) { const int pos = ax ? (s & 63) : (s >> 6);
#pragma unroll
      for (int dd = 0; dd < 2; ++dd) { const float4* cs = reinterpret_cast<const float4*>(ROPE + (pos * 32 + 16 * dd + 8 * hi) * 2); const int d1 = 4 * ax + dd, d2 = d1 + 2;
#pragma unroll
        for (int e2 = 0; e2 < 4; ++e2) { const float4 c4 = cs[e2];
          { const float x1 = xf[d1][2 * e2], x2 = xf[d2][2 * e2]; xf[d1][2 * e2] = x1 * c4.x - x2 * c4.y; xf[d2][2 * e2] = x2 * c4.x + x1 * c4.y; }
          { const float x1 = xf[d1][2 * e2 + 1], x2 = xf[d2][2 * e2 + 1]; xf[d1][2 * e2 + 1] = x1 * c4.z - x2 * c4.w; xf[d2][2 * e2 + 1] = x2 * c4.z + x1 * c4.w; } } } }
#pragma unroll
    for (int d0 = 0; d0 < 8; ++d0) { u32x4 w = {cvtpk(xf[d0][0], xf[d0][1]), cvtpk(xf[d0][2], xf[d0][3]), cvtpk(xf[d0][4], xf[d0][5]), cvtpk(xf[d0][6], xf[d0][7])}; qr[d0] = *reinterpret_cast<bf16x8*>(&w); }
  }
  const int sr = tid >> 4, sc = (tid & 15) * 8, vst0 = v_st(sr, sc), vst1 = v_st(32 + sr, sc);
  const int vb0 = (int)(uintptr_t)V_lds + v_rd_base(lane);
  struct { typename St::T vs0, vs1, ks0, ks1; } sr_[SDEPTH];
#define SLOAD(i, k0) do { sr_[i].vs0 = St::ld8(&Vh[(long)((k0) + sr) * LDK + sc]); sr_[i].vs1 = St::ld8(&Vh[(long)((k0) + 32 + sr) * LDK + sc]); \
    sr_[i].ks0 = St::ld8(&Kh[(long)((k0) + sr) * LDK + sc]); sr_[i].ks1 = St::ld8(&Kh[(long)((k0) + 32 + sr) * LDK + sc]); } while (0)
#define SWRITE(b, i) do { *(bf16x8*)((char*)V_lds + (b) * SHM_V + vst0) = St::tobf(sr_[i].vs0);          \
    *(bf16x8*)((char*)V_lds + (b) * SHM_V + vst1) = St::tobf(sr_[i].vs1); int kc = sc * 2;               \
    *(bf16x8*)((char*)K_lds + (b) * SHM_K + KSWZ(sr, kc)) = St::tobf(sr_[i].ks0);                       \
    *(bf16x8*)((char*)K_lds + (b) * SHM_K + KSWZ(32 + sr, kc)) = St::tobf(sr_[i].ks1); } while (0)
#define SWAIT() do { if constexpr (SDEPTH == 2) asm volatile("s_waitcnt vmcnt(4)" ::: "memory"); else asm volatile("s_waitcnt vmcnt(0)" ::: "memory"); } while (0)
#define RESC(a) do { if (__any((a) < 1.f)) { if (hi == 0) al_l[r32] = (a); asm volatile("s_waitcnt lgkmcnt(0)" ::: "memory"); \
    for (int d = 0; d < 4; ++d) for (int r = 0; r < 16; ++r) o[d][r] *= al_l[crow(r, hi)]; } } while (0)
  f32x16 pA0, pA1, pB0, pB1; float mnA, mnB, alA, alB; bf16x8 pa0, pa1, pa2, pa3; const int NT = seq / KVBLK;
  constexpr int SE = 0, SO = SDEPTH - 1;
  SLOAD(SE, 0); asm volatile("s_waitcnt vmcnt(0)" ::: "memory"); SWRITE(0, SE); __syncthreads();
  qkt(pA0, pA1, K_lds, qr, r32, hi); partialSM(pA0, pA1, m_reg, mnA, alA);
  SLOAD(SO, KVBLK); if constexpr (SDEPTH == 2) { if (2 < NT) SLOAD(SE, 2 * KVBLK); }
  SWAIT(); SWRITE(1, SO); __syncthreads();
  for (int j = 1; j + 1 < NT; j += 2) {
    SBAR(); qkt(pB0, pB1, (bf16*)((char*)K_lds + SHM_K), qr, r32, hi);
    finishSM(pA0, pA1, alA, l_reg, pa0, pa1, pa2, pa3); SBAR();
    SLOAD(SO, (j + SDEPTH) * KVBLK); SBAR();
    pv_d0(o, vb0, pa0, pa1, pa2, pa3); partialSM(pB0, pB1, m_reg, mnB, alB);
    __syncthreads(); SWAIT(); SWRITE(0, SE);
    RESC(alB); __syncthreads();
    SBAR(); qkt(pA0, pA1, K_lds, qr, r32, hi);
    finishSM(pB0, pB1, alB, l_reg, pa0, pa1, pa2, pa3); SBAR();
    if (SDEPTH == 1 || j + 3 < NT) SLOAD(SE, (j + 1 + SDEPTH) * KVBLK); SBAR();
    pv_d0(o, vb0 + (int)SHM_V, pa0, pa1, pa2, pa3); partialSM(pA0, pA1, m_reg, mnA, alA);
    __syncthreads(); SWAIT(); SWRITE(1, SO);
    RESC(alA); __syncthreads();
  }
  SBAR(); qkt(pB0, pB1, (bf16*)((char*)K_lds + SHM_K), qr, r32, hi);
  finishSM(pA0, pA1, alA, l_reg, pa0, pa1, pa2, pa3); SBAR();
  pv_d0(o, vb0, pa0, pa1, pa2, pa3); partialSM(pB0, pB1, m_reg, mnB, alB);
  __syncthreads(); RESC(alB);
  finishSM(pB0, pB1, alB, l_reg, pa0, pa1, pa2, pa3); SBAR();
  pv_d0(o, vb0 + (int)SHM_V, pa0, pa1, pa2, pa3);
  { constexpr float C = SCALE * 1.4426950408889634f; l_reg -= (float)NPADK * __builtin_amdgcn_exp2f(-m_reg * C); }
  int tid_e = tid; asm volatile("" : "+v"(tid_e)); const int lane_e = tid_e & 63, wid_e = tid_e >> 6;
  if (hi == 0) li_l[r32] = l_reg; asm volatile("s_waitcnt lgkmcnt(0)" ::: "memory");
  float rli[16];
#pragma unroll
  for (int r = 0; r < 16; ++r) rli[r] = __builtin_amdgcn_rcpf(li_l[crow(r, hi)]);
  unsigned short* osw = (unsigned short*)(lds + OS_OFF + wid_e * OS_WAVE);
#pragma unroll
  for (int r = 0; r < 16; ++r) { const int orow = crow(r, hi);
#pragma unroll
    for (int d0 = 0; d0 < 4; ++d0) { const float v = o[d0][r] * rli[r]; osw[orow * 136 + d0 * 32 + (lane_e & 31)] = (unsigned short)(cvtpk(v, v) & 0xffffu); } }
  asm volatile("s_waitcnt lgkmcnt(0)" ::: "memory");
#pragma unroll
  for (int k = 0; k < 8; ++k) { const int idx = k * 64 + lane_e, row = idx >> 4, chunk = idx & 15; const long go = (long)(wid_e * QBLK + row) * LDQ + chunk * 8;
    const u32x4 ov = *reinterpret_cast<const u32x4*>(osw + row * 136 + chunk * 8);
    const u32x4 ga = *reinterpret_cast<const u32x4*>(GAb + go), rt = *reinterpret_cast<const u32x4*>(RTb + go);
    u32x4 w;
#define MIX2(O, G, R) cvtpk(__uint_as_float((G) << 16) * __uint_as_float((O) << 16) + __uint_as_float((R) << 16), __uint_as_float((G) & 0xffff0000u) * __uint_as_float((O) & 0xffff0000u) + __uint_as_float((R) & 0xffff0000u))
    w.x = MIX2(ov.x, ga.x, rt.x); w.y = MIX2(ov.y, ga.y, rt.y); w.z = MIX2(ov.z, ga.z, rt.z); w.w = MIX2(ov.w, ga.w, rt.w);
#undef MIX2
    *reinterpret_cast<u32x4*>(MIXb + go) = w; }
  asm volatile("s_waitcnt lgkmcnt(0)" ::: "memory");
  __syncthreads();
#undef SLOAD
#undef SWRITE
#undef SWAIT
#undef RESC
}
#undef KSWZ
#undef SBAR
}

#ifndef MK_N_LAUNCHES
#define MK_N_LAUNCHES 1
#endif
constexpr int N_PHASES = 7;
struct Args { const float* in[17]; float* out; unsigned char* ws; int ph_lo, ph_hi; };

__global__ void __launch_bounds__(512, 2) fwd_mega(Args a) {
    extern __shared__ __attribute__((aligned(16))) unsigned char lds[];
    cg::grid_group grid = cg::this_grid();
    const int G = gridDim.x; const int bx = blockIdx.x; const int vcu = (G % 8 == 0) ? (bx % 8) * (G / 8) + bx / 8 : bx;
    P p; p.x = a.in[0]; p.meta = a.in[1]; p.g1 = a.in[2]; p.w_in = a.in[3]; p.conv_w = a.in[4]; p.conv_b = a.in[5]; p.rg_wa = a.in[6]; p.rg_ba = a.in[7];
    p.rg_wx = a.in[8]; p.rg_bx = a.in[9]; p.rg_lam = a.in[10]; p.qg = a.in[11]; p.kg = a.in[12]; p.w_out = a.in[13]; p.g2 = a.in[14]; p.w_fi = a.in[15]; p.w_fo = a.in[16];
    p.out = a.out; p.ws = a.ws;
    unsigned char* ws = a.ws;
    const int lo = a.ph_lo, hi = a.ph_hi;
#ifndef PH_MASK
#define PH_MASK 127
#endif
#define IN(k) (((PH_MASK >> (k)) & 1) && lo <= (k) && (k) < hi)
#define SEAM(k) do { if (IN(k) && IN((k) + 1)) grid.sync(); } while (0)
    PG8_LAS unsigned char* ldsl = (PG8_LAS unsigned char*)lds;

    if (IN(0)) p0_prologue(p, lds, vcu, G);
    SEAM(0);
    if (IN(1)) {
        pg8::Gemm g{(const bf16_t*)(ws + WS_XN), (const bf16_t*)(ws + WS_WIN), M, NIN, 1024}; pg8::StaticOrder S; S.init(M, NIN, G, bx);
        Epi1 E{(bf16_t*)(ws + WS_Q), (bf16_t*)(ws + WS_KRAW), (bf16_t*)(ws + WS_VF), (bf16_t*)(ws + WS_XR), (bf16_t*)(ws + WS_GG), (bf16_t*)(ws + WS_GA)};
        pg8::gemm_phase<Epi1, pg8::StaticOrder, true, true>(ldsl, g, S, E);
    }
    SEAM(1);
    if (IN(2)) {
        p2_kpass(p, vcu, G);
        __syncthreads();
        for (int it = bx; it < BATCH * 8; it += G) rnn_item(p, lds, it >> 3, it & 7);
    }
    SEAM(2);
    if (IN(3)) {
        for (int i = 0;; ++i) { const int uid = i * G + vcu; if (uid >= BATCH * 2 * 32) break;
            const int pr = uid >> 5, j = uid & 31, b = pr >> 1, kvh = pr & 1, h = kvh * 4 + (j >> 3), qb = j & 7;
            const size_t qoff = ((size_t)b * SEQ + qb * 256) * 1024 + h * 128; const size_t koff = (size_t)(b * 2 + kvh) * SKV * 128;
            att::attn_unit((const att::bf16*)(ws + WS_Q) + qoff, (const att::bf16*)(ws + WS_KF) + koff, (const att::bf16*)(ws + WS_VF) + koff,
                           (const unsigned short*)(ws + WS_GA) + qoff, (const unsigned short*)(ws + WS_RT) + qoff, (unsigned short*)(ws + WS_Q) + qoff,
                           p.qg, (const float*)(ws + WS_ROPE), qb * 256, SKV, (char*)lds);
        }
    }
    SEAM(3);
    if (IN(4)) {
        pg8::Gemm g{(const bf16_t*)(ws + WS_Q), (const bf16_t*)(ws + WS_WOUT), M, 1024, 1024}; pg8::StaticOrder S; S.init(M, 1024, G, bx);
        Epi2 E{p.x, p.out, (bf16_t*)(ws + WS_H1B), (float*)(ws + WS_SS)};
        pg8::gemm_phase<Epi2, pg8::StaticOrder, true, true>(ldsl, g, S, E);
    }
    SEAM(4);
    if (IN(5)) {
        pg8::Gemm g{(const bf16_t*)(ws + WS_H1B), (const bf16_t*)(ws + WS_WFI), M, 2 * DFF, 1024}; pg8::StaticOrder S; S.init(M, 2 * DFF, G, bx);
        Epi3 E{(const float*)(ws + WS_SS), (bf16_t*)(ws + WS_ACT)};
        pg8::gemm_phase<Epi3, pg8::StaticOrder, true, true>(ldsl, g, S, E);
    }
    SEAM(5);
    if (IN(6)) {
        pg8::Gemm g{(const bf16_t*)(ws + WS_ACT), (const bf16_t*)(ws + WS_WFO), M, 1024, DFF}; pg8::StaticOrder S; S.init(M, 1024, G, bx);
        Epi4 E{p.out};
        pg8::gemm_phase<Epi4, pg8::StaticOrder, true, true>(ldsl, g, S, E);
    }
#undef IN
#undef SEAM
}

extern "C" void kernel_launch(void* const* d_in, const int* in_sizes, int n_in, void* d_out, int out_size, void* d_ws, size_t ws_size, hipStream_t stream) {
    static int grid = 0;
    if (grid == 0) {
        if (n_in != 17 || in_sizes[0] != M * DM || out_size != M * DM || ws_size < WS_END) {
            fprintf(stderr, "kernel_launch: shape mismatch n_in %d in0 %d out %d ws %zu (need %zu)\n", n_in, n_in > 0 ? in_sizes[0] : -1, out_size, ws_size, (size_t)WS_END); grid = -1; return; }
        int dev = 0, cus = 0, per_cu = 0;
        if (hipGetDevice(&dev) != hipSuccess || hipDeviceGetAttribute(&cus, hipDeviceAttributeMultiprocessorCount, dev) != hipSuccess) { grid = -1; return; }
        if (hipFuncSetAttribute((const void*)fwd_mega, hipFuncAttributeMaxDynamicSharedMemorySize, LDS_BYTES) != hipSuccess) { fprintf(stderr, "kernel_launch: hipFuncSetAttribute failed\n"); grid = -1; return; }
        if (hipOccupancyMaxActiveBlocksPerMultiprocessor(&per_cu, (const void*)fwd_mega, 512, LDS_BYTES) != hipSuccess || per_cu < 1) { fprintf(stderr, "kernel_launch: occupancy query says %d\n", per_cu); per_cu = 1; }
        (void)hipGetLastError();
        grid = cus * 1;
        fprintf(stderr, "kernel_launch: cus %d per_cu %d grid %d\n", cus, per_cu, grid);
    }
    if (grid < 0) return;
    Args a{};
    for (int i = 0; i < 17; ++i) a.in[i] = (const float*)d_in[i];
    a.out = (float*)d_out; a.ws = (unsigned char*)d_ws;
#if MK_N_LAUNCHES == 1
    a.ph_lo = 0; a.ph_hi = N_PHASES;
    void* args[] = {&a};
    hipError_t e = hipLaunchCooperativeKernel((const void*)fwd_mega, dim3(grid), dim3(512), args, LDS_BYTES, stream);
    if (e != hipSuccess) fprintf(stderr, "kernel_launch: cooperative launch failed: %s (grid %d)\n", hipGetErrorString(e), grid);
#else
    for (int ph = 0; ph < N_PHASES; ++ph) { a.ph_lo = ph; a.ph_hi = ph + 1;
        hipLaunchKernelGGL(fwd_mega, dim3(grid), dim3(512), LDS_BYTES, stream, a);
        const hipError_t le = hipPeekAtLastError(); if (le != hipSuccess) { fprintf(stderr, "kernel_launch: launch %d failed: %s\n", ph, hipGetErrorName(le)); break; } }
#endif
}
```

```cpp
#define MK_N_LAUNCHES 1
#include <hip/hip_runtime.h>
#include <hip/hip_bf16.h>
#include <hip/hip_cooperative_groups.h>
#include <cstdio>
#include <cstdint>
namespace cg = cooperative_groups;
namespace pg8 {
#define PG8_LAS __attribute__((address_space(3)))
typedef unsigned short bf16_t;
typedef short bf16x8 __attribute__((ext_vector_type(8)));
typedef float f32x4 __attribute__((ext_vector_type(4)));
typedef unsigned u32x4 __attribute__((ext_vector_type(4)));
constexpr int BM = 256, BK = 64, HALF = 128, HTB = HALF * BK * 2  , STAGE_BYTES = 8 * HTB, NXCD = 8, WGM = 8;

__host__ __device__ __forceinline__ int lds_byte(int r, int c) { const int st = (r >> 4) * 2 + (c >> 5), rr = r & 15, cc = c & 31, ob = rr * 64 + cc * 2; return st * 1024 + (ob ^ (((ob >> 9) & 1) << 5)); }
__host__ __device__ __forceinline__ void stage_rc(int b, int& R, int& C) { const int st = b / 1024, sb = b % 1024, swz = sb ^ (((sb >> 9) & 1) << 5); R = (st >> 1) * 16 + swz / 64; C = (st & 1) * 32 + (swz % 64) / 2; }
__host__ __device__ __forceinline__ int perm32(int rho) { const int n = rho >> 4, i = rho & 15; return 8 * (i >> 2) + 4 * n + (i & 3); }

struct Unit { int pm, pn; };
struct Gemm { const bf16_t* A; const bf16_t* Bt; int M, N, K; };

struct StaticOrder {
    int nM, nN, nwg, G, c;
    __host__ __device__ void init(int M, int N, int G_, int c_) { nM = M / BM; nN = N / BM; nwg = nM * nN; G = G_; c = c_; }
    __host__ __device__ bool next(int i, Unit& u) const {
        const long L = (long)i * G + c; if (L >= nwg) return false;
        int wgid = (int)L; { const int q = nwg / NXCD, r = nwg % NXCD, xcd = wgid % NXCD, off = wgid / NXCD; wgid = (xcd < r ? xcd * (q + 1) : r * (q + 1) + (xcd - r) * q) + off; }
        const int nig = WGM * nN, gid = wgid / nig, fm = gid * WGM, gsz = (nM - fm) < WGM ? (nM - fm) : WGM;
        u.pm = fm + ((wgid % nig) % gsz); u.pn = (wgid % nig) / gsz; return true;
    }
    __device__ __forceinline__ void a_ready(const Unit&) const {}
    __device__ __forceinline__ void done(const Unit&) const {}
};

__device__ __forceinline__ unsigned cvt_pk_bf16(float lo, float hi) { unsigned r; asm volatile("v_cvt_pk_bf16_f32 %0, %1, %2" : "=v"(r) : "v"(lo), "v"(hi)); return r; }
typedef float f32x2 __attribute__((ext_vector_type(2)));
template <class Epi, class Sched, bool ALIGN_EPI = false, bool SP2 = false>
__device__ __forceinline__ void gemm_phase(PG8_LAS unsigned char* lds, const Gemm g, const Sched& S, const Epi& E) {
    const int tid = threadIdx.x, wid = __builtin_amdgcn_readfirstlane(tid >> 6), lane = tid & 63, wr = wid >> 2, wc = wid & 3, fr = lane & 15, fq = lane >> 4;
    const int K = g.K, nt = K / BK;
    unsigned voffA[2], voffB[2];
#pragma unroll
    for (int i = 0; i < 2; ++i) { int R, C; stage_rc(tid * 16 + i * 8192, R, C); const int Rb = Epi::PERM ? ((R & ~31) + perm32(R & 31)) : R;
        voffA[i] = (unsigned)(R * K + C) * 2u; voffB[i] = (unsigned)(Rb * K + C) * 2u; }
    const size_t kstep = (size_t)(BK * 2);
    const size_t hstep = (size_t)HALF * K * 2;
    const size_t tstep = 2 * hstep;
    const unsigned ldsw = (unsigned)wid * 1024u;
    const int aoff = lds_byte(wr * 64 + fr, fq * 8), boff = lds_byte(wc * 32 + fr, fq * 8);
#define PG8_SA(b, h) (((b) * 2 + (h)) * HTB)
#define PG8_SB(b, h) ((4 + (b) * 2 + (h)) * HTB)
#define PG8_STAGE(bufoff, gbase, voff) do { _Pragma("unroll") for (int _i = 0; _i < 2; ++_i) \
        __builtin_amdgcn_global_load_lds((const unsigned*)((const char*)(gbase) + (voff)[_i]), (PG8_LAS unsigned*)(lds + (bufoff) + ldsw + _i * 8192), 16, 0, 0); } while (0)
#define PG8_LDA(dst, b, h) do { _Pragma("unroll") for (int m = 0; m < 4; ++m) _Pragma("unroll") for (int k = 0; k < 2; ++k) dst[m][k] = *(const PG8_LAS bf16x8*)(lds + PG8_SA(b, h) + aoff + m * 2048 + k * 1024); } while (0)
#define PG8_LDB(dst, b, h) do { _Pragma("unroll") for (int n = 0; n < 2; ++n) _Pragma("unroll") for (int k = 0; k < 2; ++k) dst[n][k] = *(const PG8_LAS bf16x8*)(lds + PG8_SB(b, h) + boff + n * 2048 + k * 1024); } while (0)
#define PG8_MMA(ai, bj, At, Bt) do { __builtin_amdgcn_s_setprio(1); _Pragma("unroll") for (int m = 0; m < 4; ++m) _Pragma("unroll") for (int n = 0; n < 2; ++n) _Pragma("unroll") for (int k = 0; k < 2; ++k) \
        acc[ai][bj][m][n] = __builtin_amdgcn_mfma_f32_16x16x32_bf16(Bt[n][k], At[m][k], acc[ai][bj][m][n], 0, 0, 0); __builtin_amdgcn_s_setprio(0); } while (0)
#define PG8_WAIT_V(n) asm volatile("s_waitcnt vmcnt(" #n ")" ::: "memory")
#define PG8_WAIT_L(n) asm volatile("s_waitcnt lgkmcnt(" #n ")" ::: "memory")
#define PG8_BAR __builtin_amdgcn_s_barrier()
#define PG8_SCHED __builtin_amdgcn_sched_barrier(0)
    Unit cur, nxt; int ui = 0;
    if (!S.next(0, cur)) return;
    f32x4 acc[2][2][4][2];
#pragma unroll
    for (int a = 0; a < 2; ++a)
#pragma unroll
        for (int b = 0; b < 2; ++b)
#pragma unroll
            for (int m = 0; m < 4; ++m)
#pragma unroll
                for (int n = 0; n < 2; ++n) acc[a][b][m][n] = (f32x4){0.f, 0.f, 0.f, 0.f};
    bf16x8 At[4][2], B0[2][2], B1[2][2];
    const char* cA = (const char*)g.A + (size_t)cur.pm * tstep; const char* cB = (const char*)g.Bt + (size_t)cur.pn * tstep;
    S.a_ready(cur);
    if constexpr (SP2) {
        PG8_STAGE(PG8_SB(0, 0), cB, voffB); PG8_STAGE(PG8_SB(0, 1), cB + hstep, voffB); PG8_STAGE(PG8_SA(0, 0), cA, voffA); PG8_STAGE(PG8_SA(0, 1), cA + hstep, voffA);
        if (wr == 1) PG8_BAR;
        PG8_WAIT_V(2); PG8_BAR;
        PG8_STAGE(PG8_SB(1, 0), cB + kstep, voffB); PG8_STAGE(PG8_SA(1, 0), cA + kstep, voffA); PG8_STAGE(PG8_SB(1, 1), cB + hstep + kstep, voffB);
        PG8_WAIT_V(6); PG8_BAR;
    } else {
        PG8_STAGE(PG8_SB(0, 0), cB, voffB); PG8_STAGE(PG8_SA(0, 0), cA, voffA); PG8_STAGE(PG8_SB(0, 1), cB + hstep, voffB); PG8_STAGE(PG8_SA(0, 1), cA + hstep, voffA);
        if (wr == 1) PG8_BAR;
        PG8_WAIT_V(4); PG8_BAR;
        PG8_STAGE(PG8_SB(1, 0), cB + kstep, voffB); PG8_STAGE(PG8_SA(1, 0), cA + kstep, voffA); PG8_STAGE(PG8_SB(1, 1), cB + hstep + kstep, voffB);
        PG8_WAIT_V(6); PG8_BAR;
    }
    for (;;) {
        const bool has_next = S.next(ui + 1, nxt);
        const char* nA = has_next ? (const char*)g.A + (size_t)nxt.pm * tstep : cA; const char* nB = has_next ? (const char*)g.Bt + (size_t)nxt.pn * tstep : cB;
        for (int t = 0; t < nt; t += 2) {
            const bool last = (t == nt - 2);
            const char* a1 = cA + (size_t)(t + 1) * kstep;
            const char* a2 = last ? nA : cA + (size_t)(t + 2) * kstep; const char* b2 = last ? nB : cB + (size_t)(t + 2) * kstep;
            const char* a3 = a2 + kstep; const char* b3 = b2 + kstep;
            if (last && has_next) S.a_ready(nxt);
            if constexpr (SP2) {
            PG8_LDB(B0, 0, 0); PG8_LDB(B1, 0, 1); PG8_SCHED; PG8_LDA(At, 0, 0); PG8_STAGE(PG8_SA(1, 1), a1 + hstep, voffA);
            PG8_WAIT_V(8); PG8_WAIT_L(0); PG8_BAR; PG8_MMA(0, 0, At, B0); PG8_MMA(0, 1, At, B1); PG8_BAR; PG8_SCHED;
            PG8_LDA(At, 0, 1); PG8_STAGE(PG8_SB(0, 0), b2, voffB); PG8_STAGE(PG8_SB(0, 1), b2 + hstep, voffB); PG8_STAGE(PG8_SA(0, 0), a2, voffA);
            PG8_WAIT_V(8); PG8_WAIT_L(0); PG8_BAR; PG8_MMA(1, 0, At, B0); PG8_MMA(1, 1, At, B1); PG8_BAR; PG8_SCHED;
            PG8_LDB(B0, 1, 0); PG8_LDB(B1, 1, 1); PG8_SCHED; PG8_LDA(At, 1, 0); PG8_STAGE(PG8_SA(0, 1), a2 + hstep, voffA);
            PG8_WAIT_V(8); PG8_WAIT_L(0); PG8_BAR; PG8_MMA(0, 0, At, B0); PG8_MMA(0, 1, At, B1); PG8_BAR; PG8_SCHED;
            PG8_LDA(At, 1, 1); PG8_STAGE(PG8_SB(1, 0), b3, voffB); PG8_STAGE(PG8_SB(1, 1), b3 + hstep, voffB); PG8_STAGE(PG8_SA(1, 0), a3, voffA);
            PG8_WAIT_V(8); PG8_WAIT_L(0); PG8_BAR; PG8_MMA(1, 0, At, B0); PG8_MMA(1, 1, At, B1); PG8_BAR; PG8_SCHED;
            } else {
            PG8_LDB(B0, 0, 0); PG8_SCHED; PG8_LDA(At, 0, 0); PG8_STAGE(PG8_SA(1, 1), a1 + hstep, voffA);
            PG8_WAIT_L(8); PG8_BAR; PG8_WAIT_L(0); PG8_MMA(0, 0, At, B0); PG8_BAR; PG8_SCHED;
            PG8_LDB(B1, 0, 1); PG8_STAGE(PG8_SB(0, 0), b2, voffB);
            PG8_BAR; PG8_WAIT_L(0); PG8_MMA(0, 1, At, B1); PG8_BAR;
            PG8_LDA(At, 0, 1); PG8_STAGE(PG8_SA(0, 0), a2, voffA);
            PG8_BAR; PG8_WAIT_L(0); PG8_MMA(1, 0, At, B0); PG8_BAR; PG8_SCHED;
            PG8_STAGE(PG8_SB(0, 1), b2 + hstep, voffB);
            PG8_WAIT_V(6); PG8_BAR; PG8_MMA(1, 1, At, B1); PG8_BAR;
            PG8_LDB(B0, 1, 0); PG8_SCHED; PG8_LDA(At, 1, 0); PG8_STAGE(PG8_SA(0, 1), a2 + hstep, voffA);
            PG8_WAIT_L(8); PG8_BAR; PG8_WAIT_L(0); PG8_MMA(0, 0, At, B0); PG8_BAR; PG8_SCHED;
            PG8_LDB(B1, 1, 1); PG8_STAGE(PG8_SB(1, 0), b3, voffB);
            PG8_BAR; PG8_WAIT_L(0); PG8_MMA(0, 1, At, B1); PG8_BAR;
            PG8_LDA(At, 1, 1); PG8_STAGE(PG8_SA(1, 0), a3, voffA);
            PG8_BAR; PG8_WAIT_L(0); PG8_MMA(1, 0, At, B0); PG8_BAR; PG8_SCHED;
            PG8_STAGE(PG8_SB(1, 1), b3 + hstep, voffB);
            PG8_WAIT_V(6); PG8_BAR; PG8_MMA(1, 1, At, B1); PG8_BAR;
            }
        }
        if constexpr (ALIGN_EPI) { if (wr == 0) PG8_BAR; }
        if constexpr (!Epi::AFTER_DRAIN) { E(acc, cur, wr, wc, fr, fq); S.done(cur); }
        if (!has_next) break;
#pragma unroll
        for (int a = 0; a < 2; ++a)
#pragma unroll
            for (int b = 0; b < 2; ++b)
#pragma unroll
                for (int m = 0; m < 4; ++m)
#pragma unroll
                    for (int n = 0; n < 2; ++n) acc[a][b][m][n] = (f32x4){0.f, 0.f, 0.f, 0.f};
        cur = nxt; cA = nA; cB = nB; ++ui;
        if constexpr (ALIGN_EPI) { if (wr == 1) PG8_BAR; }
    }
    PG8_WAIT_V(0);
    if constexpr (!ALIGN_EPI) { if (wr == 0) PG8_BAR; }
    PG8_BAR;
    if constexpr (Epi::AFTER_DRAIN) { E.fused(acc, cur, wr, wc, fr, fq, lds, wid, lane); S.done(cur); }
#undef PG8_SA
#undef PG8_SB
#undef PG8_STAGE
#undef PG8_LDA
#undef PG8_LDB
#undef PG8_MMA
#undef PG8_WAIT_V
#undef PG8_WAIT_L
#undef PG8_BAR
#undef PG8_SCHED
}
}

constexpr int BATCH = 32, SEQ = 2048, DM = 1024, M = BATCH * SEQ, NMETA = 16, TT = SEQ + NMETA;
constexpr int SKV = 2176, NPAD = SKV - TT;
constexpr int NIN = 5632, DFF = 2816, HD = 128;
constexpr float EPS = 1e-6f;
constexpr size_t MiB = 1u << 20;
constexpr size_t WS_WIN = 2 * MiB, WS_WOUT = 14 * MiB, WS_WFI = 16 * MiB, WS_WFO = 28 * MiB, WS_WG = 34 * MiB, WS_ROPE = 35 * MiB,
                 WS_METAP = 35 * MiB + 65536, WS_XRM = 35 * MiB + 262144, WS_SS = 36 * MiB,
                 WS_XN = 64 * MiB, WS_Q = 192 * MiB, WS_KRAW = 320 * MiB, WS_KF = 352 * MiB, WS_VF = 388 * MiB, WS_XR = 424 * MiB,
                 WS_GG = 552 * MiB, WS_GA = 680 * MiB, WS_HF = 808 * MiB, WS_END = 936 * MiB;
constexpr size_t WS_RT = WS_XN, WS_H1B = WS_XR, WS_ACT = WS_GG;
constexpr int LDS_BYTES = 147456;
#define LAS __attribute__((address_space(3)))
typedef unsigned short bf16_t;
typedef short bf16x8 __attribute__((ext_vector_type(8)));
typedef float f32x4 __attribute__((ext_vector_type(4)));
typedef float f32x2 __attribute__((ext_vector_type(2)));
typedef unsigned u32x4 __attribute__((ext_vector_type(4)));
typedef unsigned u32x2 __attribute__((ext_vector_type(2)));

__device__ __forceinline__ unsigned pk2(float lo, float hi) { unsigned r; asm volatile("v_cvt_pk_bf16_f32 %0, %1, %2" : "=v"(r) : "v"(lo), "v"(hi)); return r; }
__device__ __forceinline__ float bflo(unsigned w) { return __uint_as_float(w << 16); }
__device__ __forceinline__ float bfhi(unsigned w) { return __uint_as_float(w & 0xffff0000u); }
__device__ __forceinline__ float bf1(bf16_t v) { return __uint_as_float((unsigned)v << 16); }
__device__ __forceinline__ float sigm(float x) { return __builtin_amdgcn_rcpf(1.f + __builtin_amdgcn_exp2f(-1.4426950408889634f * x)); }
__device__ __forceinline__ float gelu_t(float x) { const float z = 1.5957691216057308f * (x + 0.044715f * x * x * x); return x * sigm(z); }
__device__ __forceinline__ float wave_sum(float v) {
#pragma unroll
    for (int o = 1; o < 64; o <<= 1) v += __shfl_xor(v, o);
    return v;
}
#define LDS_WAIT() asm volatile("s_waitcnt lgkmcnt(0)" ::: "memory")
#define LBAR() do { asm volatile("s_waitcnt lgkmcnt(0)" ::: "memory"); __builtin_amdgcn_s_barrier(); asm volatile("" ::: "memory"); } while (0)

struct Epi1 {
    static constexpr bool PERM = true, AFTER_DRAIN = false;
    bf16_t *Q, *KRAW, *VF, *XR, *GG, *GA;
    __device__ __forceinline__ void operator()(const pg8::f32x4 (&acc)[2][2][4][2], const pg8::Unit& u, int wr, int wc, int fr, int fq) const {
        const int pn = u.pn; const int row0 = u.pm * 256 + wr * 64 + fr; const int cl = wc * 32 + 8 * fq;
        if (pn >= 10 && pn < 18) {
#pragma unroll
            for (int ai = 0; ai < 2; ++ai)
#pragma unroll
                for (int m = 0; m < 4; ++m) { const size_t row = row0 + ai * 128 + m * 16;
                    float o[8];
#pragma unroll
                    for (int n = 0; n < 2; ++n)
#pragma unroll
                        for (int e = 0; e < 4; ++e) o[n * 4 + e] = gelu_t(acc[ai][0][m][n][e]) * sigm(acc[ai][1][m][n][e]);
                    u32x4 w; w.x = pk2(o[0], o[1]); w.y = pk2(o[2], o[3]); w.z = pk2(o[4], o[5]); w.w = pk2(o[6], o[7]);
                    *(u32x4*)(GG + row * 1024 + (pn - 10) * 128 + cl) = w; }
            return;
        }
        bf16_t* base; int ld, colb; bool sg = false;
        if (pn < 4) { base = Q; ld = 1024; colb = pn * 256; }
        else if (pn == 4) { base = KRAW; ld = 256; colb = 0; }
        else if (pn == 5) { const int b = (u.pm * 256) >> 11, s0 = (u.pm * 256) & 2047;
            base = VF + ((size_t)(b * 2) * SKV + 16 + s0) * 128 - (size_t)(u.pm * 256) * 128; ld = 128; colb = 0; }
        else if (pn < 10) { base = XR; ld = 1024; colb = (pn - 6) * 256; }
        else { base = GA; ld = 1024; colb = (pn - 18) * 256; sg = true; }
        const size_t bjstep = (pn == 5) ? (size_t)SKV * 128 : 128;
#pragma unroll
        for (int ai = 0; ai < 2; ++ai)
#pragma unroll
            for (int m = 0; m < 4; ++m) { const size_t row = row0 + ai * 128 + m * 16;
#pragma unroll
                for (int bj = 0; bj < 2; ++bj) { pg8::f32x4 v0 = acc[ai][bj][m][0], v1 = acc[ai][bj][m][1];
                    if (sg) { v0 = (pg8::f32x4){sigm(v0[0]), sigm(v0[1]), sigm(v0[2]), sigm(v0[3])}; v1 = (pg8::f32x4){sigm(v1[0]), sigm(v1[1]), sigm(v1[2]), sigm(v1[3])}; }
                    u32x4 w; w.x = pk2(v0[0], v0[1]); w.y = pk2(v0[2], v0[3]); w.z = pk2(v1[0], v1[1]); w.w = pk2(v1[2], v1[3]);
                    *(u32x4*)(base + row * ld + colb + bj * bjstep + cl) = w; } }
    }
};
struct Epi2 {
    static constexpr bool PERM = true, AFTER_DRAIN = false;
    const float* X; float* H1; bf16_t* H1B; float* SS;
    __device__ __forceinline__ void operator()(const pg8::f32x4 (&acc)[2][2][4][2], const pg8::Unit& u, int wr, int wc, int fr, int fq) const {
        const int row0 = u.pm * 256 + wr * 64 + fr; const int c0 = u.pn * 256 + wc * 32 + 8 * fq;
#pragma unroll
        for (int ai = 0; ai < 2; ++ai)
#pragma unroll
            for (int m = 0; m < 4; ++m) { const size_t row = row0 + ai * 128 + m * 16; float ss = 0.f;
#pragma unroll
                for (int bj = 0; bj < 2; ++bj) { const size_t off = row * 1024 + c0 + bj * 128;
                    const pg8::f32x4 x0 = *(const pg8::f32x4*)(X + off), x1 = *(const pg8::f32x4*)(X + off + 4);
                    const pg8::f32x4 v0 = acc[ai][bj][m][0] + x0, v1 = acc[ai][bj][m][1] + x1;
                    *(pg8::f32x4*)(H1 + off) = v0; *(pg8::f32x4*)(H1 + off + 4) = v1;
                    u32x4 w; w.x = pk2(v0[0], v0[1]); w.y = pk2(v0[2], v0[3]); w.z = pk2(v1[0], v1[1]); w.w = pk2(v1[2], v1[3]);
                    *(u32x4*)(H1B + off) = w;
                    ss += (v0[0] * v0[0] + v0[1] * v0[1]) + (v0[2] * v0[2] + v0[3] * v0[3]) + (v1[0] * v1[0] + v1[1] * v1[1]) + (v1[2] * v1[2] + v1[3] * v1[3]); }
                ss += __shfl_xor(ss, 16); ss += __shfl_xor(ss, 32);
                if (fq == 0) SS[row * 16 + u.pn * 4 + wc] = ss;
                if (m & 1) asm volatile("" ::: "memory"); }
    }
};
struct Epi3 {
    static constexpr bool PERM = true, AFTER_DRAIN = false;
    const float* SS; bf16_t* ACT;
    __device__ __forceinline__ void operator()(const pg8::f32x4 (&acc)[2][2][4][2], const pg8::Unit& u, int wr, int wc, int fr, int fq) const {
        const int row0 = u.pm * 256 + wr * 64 + fr; const int c0 = u.pn * 128 + wc * 32 + 8 * fq;
#pragma unroll
        for (int ai = 0; ai < 2; ++ai)
#pragma unroll
            for (int m = 0; m < 4; ++m) { const size_t row = row0 + ai * 128 + m * 16;
                const pg8::f32x4* sp = (const pg8::f32x4*)(SS + row * 16); const pg8::f32x4 s0 = sp[0], s1 = sp[1], s2 = sp[2], s3 = sp[3];
                const float tot = ((s0[0] + s0[1]) + (s0[2] + s0[3])) + ((s1[0] + s1[1]) + (s1[2] + s1[3])) + ((s2[0] + s2[1]) + (s2[2] + s2[3])) + ((s3[0] + s3[1]) + (s3[2] + s3[3]));
                const float rstd = __builtin_amdgcn_rsqf(tot * (1.f / 1024.f) + EPS);
                float o[8];
#pragma unroll
                for (int n = 0; n < 2; ++n)
#pragma unroll
                    for (int e = 0; e < 4; ++e) { const float g = acc[ai][0][m][n][e] * rstd, uu = acc[ai][1][m][n][e] * rstd; o[n * 4 + e] = g * sigm(g) * uu; }
                u32x4 w; w.x = pk2(o[0], o[1]); w.y = pk2(o[2], o[3]); w.z = pk2(o[4], o[5]); w.w = pk2(o[6], o[7]);
                *(u32x4*)(ACT + row * DFF + c0) = w; }
    }
};
struct Epi4 {
    static constexpr bool PERM = true, AFTER_DRAIN = false;
    float* H1;
    __device__ __forceinline__ void operator()(const pg8::f32x4 (&acc)[2][2][4][2], const pg8::Unit& u, int wr, int wc, int fr, int fq) const {
        const int row0 = u.pm * 256 + wr * 64 + fr; const int c0 = u.pn * 256 + wc * 32 + 8 * fq;
#pragma unroll
        for (int ai = 0; ai < 2; ++ai)
#pragma unroll
            for (int m = 0; m < 4; ++m) { const size_t row = row0 + ai * 128 + m * 16;
#pragma unroll
                for (int bj = 0; bj < 2; ++bj) { const size_t off = row * 1024 + c0 + bj * 128;
                    const pg8::f32x4 x0 = *(const pg8::f32x4*)(H1 + off), x1 = *(const pg8::f32x4*)(H1 + off + 4);
                    *(pg8::f32x4*)(H1 + off) = acc[ai][bj][m][0] + x0; *(pg8::f32x4*)(H1 + off + 4) = acc[ai][bj][m][1] + x1; }
                if (m & 1) asm volatile("" ::: "memory"); }
    }
};

struct P {
    const float *x, *meta, *g1, *w_in, *conv_w, *conv_b, *rg_wa, *rg_ba, *rg_wx, *rg_bx, *rg_lam, *qg, *kg, *w_out, *g2, *w_fi, *w_fo;
    float* out; unsigned char* ws;
};
__device__ __forceinline__ void tr_item(const float* W, int K, int N, bf16_t* WT, int k0, int n0s, int n0d, const float* ksc, LAS float* scr, int lane) {
#pragma unroll 8
    for (int i = 0; i < 32; ++i) { const int kk = 2 * i + (lane >> 5); float v = W[(size_t)(k0 + kk) * N + n0s + (lane & 31)]; if (ksc) v *= ksc[k0 + kk]; scr[kk * 33 + (lane & 31)] = v; }
    LDS_WAIT(); asm volatile("" ::: "memory");
    const int c = lane & 7;
#pragma unroll
    for (int j = 0; j < 4; ++j) { const int n = (lane >> 3) + 8 * j; const LAS float* s = scr + (8 * c) * 33 + n;
        u32x4 o; o.x = pk2(s[0 * 33], s[1 * 33]); o.y = pk2(s[2 * 33], s[3 * 33]); o.z = pk2(s[4 * 33], s[5 * 33]); o.w = pk2(s[6 * 33], s[7 * 33]);
        *(u32x4*)(WT + (size_t)(n0d + n) * K + k0 + 8 * c) = o; }
    LDS_WAIT(); asm volatile("" ::: "memory");
}
__device__ __forceinline__ int win_src_col(int nd) {
    if (nd < 2560) return nd;
    if (nd < 4608) { const int r = nd - 2560, t = r >> 8, half = (r >> 7) & 1, c = r & 127; return (half ? 4608 : 2560) + 128 * t + c; }
    return 3584 + (nd - 4608);
}
__device__ __forceinline__ void p0_prologue(const P& p, unsigned char* ldsg, int vcu, int G) {
    const int tid = threadIdx.x, lane = tid & 63, wave = tid >> 6;
    unsigned char* ws = p.ws;
    if (blockIdx.x < 192) {
        float* xm = (float*)ldsg;
        float* red = (float*)(ldsg + 65536);
        for (int r = wave * 2; r < wave * 2 + 2; ++r) {
            const f32x4* xr = (const f32x4*)(p.meta + r * 1024) + lane; f32x4 v[4]; float s = 0.f;
#pragma unroll
            for (int j = 0; j < 4; ++j) { v[j] = xr[64 * j]; s += (v[j][0] * v[j][0] + v[j][1] * v[j][1]) + (v[j][2] * v[j][2] + v[j][3] * v[j][3]); }
            const float rstd = __builtin_amdgcn_rsqf(wave_sum(s) * (1.f / 1024.f) + EPS);
#pragma unroll
            for (int j = 0; j < 4; ++j) { const f32x4 g = ((const f32x4*)p.g1)[lane + 64 * j]; ((f32x4*)(xm + r * 1024))[lane + 64 * j] = v[j] * rstd * g; }
        }
        __syncthreads();
        float* METAP = (float*)(ws + WS_METAP); bf16_t* XRM = (bf16_t*)(ws + WS_XRM);
        for (int cgi = blockIdx.x; cgi < 192; cgi += G) {
            const int c = tid & 7, ks = tid >> 3, col = cgi * 8 + c; float acc[16];
#pragma unroll
            for (int r = 0; r < 16; ++r) acc[r] = 0.f;
#pragma unroll 4
            for (int k = ks * 16; k < ks * 16 + 16; ++k) { const float w = p.w_in[(size_t)k * NIN + 1024 + col];
#pragma unroll
                for (int r = 0; r < 16; ++r) acc[r] += xm[r * 1024 + k] * w; }
#pragma unroll
            for (int r = 0; r < 16; ++r) red[(ks * 16 + r) * 8 + c] = acc[r];
            __syncthreads();
            if (tid < 128) { const int r = tid >> 3, c2 = tid & 7; float s = 0.f;
                for (int q = 0; q < 64; ++q) s += red[(q * 16 + r) * 8 + c2];
                const int cc = cgi * 8 + c2; METAP[r * 1536 + cc] = s;
                if (cc >= 512) XRM[r * 1024 + cc - 512] = (bf16_t)(pk2(s, s) & 0xffffu); }
            __syncthreads();
        }
    }
    if (blockIdx.x == (unsigned)(G - 1)) {
        f32x2* ROPE = (f32x2*)(ws + WS_ROPE);
        for (int idx = tid; idx < 2048; idx += 512) { const int pos = idx >> 5, i = idx & 31;
            double invf = 1.0; for (int q = 0; q < i; ++q) invf *= 0.74989420933245582730;
            const double a = (double)pos * invf; const double nq = __builtin_rint(a * 0.63661977236758134308); const double r = (a - nq * 1.57079632679489655800) - nq * 6.123233995736766e-17;
            const double r2 = r * r;
            const double sn = r * (1.0 + r2 * (-1.0 / 6 + r2 * (1.0 / 120 + r2 * (-1.0 / 5040 + r2 * (1.0 / 362880 + r2 * (-1.0 / 39916800 + r2 * (1.0 / 6227020800.0)))))));
            const double cs = 1.0 + r2 * (-0.5 + r2 * (1.0 / 24 + r2 * (-1.0 / 720 + r2 * (1.0 / 40320 + r2 * (-1.0 / 3628800 + r2 * (1.0 / 479001600.0))))));
            const int qd = ((int)nq) & 3; double c, s;
            if (qd == 0) { c = cs; s = sn; } else if (qd == 1) { c = -sn; s = cs; } else if (qd == 2) { c = -cs; s = -sn; } else { c = sn; s = -cs; }
            ROPE[idx] = (f32x2){(float)c, (float)s}; }
    }
    LAS float* scr = (LAS float*)((LAS unsigned char*)ldsg + wave * 16384);
    const int gw = vcu * 8 + wave, NGW = G * 8;
    constexpr int I_IN = 16 * 176, I_OUT = 16 * 32, I_FI = 16 * 176, I_FO = 44 * 32, I_G = 32 * 8;
    constexpr int NITEMS = I_IN + I_OUT + I_FI + I_FO + I_G;
    for (int it = gw; it < NITEMS; it += NGW) {
        int r = it;
        if (r < I_IN) { const int kb = r / 176, nb = r % 176; tr_item(p.w_in, 1024, NIN, (bf16_t*)(ws + WS_WIN), 64 * kb, win_src_col(32 * nb), 32 * nb, nullptr, scr, lane); continue; } r -= I_IN;
        if (r < I_OUT) { const int kb = r / 32, nb = r % 32; tr_item(p.w_out, 1024, 1024, (bf16_t*)(ws + WS_WOUT), 64 * kb, 32 * nb, 32 * nb, nullptr, scr, lane); continue; } r -= I_OUT;
        if (r < I_FI) { const int kb = r / 176, nb = r % 176, nd = 32 * nb, t = nd >> 8, half = (nd >> 7) & 1, c = nd & 127;
            tr_item(p.w_fi, 1024, 2 * DFF, (bf16_t*)(ws + WS_WFI), 64 * kb, (half ? DFF : 0) + 128 * t + c, nd, p.g2, scr, lane); continue; } r -= I_FI;
        if (r < I_FO) { const int kb = r / 32, nb = r % 32; tr_item(p.w_fo, DFF, 1024, (bf16_t*)(ws + WS_WFO), 64 * kb, 32 * nb, 32 * nb, nullptr, scr, lane); continue; } r -= I_FO;
        { const int mi = r >> 3, sub = r & 7, gate = mi >> 4, dir = (mi >> 3) & 1, n = mi & 7, kb = sub >> 2, nb = sub & 3;
          const float* src = (gate ? p.rg_wx : p.rg_wa) + (size_t)(dir * 8 + n) * 16384;
          tr_item(src, 128, 128, (bf16_t*)(ws + WS_WG) + (size_t)((dir * 2 + gate) * 8 + n) * 16384, 64 * kb, 32 * nb, 32 * nb, nullptr, scr, lane); }
    }
    bf16_t* XN = (bf16_t*)(ws + WS_XN);
    f32x4 g[4];
#pragma unroll
    for (int j = 0; j < 4; ++j) g[j] = ((const f32x4*)p.g1)[lane + 64 * j];
    for (int m = gw; m < M; m += NGW) {
        const f32x4* xr = (const f32x4*)(p.x + (size_t)m * 1024) + lane; f32x4 v[4]; float s = 0.f;
#pragma unroll
        for (int j = 0; j < 4; ++j) { v[j] = __builtin_nontemporal_load(xr + 64 * j); s += (v[j][0] * v[j][0] + v[j][1] * v[j][1]) + (v[j][2] * v[j][2] + v[j][3] * v[j][3]); }
        const float rstd = __builtin_amdgcn_rsqf(wave_sum(s) * (1.f / 1024.f) + EPS);
        u32x2* o8 = (u32x2*)(XN + (size_t)m * 1024) + lane;
#pragma unroll
        for (int j = 0; j < 4; ++j) { const f32x4 y = v[j] * rstd * g[j]; o8[64 * j] = (u32x2){pk2(y[0], y[1]), pk2(y[2], y[3])}; }
    }
}

__device__ __forceinline__ void p2_kpass(const P& p, int vcu, int G) {
    unsigned char* ws = p.ws;
    const int tid = threadIdx.x, j = tid & 15;
    const int gidx = vcu * 32 + (tid >> 4), NG = G * 32;
    const bf16_t* KRAW = (const bf16_t*)(ws + WS_KRAW); bf16_t* KF = (bf16_t*)(ws + WS_KF); bf16_t* VF = (bf16_t*)(ws + WS_VF);
    const f32x2* ROPE = (const f32x2*)(ws + WS_ROPE); const float* METAP = (const float*)(ws + WS_METAP);
    float kg[8];
#pragma unroll
    for (int e = 0; e < 8; ++e) kg[e] = p.kg[8 * j + e];
    for (int task = gidx; task < 2 * M; task += NG) {
        const int row = task >> 1, h = task & 1, b = row >> 11, s = row & 2047;
        const u32x4 raw = *(const u32x4*)(KRAW + (size_t)row * 256 + h * 128 + 8 * j);
        float y[8] = {bflo(raw.x), bfhi(raw.x), bflo(raw.y), bfhi(raw.y), bflo(raw.z), bfhi(raw.z), bflo(raw.w), bfhi(raw.w)};
        float ss = 0.f;
#pragma unroll
        for (int e = 0; e < 8; ++e) ss += y[e] * y[e];
        ss += __shfl_xor(ss, 1); ss += __shfl_xor(ss, 2); ss += __shfl_xor(ss, 4); ss += __shfl_xor(ss, 8);
        const float rstd = __builtin_amdgcn_rsqf(ss * (1.f / 128.f) + EPS);
        const int pos = (j >> 3) ? (s & 63) : (s >> 6);
        const f32x4* cs = (const f32x4*)(ROPE + pos * 32 + 8 * (j & 3));
        float o[8];
#pragma unroll
        for (int e2 = 0; e2 < 4; ++e2) { const f32x4 c2 = cs[e2];
#pragma unroll
            for (int q = 0; q < 2; ++q) { const int e = 2 * e2 + q; const float v = y[e] * rstd * kg[e]; const float pr = __shfl_xor(v, 4);
                const float c = c2[2 * q], sn = c2[2 * q + 1]; o[e] = (j & 4) ? (v * c + pr * sn) : (v * c - pr * sn); } }
        u32x4 w; w.x = pk2(o[0], o[1]); w.y = pk2(o[2], o[3]); w.z = pk2(o[4], o[5]); w.w = pk2(o[6], o[7]);
        *(u32x4*)(KF + ((size_t)(b * 2 + h) * SKV + 16 + s) * 128 + 8 * j) = w;
    }
    for (int task = gidx; task < BATCH * 2 * 128; task += NG) {
        const int bh = task >> 7, pp = task & 127, h = bh & 1;
        u32x4 wk = (u32x4){0u, 0u, 0u, 0u}, wv = wk; int prow;
        if (pp < 16) { prow = pp;
            const float* mk = METAP + pp * 1536 + h * 128 + 8 * j; const float* mv = mk + 256;
            float y[8]; float ss = 0.f;
#pragma unroll
            for (int e = 0; e < 8; ++e) { y[e] = mk[e]; ss += y[e] * y[e]; }
            ss += __shfl_xor(ss, 1); ss += __shfl_xor(ss, 2); ss += __shfl_xor(ss, 4); ss += __shfl_xor(ss, 8);
            const float rstd = __builtin_amdgcn_rsqf(ss * (1.f / 128.f) + EPS);
#pragma unroll
            for (int e = 0; e < 8; ++e) y[e] = y[e] * rstd * kg[e];
            wk.x = pk2(y[0], y[1]); wk.y = pk2(y[2], y[3]); wk.z = pk2(y[4], y[5]); wk.w = pk2(y[6], y[7]);
            wv.x = pk2(mv[0], mv[1]); wv.y = pk2(mv[2], mv[3]); wv.z = pk2(mv[4], mv[5]); wv.w = pk2(mv[6], mv[7]);
        } else { prow = TT + (pp - 16); }
        *(u32x4*)(KF + ((size_t)bh * SKV + prow) * 128 + 8 * j) = wk;
        *(u32x4*)(VF + ((size_t)bh * SKV + prow) * 128 + 8 * j) = wv;
    }
}

constexpr int R_XC = 0, R_AS = 17408, R_US = R_AS + 33792, R_SEG = R_US + 33792, R_ST = R_SEG + 4096, R_CW = R_ST + 1024, R_END = R_CW + 2560;
__device__ __forceinline__ bf16x8 rnn_ld_row(const bf16_t* XRb, const bf16_t* XRMn, int pidx, int coff) {
    bf16x8 z = {0, 0, 0, 0, 0, 0, 0, 0};
    if (pidx < 0 || pidx >= TT) return z;
    if (pidx < NMETA) return *(const bf16x8*)(XRMn + pidx * 1024 + coff);
    return *(const bf16x8*)(XRb + (size_t)(pidx - NMETA) * 1024 + coff);
}
__device__ __forceinline__ void rnn_item(const P& p, unsigned char* ldsg, int b, int n) {
    unsigned char* ws = p.ws;
    const int tid = threadIdx.x, lane = tid & 63, w = tid >> 6, fr = lane & 15, fq = lane >> 4;
    bf16_t* XC = (bf16_t*)(ldsg + R_XC); float* AS = (float*)(ldsg + R_AS); float* US = (float*)(ldsg + R_US);
    float* SEG = (float*)(ldsg + R_SEG); float* ST = (float*)(ldsg + R_ST); float* CW = (float*)(ldsg + R_CW);
    const bf16_t* XRb = (const bf16_t*)(ws + WS_XR) + (size_t)b * SEQ * 1024 + 128 * n;
    const bf16_t* XRMn = (const bf16_t*)(ws + WS_XRM) + 128 * n;
    bf16_t* HF = (bf16_t*)(ws + WS_HF) + (size_t)b * SEQ * 1024 + 128 * n;
    const bf16_t* GG = (const bf16_t*)(ws + WS_GG) + (size_t)b * SEQ * 1024 + 128 * n;
    bf16_t* RT = (bf16_t*)(ws + WS_RT) + (size_t)b * SEQ * 1024 + 128 * n;
    const bf16_t* WG = (const bf16_t*)(ws + WS_WG);
    for (int i = tid; i < 640; i += 512) CW[i] = (i < 512) ? p.conv_w[(i >> 7) * 1024 + 128 * n + (i & 127)] : p.conv_b[128 * n + (i - 512)];
    const int tg0 = tid >> 4, coff0 = 8 * (tid & 15);
    for (int dir = 0; dir < 2; ++dir) {
        bf16x8 bfr[2][4];
#pragma unroll
        for (int gate = 0; gate < 2; ++gate)
#pragma unroll
            for (int ks = 0; ks < 4; ++ks) bfr[gate][ks] = *(const bf16x8*)(WG + ((size_t)((dir * 2 + gate) * 8 + n) * 128 + 16 * w + fr) * 128 + 32 * ks + 8 * fq);
        float ba4[4], bx4[4], ls4[4];
#pragma unroll
        for (int r = 0; r < 4; ++r) { const int cgl = dir * 1024 + 128 * n + 16 * w + 4 * fq + r; ba4[r] = p.rg_ba[cgl]; bx4[r] = p.rg_bx[cgl];
            const float lam = p.rg_lam[cgl]; const float y = __builtin_amdgcn_exp2f(-1.4426950408889634f * lam);
            float l1p; if (y < 0.05f) l1p = y * (1.f + y * (-0.5f + y * (1.f / 3 + y * (-0.25f + y * (0.2f + y * (-1.f / 6)))))); else l1p = __logf(1.f + y);
            ls4[r] = -8.f * l1p; }
        if (tid < 128) ST[tid] = 0.f;
        __syncthreads();
        const int nch = dir == 0 ? 33 : 32;
        bf16x8 rows[5];
        { const int ci0 = dir == 0 ? 0 : 32; const int p00 = ci0 == 0 ? -48 : 16 + 64 * (ci0 - 1);
#pragma unroll
          for (int q = 0; q < 5; ++q) rows[q] = rnn_ld_row(XRb, XRMn, p00 + 2 * tg0 - 2 + q, coff0); }
        for (int c = 0; c < nch; ++c) {
            const int ci = dir == 0 ? c : 32 - c; const int p0 = ci == 0 ? -48 : 16 + 64 * (ci - 1);
            int tq = tid; asm volatile("" : "+v"(tq));
            const int lane = tq & 63, w = tq >> 6, fr = lane & 15, fq = lane >> 4, tg = tq >> 4, coff = 8 * (tq & 15), ch = tq & 127, sg = tq >> 7, otok = tq >> 3, ocol = 16 * (tq & 7);
            { float xf[5][8];
#pragma unroll
              for (int q = 0; q < 5; ++q)
#pragma unroll
                  for (int e = 0; e < 8; ++e) xf[q][e] = bf1((bf16_t)rows[q][e]);
              float o0[8], o1[8];
#pragma unroll
              for (int e = 0; e < 8; ++e) { const float w0 = CW[coff + e], w1 = CW[128 + coff + e], w2 = CW[256 + coff + e], w3 = CW[384 + coff + e], cb = CW[512 + coff + e];
                  o0[e] = cb + w0 * xf[0][e] + w1 * xf[1][e] + w2 * xf[2][e] + w3 * xf[3][e];
                  o1[e] = cb + w0 * xf[1][e] + w1 * xf[2][e] + w2 * xf[3][e] + w3 * xf[4][e]; }
              u32x4 a0, a1; a0.x = pk2(o0[0], o0[1]); a0.y = pk2(o0[2], o0[3]); a0.z = pk2(o0[4], o0[5]); a0.w = pk2(o0[6], o0[7]);
              a1.x = pk2(o1[0], o1[1]); a1.y = pk2(o1[2], o1[3]); a1.z = pk2(o1[4], o1[5]); a1.w = pk2(o1[6], o1[7]);
              *(u32x4*)(XC + (2 * tg) * 136 + coff) = a0; *(u32x4*)(XC + (2 * tg + 1) * 136 + coff) = a1; }
            if (c + 1 < nch) { const int cin = dir == 0 ? c + 1 : 32 - (c + 1); const int pn0 = cin == 0 ? -48 : 16 + 64 * (cin - 1);
#pragma unroll
                for (int q = 0; q < 5; ++q) rows[q] = rnn_ld_row(XRb, XRMn, pn0 + 2 * tg - 2 + q, coff); }
            u32x4 hfp[2], ggp[2];
            if (dir == 1) { const size_t ro = (size_t)(p0 - NMETA + otok) * 1024 + ocol;
                hfp[0] = *(const u32x4*)(HF + ro); hfp[1] = *(const u32x4*)(HF + ro + 8); ggp[0] = *(const u32x4*)(GG + ro); ggp[1] = *(const u32x4*)(GG + ro + 8); }
            LBAR();
            f32x4 accA[4], accX[4];
#pragma unroll
            for (int tb = 0; tb < 4; ++tb) { accA[tb] = (f32x4){0.f, 0.f, 0.f, 0.f}; accX[tb] = accA[tb];
#pragma unroll
                for (int ks = 0; ks < 4; ++ks) { const bf16x8 yv = *(const bf16x8*)(XC + (16 * tb + fr) * 136 + 32 * ks + 8 * fq);
                    accA[tb] = __builtin_amdgcn_mfma_f32_16x16x32_bf16(bfr[0][ks], yv, accA[tb], 0, 0, 0);
                    accX[tb] = __builtin_amdgcn_mfma_f32_16x16x32_bf16(bfr[1][ks], yv, accX[tb], 0, 0, 0); } }
#pragma unroll
            for (int tb = 0; tb < 4; ++tb) { const int tok = 16 * tb + fr; const u32x2 xw = *(const u32x2*)(XC + tok * 136 + 16 * w + 4 * fq);
                const float xc4[4] = {bflo(xw.x), bfhi(xw.x), bflo(xw.y), bfhi(xw.y)}; f32x4 av, uv;
#pragma unroll
                for (int r = 0; r < 4; ++r) { const float rr = sigm(accA[tb][r] + ba4[r]), ii = sigm(accX[tb][r] + bx4[r]); const float la = rr * ls4[r];
                    const float a = __builtin_amdgcn_exp2f(1.4426950408889634f * la); const float x2 = 2.f * la;
                    const float om = -x2 * (1.f + x2 * (0.5f + x2 * (1.f / 6 + x2 * (1.f / 24 + x2 * (1.f / 120 + x2 * (1.f / 720))))));
                    av[r] = a; uv[r] = __builtin_amdgcn_sqrtf(fmaxf(om, 0.f)) * ii * xc4[r]; }
                if (p0 + tok < 0) { av = (f32x4){1.f, 1.f, 1.f, 1.f}; uv = (f32x4){0.f, 0.f, 0.f, 0.f}; }
                *(f32x4*)(AS + tok * 132 + 16 * w + 4 * fq) = av; *(f32x4*)(US + tok * 132 + 16 * w + 4 * fq) = uv; }
            LBAR();
            float hl[16], ac[16]; float hh = 0.f, aa = 1.f;
#pragma unroll
            for (int i = 0; i < 16; ++i) { const int t = dir == 0 ? 16 * sg + i : 63 - (16 * sg + i); const float a = AS[t * 132 + ch], u = US[t * 132 + ch]; hh = a * hh + u; aa *= a; hl[i] = hh; ac[i] = aa; }
            SEG[sg * 128 + ch] = aa; SEG[512 + sg * 128 + ch] = hh;
            LBAR();
            float carry = ST[(c & 1) * 128 + ch];
#pragma unroll
            for (int s2 = 0; s2 < 3; ++s2) if (s2 < sg) carry = SEG[s2 * 128 + ch] * carry + SEG[512 + s2 * 128 + ch];
            if (sg == 3) ST[((c + 1) & 1) * 128 + ch] = aa * carry + hh;
            if (ci > 0) {
#pragma unroll
                for (int i = 0; i < 16; ++i) { const int t = dir == 0 ? 16 * sg + i : 63 - (16 * sg + i); AS[t * 132 + ch] = hl[i] + ac[i] * carry; }
                LBAR();
                const size_t ro = (size_t)(p0 - NMETA + otok) * 1024 + ocol; const f32x4* hp = (const f32x4*)(AS + otok * 132 + ocol);
                const f32x4 h0 = hp[0], h1 = hp[1], h2 = hp[2], h3 = hp[3];
                if (dir == 0) {
                    u32x4 o0, o1; o0.x = pk2(h0[0], h0[1]); o0.y = pk2(h0[2], h0[3]); o0.z = pk2(h1[0], h1[1]); o0.w = pk2(h1[2], h1[3]);
                    o1.x = pk2(h2[0], h2[1]); o1.y = pk2(h2[2], h2[3]); o1.z = pk2(h3[0], h3[1]); o1.w = pk2(h3[2], h3[3]);
                    *(u32x4*)(HF + ro) = o0; *(u32x4*)(HF + ro + 8) = o1;
                } else {
#define RT2(H, HA, HB, G) pk2((bflo(H) + (HA)) * bflo(G), (bfhi(H) + (HB)) * bfhi(G))
                    u32x4 o0, o1; o0.x = RT2(hfp[0].x, h0[0], h0[1], ggp[0].x); o0.y = RT2(hfp[0].y, h0[2], h0[3], ggp[0].y); o0.z = RT2(hfp[0].z, h1[0], h1[1], ggp[0].z); o0.w = RT2(hfp[0].w, h1[2], h1[3], ggp[0].w);
                    o1.x = RT2(hfp[1].x, h2[0], h2[1], ggp[1].x); o1.y = RT2(hfp[1].y, h2[2], h2[3], ggp[1].y); o1.z = RT2(hfp[1].z, h3[0], h3[1], ggp[1].z); o1.w = RT2(hfp[1].w, h3[2], h3[3], ggp[1].w);
#undef RT2
                    *(u32x4*)(RT + ro) = o0; *(u32x4*)(RT + ro + 8) = o1;
                }
            }
        }
        __syncthreads();
    }
}

namespace att {
using bf16 = __hip_bfloat16;
constexpr int   D = 128, NW = 8, QBLK = 32, KVBLK = 64;
constexpr float SCALE = 0.088388347648318440f;
constexpr float THR = 8.f;
constexpr int SDEPTH = 2;
constexpr int NPADK = NPAD;
constexpr size_t SHM_V = KVBLK * D * 2, SHM_K = KVBLK * D * 2, SHM_ATTN = 2 * SHM_V + 2 * SHM_K + NW * 64 * 4;
using bf16x8 = __attribute__((ext_vector_type(8))) short;
using s16x4  = __attribute__((ext_vector_type(4))) short;
using f32x16 = __attribute__((ext_vector_type(16))) float;
using f32x8  = __attribute__((ext_vector_type(8))) float;
using u32x4  = __attribute__((ext_vector_type(4))) unsigned;
#define KSWZ(row, colB) ((row) * 256 + ((colB) ^ (((row) & 7) << 4)))
#define SBAR() __builtin_amdgcn_sched_barrier(0)
__device__ __forceinline__ int crow(int r, int hi) { return (r & 3) + 8 * (r >> 2) + 4 * hi; }
__device__ __forceinline__ unsigned cvtpk(float lo, float hi) {
  unsigned r; asm volatile("v_cvt_pk_bf16_f32 %0, %1, %2" : "=v"(r) : "v"(lo), "v"(hi)); return r;
}
template <typename TIn> struct Stage;
template <> struct Stage<bf16>  { using T = bf16x8;
  __device__ static __forceinline__ T ld8(const bf16* p) { return *reinterpret_cast<const bf16x8*>(p); }
  __device__ static __forceinline__ bf16x8 tobf(T x) { return x; } };
template <> struct Stage<float> { using T = f32x8;
  __device__ static __forceinline__ T ld8(const float* p) { return *reinterpret_cast<const f32x8*>(p); }
  __device__ static __forceinline__ bf16x8 tobf(T x) {
    u32x4 w = {cvtpk(x[0], x[1]), cvtpk(x[2], x[3]), cvtpk(x[4], x[5]), cvtpk(x[6], x[7])}; return *reinterpret_cast<bf16x8*>(&w); } };

__device__ __forceinline__ void partialSM(f32x16& p0, f32x16& p1, float& m_reg, float& mn, float& alpha) {
  constexpr float C = SCALE * 1.4426950408889634f;
  float pmax = p0[0]; for (int r = 1; r < 16; ++r) pmax = fmaxf(pmax, p0[r]); for (int r = 0; r < 16; ++r) pmax = fmaxf(pmax, p1[r]);
  { auto rr = __builtin_amdgcn_permlane32_swap(__float_as_uint(pmax), __float_as_uint(pmax), false, false);
    pmax = fmaxf(__uint_as_float(rr[0]), __uint_as_float(rr[1])); }
  if (__builtin_expect(__all(pmax - m_reg <= THR / SCALE), 1)) { mn = m_reg; alpha = 1.f; }
  else { mn = fmaxf(m_reg, pmax); alpha = __builtin_amdgcn_exp2f((m_reg - mn) * C); m_reg = mn; }
  float mnC = -mn * C;
  for (int r = 0; r < 16; ++r) p0[r] = fmaf(p0[r], C, mnC); for (int r = 0; r < 16; ++r) p1[r] = fmaf(p1[r], C, mnC);
  for (int r = 0; r < 16; ++r) p0[r] = __builtin_amdgcn_exp2f(p0[r]);
}
__device__ __forceinline__ void finishSM(f32x16& p0, f32x16& p1, float alpha, float& l_reg, bf16x8& pa0, bf16x8& pa1, bf16x8& pa2, bf16x8& pa3) {
  for (int r = 0; r < 16; ++r) p1[r] = __builtin_amdgcn_exp2f(p1[r]);
  float ps = 0; for (int r = 0; r < 16; ++r) ps += p0[r]; for (int r = 0; r < 16; ++r) ps += p1[r];
  { auto rr = __builtin_amdgcn_permlane32_swap(__float_as_uint(ps), __float_as_uint(ps), false, false);
    ps = __uint_as_float(rr[0]) + __uint_as_float(rr[1]); }
  l_reg = l_reg * alpha + ps;
#define PK4(P, BASE, OUT) do { unsigned a0 = cvtpk(P[BASE + 0], P[BASE + 1]), a1 = cvtpk(P[BASE + 2], P[BASE + 3]);   \
    unsigned b0 = cvtpk(P[BASE + 4], P[BASE + 5]), b1 = cvtpk(P[BASE + 6], P[BASE + 7]);                              \
    auto r0 = __builtin_amdgcn_permlane32_swap(a0, b0, false, false); auto r1 = __builtin_amdgcn_permlane32_swap(a1, b1, false, false); \
    u32x4 w = {r0[0], r1[0], r0[1], r1[1]}; OUT = *reinterpret_cast<bf16x8*>(&w); } while (0)
  PK4(p0, 0, pa0); PK4(p0, 8, pa1); PK4(p1, 0, pa2); PK4(p1, 8, pa3);
#undef PK4
}
__device__ __forceinline__ void qkt(f32x16& p0, f32x16& p1, const bf16* Ks, const bf16x8* qr, int r32, int hi) {
  p0 = f32x16{}; p1 = f32x16{};
  for (int d0 = 0; d0 < 8; ++d0) { int cb = (d0 * 16 + hi * 8) * 2;
    bf16x8 b0 = *reinterpret_cast<const bf16x8*>((const char*)Ks + KSWZ(r32, cb));
    bf16x8 b1 = *reinterpret_cast<const bf16x8*>((const char*)Ks + KSWZ(32 + r32, cb));
    p0 = __builtin_amdgcn_mfma_f32_32x32x16_bf16(b0, qr[d0], p0, 0, 0, 0);
    p1 = __builtin_amdgcn_mfma_f32_32x32x16_bf16(b1, qr[d0], p1, 0, 0, 0); }
}
__device__ __forceinline__ int v_st(int k, int c) { const int kk = (k & ~0xC) | ((k & 4) << 1) | ((k & 8) >> 1); return ((kk >> 3) * 4 + (c >> 5)) * 512 + ((kk & 7) * 32 + (c & 31)) * 2; }
__device__ __forceinline__ int v_rd_base(int lane) { return ((lane & 3) << 3) | (((lane >> 2) & 3) << 6) | (((lane >> 4) & 1) << 5) | (((lane >> 5) & 1) << 8); }
constexpr int v_rd_off(int d0, int ks, int half) { return d0 * 512 + ks * 4096 + half * 2048; }
template <int OFF> __device__ __forceinline__ s16x4 tr_read(int vb) {
  s16x4 r; asm volatile("ds_read_b64_tr_b16 %0, %1 offset:%2" : "=&v"(r) : "v"(vb), "i"(OFF) : "memory"); return r;
}
template <int D0> __device__ __forceinline__ void pv_one(f32x16& od, int vb, bf16x8 pa0, bf16x8 pa1, bf16x8 pa2, bf16x8 pa3) {
  const s16x4 l0 = tr_read<v_rd_off(D0, 0, 0)>(vb), h0 = tr_read<v_rd_off(D0, 0, 1)>(vb), l1 = tr_read<v_rd_off(D0, 1, 0)>(vb), h1 = tr_read<v_rd_off(D0, 1, 1)>(vb);
  const s16x4 l2 = tr_read<v_rd_off(D0, 2, 0)>(vb), h2 = tr_read<v_rd_off(D0, 2, 1)>(vb), l3 = tr_read<v_rd_off(D0, 3, 0)>(vb), h3 = tr_read<v_rd_off(D0, 3, 1)>(vb);
  asm volatile("s_waitcnt lgkmcnt(0)" ::: "memory"); SBAR();
#define PK(L, H) (bf16x8){L[0], L[1], L[2], L[3], H[0], H[1], H[2], H[3]}
  od = __builtin_amdgcn_mfma_f32_32x32x16_bf16(pa0, PK(l0, h0), od, 0, 0, 0);
  od = __builtin_amdgcn_mfma_f32_32x32x16_bf16(pa1, PK(l1, h1), od, 0, 0, 0);
  od = __builtin_amdgcn_mfma_f32_32x32x16_bf16(pa2, PK(l2, h2), od, 0, 0, 0);
  od = __builtin_amdgcn_mfma_f32_32x32x16_bf16(pa3, PK(l3, h3), od, 0, 0, 0);
#undef PK
}
__device__ __forceinline__ void pv_d0(f32x16* o, int vb, bf16x8 pa0, bf16x8 pa1, bf16x8 pa2, bf16x8 pa3) {
  pv_one<0>(o[0], vb, pa0, pa1, pa2, pa3); pv_one<1>(o[1], vb, pa0, pa1, pa2, pa3); pv_one<2>(o[2], vb, pa0, pa1, pa2, pa3); pv_one<3>(o[3], vb, pa0, pa1, pa2, pa3);
}

constexpr int LDQ = 1024, LDK = 128;
constexpr int OS_OFF = (int)SHM_ATTN, OS_WAVE = 32 * 136 * 2;
__device__ __forceinline__ void attn_unit(const bf16* __restrict__ Qb, const bf16* __restrict__ Kh, const bf16* __restrict__ Vh,
                                          const unsigned short* __restrict__ GAb, const unsigned short* __restrict__ RTb, unsigned short* __restrict__ MIXb,
                                          const float* __restrict__ qg, const float* __restrict__ ROPE, int s_base, int seq, char* lds) {
  using St = Stage<bf16>;
  int tid_o = threadIdx.x; asm volatile("" : "+v"(tid_o));
  const int tid = tid_o, wid = tid >> 6, lane = tid & 63, r32 = lane & 31, hi = lane >> 5;
  bf16* V_lds = (bf16*)lds; bf16* K_lds = (bf16*)(lds + 2 * SHM_V);
  float* ws = (float*)(lds + 2 * SHM_V + 2 * SHM_K) + wid * 64; float* li_l = ws; float* al_l = ws + 32;
  float m_reg = -1e30f, l_reg = 0; f32x16 o[4] = {}; bf16x8 qr[8];
  {
    const bf16* Qw = Qb + (long)(wid * QBLK + r32) * LDQ + hi * 8;
    float xf[8][8]; float ss = 0.f;
#pragma unroll
    for (int d0 = 0; d0 < 8; ++d0) { const bf16x8 raw = *reinterpret_cast<const bf16x8*>(Qw + d0 * 16);
#pragma unroll
      for (int e = 0; e < 8; ++e) { xf[d0][e] = __uint_as_float((unsigned)(unsigned short)raw[e] << 16); ss += xf[d0][e] * xf[d0][e]; } }
    ss += __shfl_xor(ss, 32);
    const float rstd = __builtin_amdgcn_rsqf(ss * (1.f / 128.f) + 1e-6f);
#pragma unroll
    for (int d0 = 0; d0 < 8; ++d0) { const float4 g0 = *reinterpret_cast<const float4*>(qg + d0 * 16 + hi * 8), g1 = *reinterpret_cast<const float4*>(qg + d0 * 16 + hi * 8 + 4);
      xf[d0][0] *= rstd * g0.x; xf[d0][1] *= rstd * g0.y; xf[d0][2] *= rstd * g0.z; xf[d0][3] *= rstd * g0.w;
      xf[d0][4] *= rstd * g1.x; xf[d0][5] *= rstd * g1.y; xf[d0][6] *= rstd * g1.z; xf[d0][7] *= rstd * g1.w; }
    const int s = s_base + wid * QBLK + r32;
#pragma unroll
    for (int ax = 0; ax < 2; ++ax) { const int pos = ax ? (s & 63) : (s >> 6);
#pragma unroll
      for (int dd = 0; dd < 2; ++dd) { const float4* cs = reinterpret_cast<const float4*>(ROPE + (pos * 32 + 16 * dd + 8 * hi) * 2); const int d1 = 4 * ax + dd, d2 = d1 + 2;
#pragma unroll
        for (int e2 = 0; e2 < 4; ++e2) { const float4 c4 = cs[e2];
          { const float x1 = xf[d1][2 * e2], x2 = xf[d2][2 * e2]; xf[d1][2 * e2] = x1 * c4.x - x2 * c4.y; xf[d2][2 * e2] = x2 * c4.x + x1 * c4.y; }
          { const float x1 = xf[d1][2 * e2 + 1], x2 = xf[d2][2 * e2 + 1]; xf[d1][2 * e2 + 1] = x1 * c4.z - x2 * c4.w; xf[d2][2 * e2 + 1] = x2 * c4.z + x1 * c4.w; } } } }
#pragma unroll
    for (int d0 = 0; d0 < 8; ++d0) { u32x4 w = {cvtpk(xf[d0][0], xf[d0][1]), cvtpk(xf[d0][2], xf[d0][3]), cvtpk(xf[d0][4], xf[d0][5]), cvtpk(xf[d0][6], xf[d0][7])}; qr[d0] = *reinterpret_cast<bf16x8*>(&w); }
  }
  const int sr = tid >> 4, sc = (tid & 15) * 8, vst0 = v_st(sr, sc), vst1 = v_st(32 + sr, sc);
  const int vb0 = (int)(uintptr_t)V_lds + v_rd_base(lane);
  struct { typename St::T vs0, vs1, ks0, ks1; } sr_[SDEPTH];
#define SLOAD(i, k0) do { sr_[i].vs0 = St::ld8(&Vh[(long)((k0) + sr) * LDK + sc]); sr_[i].vs1 = St::ld8(&Vh[(long)((k0) + 32 + sr) * LDK + sc]); \
    sr_[i].ks0 = St::ld8(&Kh[(long)((k0) + sr) * LDK + sc]); sr_[i].ks1 = St::ld8(&Kh[(long)((k0) + 32 + sr) * LDK + sc]); } while (0)
#define SWRITE(b, i) do { *(bf16x8*)((char*)V_lds + (b) * SHM_V + vst0) = St::tobf(sr_[i].vs0);          \
    *(bf16x8*)((char*)V_lds + (b) * SHM_V + vst1) = St::tobf(sr_[i].vs1); int kc = sc * 2;               \
    *(bf16x8*)((char*)K_lds + (b) * SHM_K + KSWZ(sr, kc)) = St::tobf(sr_[i].ks0);                       \
    *(bf16x8*)((char*)K_lds + (b) * SHM_K + KSWZ(32 + sr, kc)) = St::tobf(sr_[i].ks1); } while (0)
#define SWAIT() do { if constexpr (SDEPTH == 2) asm volatile("s_waitcnt vmcnt(4)" ::: "memory"); else asm volatile("s_waitcnt vmcnt(0)" ::: "memory"); } while (0)
#define RESC(a) do { if (__any((a) < 1.f)) { if (hi == 0) al_l[r32] = (a); asm volatile("s_waitcnt lgkmcnt(0)" ::: "memory"); \
    for (int d = 0; d < 4; ++d) for (int r = 0; r < 16; ++r) o[d][r] *= al_l[crow(r, hi)]; } } while (0)
  f32x16 pA0, pA1, pB0, pB1; float mnA, mnB, alA, alB; bf16x8 pa0, pa1, pa2, pa3; const int NT = seq / KVBLK;
  constexpr int SE = 0, SO = SDEPTH - 1;
  SLOAD(SE, 0); asm volatile("s_waitcnt vmcnt(0)" ::: "memory"); SWRITE(0, SE); __syncthreads();
  qkt(pA0, pA1, K_lds, qr, r32, hi); partialSM(pA0, pA1, m_reg, mnA, alA);
  SLOAD(SO, KVBLK); if constexpr (SDEPTH == 2) { if (2 < NT) SLOAD(SE, 2 * KVBLK); }
  SWAIT(); SWRITE(1, SO); __syncthreads();
  for (int j = 1; j + 1 < NT; j += 2) {
    SBAR(); qkt(pB0, pB1, (bf16*)((char*)K_lds + SHM_K), qr, r32, hi);
    finishSM(pA0, pA1, alA, l_reg, pa0, pa1, pa2, pa3); SBAR();
    SLOAD(SO, (j + SDEPTH) * KVBLK); SBAR();
    pv_d0(o, vb0, pa0, pa1, pa2, pa3); partialSM(pB0, pB1, m_reg, mnB, alB);
    __syncthreads(); SWAIT(); SWRITE(0, SE);
    RESC(alB); __syncthreads();
    SBAR(); qkt(pA0, pA1, K_lds, qr, r32, hi);
    finishSM(pB0, pB1, alB, l_reg, pa0, pa1, pa2, pa3); SBAR();
    if (SDEPTH == 1 || j + 3 < NT) SLOAD(SE, (j + 1 + SDEPTH) * KVBLK); SBAR();
    pv_d0(o, vb0 + (int)SHM_V, pa0, pa1, pa2, pa3); partialSM(pA0, pA1, m_reg, mnA, alA);
    __syncthreads(); SWAIT(); SWRITE(1, SO);
    RESC(alA); __syncthreads();
  }
  SBAR(); qkt(pB0, pB1, (bf16*)((char*)K_lds + SHM_K), qr, r32, hi);
  finishSM(pA0, pA1, alA, l_reg, pa0, pa1, pa2, pa3); SBAR();
  pv_d0(o, vb0, pa0, pa1, pa2, pa3); partialSM(pB0, pB1, m_reg, mnB, alB);
  __syncthreads(); RESC(alB);
  finishSM(pB0, pB1, alB, l_reg, pa0, pa1, pa2, pa3); SBAR();
  pv_d0(o, vb0 + (int)SHM_V, pa0, pa1, pa2, pa3);
  { constexpr float C = SCALE * 1.4426950408889634f; l_reg -= (float)NPADK * __builtin_amdgcn_exp2f(-m_reg * C); }
  int tid_e = tid; asm volatile("" : "+v"(tid_e)); const int lane_e = tid_e & 63, wid_e = tid_e >> 6;
  if (hi == 0) li_l[r32] = l_reg; asm volatile("s_waitcnt lgkmcnt(0)" ::: "memory");
  float rli[16];
#pragma unroll
  for (int r = 0; r < 16; ++r) rli[r] = __builtin_amdgcn_rcpf(li_l[crow(r, hi)]);
  unsigned short* osw = (unsigned short*)(lds + OS_OFF + wid_e * OS_WAVE);
#pragma unroll
  for (int r = 0; r < 16; ++r) { const int orow = crow(r, hi);
#pragma unroll
    for (int d0 = 0; d0 < 4; ++d0) { const float v = o[d0][r] * rli[r]; osw[orow * 136 + d0 * 32 + (lane_e & 31)] = (unsigned short)(cvtpk(v, v) & 0xffffu); } }
  asm volatile("s_waitcnt lgkmcnt(0)" ::: "memory");
#pragma unroll
  for (int k = 0; k < 8; ++k) { const int idx = k * 64 + lane_e, row = idx >> 4, chunk = idx & 15; const long go = (long)(wid_e * QBLK + row) * LDQ + chunk * 8;
    const u32x4 ov = *reinterpret_cast<const u32x4*>(osw + row * 136 + chunk * 8);
    const u32x4 ga = *reinterpret_cast<const u32x4*>(GAb + go), rt = *reinterpret_cast<const u32x4*>(RTb + go);
    u32x4 w;
#define MIX2(O, G, R) cvtpk(__uint_as_float((G) << 16) * __uint_as_float((O) << 16) + __uint_as_float((R) << 16), __uint_as_float((G) & 0xffff0000u) * __uint_as_float((O) & 0xffff0000u) + __uint_as_float((R) & 0xffff0000u))
    w.x = MIX2(ov.x, ga.x, rt.x); w.y = MIX2(ov.y, ga.y, rt.y); w.z = MIX2(ov.z, ga.z, rt.z); w.w = MIX2(ov.w, ga.w, rt.w);
#undef MIX2
    *reinterpret_cast<u32x4*>(MIXb + go) = w; }
  asm volatile("s_waitcnt lgkmcnt(0)" ::: "memory");
  __syncthreads();
#undef SLOAD
#undef SWRITE
#undef SWAIT
#undef RESC
}
#undef KSWZ
#undef SBAR
}

#ifndef MK_N_LAUNCHES
#define MK_N_LAUNCHES 1
#endif
constexpr int N_PHASES = 7;
#ifndef PROBE_PHASE
#define PROBE_PHASE -1
#endif
#define REPS(k)
struct Args { const float* in[17]; float* out; unsigned char* ws; int ph_lo, ph_hi; };

__global__ void __launch_bounds__(512, 2) fwd_mega(Args a) {
    extern __shared__ __attribute__((aligned(16))) unsigned char lds[];
    cg::grid_group grid = cg::this_grid();
    const int G = gridDim.x; const int bx = blockIdx.x; const int vcu = (G % 8 == 0) ? (bx % 8) * (G / 8) + bx / 8 : bx;
    P p; p.x = a.in[0]; p.meta = a.in[1]; p.g1 = a.in[2]; p.w_in = a.in[3]; p.conv_w = a.in[4]; p.conv_b = a.in[5]; p.rg_wa = a.in[6]; p.rg_ba = a.in[7];
    p.rg_wx = a.in[8]; p.rg_bx = a.in[9]; p.rg_lam = a.in[10]; p.qg = a.in[11]; p.kg = a.in[12]; p.w_out = a.in[13]; p.g2 = a.in[14]; p.w_fi = a.in[15]; p.w_fo = a.in[16];
    p.out = a.out; p.ws = a.ws;
    unsigned char* ws = a.ws;
    const int lo = a.ph_lo, hi = a.ph_hi;
#ifndef PH_MASK
#define PH_MASK 127
#endif
#define IN(k) (((PH_MASK >> (k)) & 1) && lo <= (k) && (k) < hi)
#define SEAM(k) do { if (IN(k) && IN((k) + 1)) grid.sync(); } while (0)
    PG8_LAS unsigned char* ldsl = (PG8_LAS unsigned char*)lds;

    if (IN(0)) p0_prologue(p, lds, vcu, G);
    SEAM(0);
    if (IN(1)) REPS(1) {
        pg8::Gemm g{(const bf16_t*)(ws + WS_XN), (const bf16_t*)(ws + WS_WIN), M, NIN, 1024}; pg8::StaticOrder S; S.init(M, NIN, G, bx);
        Epi1 E{(bf16_t*)(ws + WS_Q), (bf16_t*)(ws + WS_KRAW), (bf16_t*)(ws + WS_VF), (bf16_t*)(ws + WS_XR), (bf16_t*)(ws + WS_GG), (bf16_t*)(ws + WS_GA)};
        pg8::gemm_phase<Epi1, pg8::StaticOrder, true, true>(ldsl, g, S, E);
    }
    SEAM(1);
    if (IN(2)) REPS(2) {
        p2_kpass(p, vcu, G);
        __syncthreads();
        for (int it = bx; it < BATCH * 8; it += G) rnn_item(p, lds, it >> 3, it & 7);
    }
    SEAM(2);
    if (IN(3)) {
        for (int i = 0;; ++i) { const int uid = i * G + vcu; if (uid >= BATCH * 2 * 32) break;
            const int pr = uid >> 5, j = uid & 31, b = pr >> 1, kvh = pr & 1, h = kvh * 4 + (j >> 3), qb = j & 7;
            const size_t qoff = ((size_t)b * SEQ + qb * 256) * 1024 + h * 128; const size_t koff = (size_t)(b * 2 + kvh) * SKV * 128;
            att::attn_unit((const att::bf16*)(ws + WS_Q) + qoff, (const att::bf16*)(ws + WS_KF) + koff, (const att::bf16*)(ws + WS_VF) + koff,
                           (const unsigned short*)(ws + WS_GA) + qoff, (const unsigned short*)(ws + WS_RT) + qoff, (unsigned short*)(ws + WS_Q) + qoff,
                           p.qg, (const float*)(ws + WS_ROPE), qb * 256, SKV, (char*)lds);
        }
    }
    SEAM(3);
    if (IN(4)) REPS(4) {
        pg8::Gemm g{(const bf16_t*)(ws + WS_Q), (const bf16_t*)(ws + WS_WOUT), M, 1024, 1024}; pg8::StaticOrder S; S.init(M, 1024, G, bx);
        Epi2 E{p.x, p.out, (bf16_t*)(ws + WS_H1B), (float*)(ws + WS_SS)};
        pg8::gemm_phase<Epi2, pg8::StaticOrder, true, true>(ldsl, g, S, E);
    }
    SEAM(4);
    if (IN(5)) REPS(5) {
        pg8::Gemm g{(const bf16_t*)(ws + WS_H1B), (const bf16_t*)(ws + WS_WFI), M, 2 * DFF, 1024}; pg8::StaticOrder S; S.init(M, 2 * DFF, G, bx);
        Epi3 E{(const float*)(ws + WS_SS), (bf16_t*)(ws + WS_ACT)};
        pg8::gemm_phase<Epi3, pg8::StaticOrder, true, true>(ldsl, g, S, E);
    }
    SEAM(5);
    if (IN(6)) {
        pg8::Gemm g{(const bf16_t*)(ws + WS_ACT), (const bf16_t*)(ws + WS_WFO), M, 1024, DFF}; pg8::StaticOrder S; S.init(M, 1024, G, bx);
        Epi4 E{p.out};
        pg8::gemm_phase<Epi4, pg8::StaticOrder, true, true>(ldsl, g, S, E);
    }
#undef IN
#undef SEAM
}

extern "C" void kernel_launch(void* const* d_in, const int* in_sizes, int n_in, void* d_out, int out_size, void* d_ws, size_t ws_size, hipStream_t stream) {
    static int grid = 0;
    if (grid == 0) {
        if (n_in != 17 || in_sizes[0] != M * DM || out_size != M * DM || ws_size < WS_END) {
            fprintf(stderr, "kernel_launch: shape mismatch n_in %d in0 %d out %d ws %zu (need %zu)\n", n_in, n_in > 0 ? in_sizes[0] : -1, out_size, ws_size, (size_t)WS_END); grid = -1; return; }
        int dev = 0, cus = 0, per_cu = 0;
        if (hipGetDevice(&dev) != hipSuccess || hipDeviceGetAttribute(&cus, hipDeviceAttributeMultiprocessorCount, dev) != hipSuccess) { grid = -1; return; }
        if (hipFuncSetAttribute((const void*)fwd_mega, hipFuncAttributeMaxDynamicSharedMemorySize, LDS_BYTES) != hipSuccess) { fprintf(stderr, "kernel_launch: hipFuncSetAttribute failed\n"); grid = -1; return; }
        if (hipOccupancyMaxActiveBlocksPerMultiprocessor(&per_cu, (const void*)fwd_mega, 512, LDS_BYTES) != hipSuccess || per_cu < 1) { fprintf(stderr, "kernel_launch: occupancy query says %d\n", per_cu); per_cu = 1; }
        (void)hipGetLastError();
        grid = cus * 1;
        fprintf(stderr, "kernel_launch: cus %d per_cu %d grid %d\n", cus, per_cu, grid);
    }
    if (grid < 0) return;
    Args a{};
    for (int i = 0; i < 17; ++i) a.in[i] = (const float*)d_in[i];
    a.out = (float*)d_out; a.ws = (unsigned char*)d_ws;
#if MK_N_LAUNCHES == 1
    a.ph_lo = 0; a.ph_hi = N_PHASES;
    void* args[] = {&a};
    hipError_t e = hipLaunchCooperativeKernel((const void*)fwd_mega, dim3(grid), dim3(512), args, LDS_BYTES, stream);
    if (e != hipSuccess) fprintf(stderr, "kernel_launch: cooperative launch failed: %s (grid %d)\n", hipGetErrorString(e), grid);
#else
    for (int ph = 0; ph < N_PHASES; ++ph) for (int rep = 0; rep < (ph == PROBE_PHASE ? 2 : 1); ++rep) { a.ph_lo = ph; a.ph_hi = ph + 1;
        hipLaunchKernelGGL(fwd_mega, dim3(grid), dim3(512), LDS_BYTES, stream, a);
        const hipError_t le = hipPeekAtLastError(); if (le != hipSuccess) { fprintf(stderr, "kernel_launch: launch %d failed: %s\n", ph, hipGetErrorName(le)); break; } }
#endif
}
```

```cpp
#define MK_N_LAUNCHES 1
#include <hip/hip_runtime.h>
#include <hip/hip_bf16.h>
#include <hip/hip_cooperative_groups.h>
#include <cstdio>
#include <cstdint>
namespace cg = cooperative_groups;
namespace pg8 {
#define PG8_LAS __attribute__((address_space(3)))
typedef unsigned short bf16_t;
typedef short bf16x8 __attribute__((ext_vector_type(8)));
typedef float f32x4 __attribute__((ext_vector_type(4)));
typedef unsigned u32x4 __attribute__((ext_vector_type(4)));
constexpr int BM = 256, BK = 64, HALF = 128, HTB = HALF * BK * 2  , STAGE_BYTES = 8 * HTB, NXCD = 8, WGM = 8;

__host__ __device__ __forceinline__ int lds_byte(int r, int c) { const int st = (r >> 4) * 2 + (c >> 5), rr = r & 15, cc = c & 31, ob = rr * 64 + cc * 2; return st * 1024 + (ob ^ (((ob >> 9) & 1) << 5)); }
__host__ __device__ __forceinline__ void stage_rc(int b, int& R, int& C) { const int st = b / 1024, sb = b % 1024, swz = sb ^ (((sb >> 9) & 1) << 5); R = (st >> 1) * 16 + swz / 64; C = (st & 1) * 32 + (swz % 64) / 2; }
__host__ __device__ __forceinline__ int perm32(int rho) { const int n = rho >> 4, i = rho & 15; return 8 * (i >> 2) + 4 * n + (i & 3); }

struct Unit { int pm, pn; };
struct Gemm { const bf16_t* A; const bf16_t* Bt; int M, N, K; };

struct StaticOrder {
    int nM, nN, nwg, G, c;
    __host__ __device__ void init(int M, int N, int G_, int c_) { nM = M / BM; nN = N / BM; nwg = nM * nN; G = G_; c = c_; }
    __host__ __device__ bool next(int i, Unit& u) const {
        const long L = (long)i * G + c; if (L >= nwg) return false;
        int wgid = (int)L; { const int q = nwg / NXCD, r = nwg % NXCD, xcd = wgid % NXCD, off = wgid / NXCD; wgid = (xcd < r ? xcd * (q + 1) : r * (q + 1) + (xcd - r) * q) + off; }
        const int nig = WGM * nN, gid = wgid / nig, fm = gid * WGM, gsz = (nM - fm) < WGM ? (nM - fm) : WGM;
        u.pm = fm + ((wgid % nig) % gsz); u.pn = (wgid % nig) / gsz; return true;
    }
    __device__ __forceinline__ void a_ready(const Unit&) const {}
    __device__ __forceinline__ void done(const Unit&) const {}
};

__device__ __forceinline__ unsigned cvt_pk_bf16(float lo, float hi) { unsigned r; asm volatile("v_cvt_pk_bf16_f32 %0, %1, %2" : "=v"(r) : "v"(lo), "v"(hi)); return r; }
typedef float f32x2 __attribute__((ext_vector_type(2)));
template <class Epi, class Sched, bool ALIGN_EPI = false, bool SP2 = false>
__device__ __forceinline__ void gemm_phase(PG8_LAS unsigned char* lds, const Gemm g, const Sched& S, const Epi& E) {
    const int tid = threadIdx.x, wid = __builtin_amdgcn_readfirstlane(tid >> 6), lane = tid & 63, wr = wid >> 2, wc = wid & 3, fr = lane & 15, fq = lane >> 4;
    const int K = g.K, nt = K / BK;
    unsigned voffA[2], voffB[2];
#pragma unroll
    for (int i = 0; i < 2; ++i) { int R, C; stage_rc(tid * 16 + i * 8192, R, C); const int Rb = Epi::PERM ? ((R & ~31) + perm32(R & 31)) : R;
        voffA[i] = (unsigned)(R * K + C) * 2u; voffB[i] = (unsigned)(Rb * K + C) * 2u; }
    const size_t kstep = (size_t)(BK * 2);
    const size_t hstep = (size_t)HALF * K * 2;
    const size_t tstep = 2 * hstep;
    const unsigned ldsw = (unsigned)wid * 1024u;
    const int aoff = lds_byte(wr * 64 + fr, fq * 8), boff = lds_byte(wc * 32 + fr, fq * 8);
#define PG8_SA(b, h) (((b) * 2 + (h)) * HTB)
#define PG8_SB(b, h) ((4 + (b) * 2 + (h)) * HTB)
#define PG8_STAGE(bufoff, gbase, voff) do { _Pragma("unroll") for (int _i = 0; _i < 2; ++_i) \
        __builtin_amdgcn_global_load_lds((const unsigned*)((const char*)(gbase) + (voff)[_i]), (PG8_LAS unsigned*)(lds + (bufoff) + ldsw + _i * 8192), 16, 0, 0); } while (0)
#define PG8_LDA(dst, b, h) do { _Pragma("unroll") for (int m = 0; m < 4; ++m) _Pragma("unroll") for (int k = 0; k < 2; ++k) dst[m][k] = *(const PG8_LAS bf16x8*)(lds + PG8_SA(b, h) + aoff + m * 2048 + k * 1024); } while (0)
#define PG8_LDB(dst, b, h) do { _Pragma("unroll") for (int n = 0; n < 2; ++n) _Pragma("unroll") for (int k = 0; k < 2; ++k) dst[n][k] = *(const PG8_LAS bf16x8*)(lds + PG8_SB(b, h) + boff + n * 2048 + k * 1024); } while (0)
#define PG8_MMA(ai, bj, At, Bt) do { __builtin_amdgcn_s_setprio(1); _Pragma("unroll") for (int m = 0; m < 4; ++m) _Pragma("unroll") for (int n = 0; n < 2; ++n) _Pragma("unroll") for (int k = 0; k < 2; ++k) \
        acc[ai][bj][m][n] = __builtin_amdgcn_mfma_f32_16x16x32_bf16(Bt[n][k], At[m][k], acc[ai][bj][m][n], 0, 0, 0); __builtin_amdgcn_s_setprio(0); } while (0)
#define PG8_WAIT_V(n) asm volatile("s_waitcnt vmcnt(" #n ")" ::: "memory")
#define PG8_WAIT_L(n) asm volatile("s_waitcnt lgkmcnt(" #n ")" ::: "memory")
#define PG8_BAR __builtin_amdgcn_s_barrier()
#define PG8_SCHED __builtin_amdgcn_sched_barrier(0)
    Unit cur, nxt; int ui = 0;
    if (!S.next(0, cur)) return;
    f32x4 acc[2][2][4][2];
#pragma unroll
    for (int a = 0; a < 2; ++a)
#pragma unroll
        for (int b = 0; b < 2; ++b)
#pragma unroll
            for (int m = 0; m < 4; ++m)
#pragma unroll
                for (int n = 0; n < 2; ++n) acc[a][b][m][n] = (f32x4){0.f, 0.f, 0.f, 0.f};
    bf16x8 At[4][2], B0[2][2], B1[2][2];
    const char* cA = (const char*)g.A + (size_t)cur.pm * tstep; const char* cB = (const char*)g.Bt + (size_t)cur.pn * tstep;
    S.a_ready(cur);
    if constexpr (SP2) {
        PG8_STAGE(PG8_SB(0, 0), cB, voffB); PG8_STAGE(PG8_SB(0, 1), cB + hstep, voffB); PG8_STAGE(PG8_SA(0, 0), cA, voffA); PG8_STAGE(PG8_SA(0, 1), cA + hstep, voffA);
        if (wr == 1) PG8_BAR;
        PG8_WAIT_V(2); PG8_BAR;
        PG8_STAGE(PG8_SB(1, 0), cB + kstep, voffB); PG8_STAGE(PG8_SA(1, 0), cA + kstep, voffA); PG8_STAGE(PG8_SB(1, 1), cB + hstep + kstep, voffB);
        PG8_WAIT_V(6); PG8_BAR;
    } else {
        PG8_STAGE(PG8_SB(0, 0), cB, voffB); PG8_STAGE(PG8_SA(0, 0), cA, voffA); PG8_STAGE(PG8_SB(0, 1), cB + hstep, voffB); PG8_STAGE(PG8_SA(0, 1), cA + hstep, voffA);
        if (wr == 1) PG8_BAR;
        PG8_WAIT_V(4); PG8_BAR;
        PG8_STAGE(PG8_SB(1, 0), cB + kstep, voffB); PG8_STAGE(PG8_SA(1, 0), cA + kstep, voffA); PG8_STAGE(PG8_SB(1, 1), cB + hstep + kstep, voffB);
        PG8_WAIT_V(6); PG8_BAR;
    }
    for (;;) {
        const bool has_next = S.next(ui + 1, nxt);
        const char* nA = has_next ? (const char*)g.A + (size_t)nxt.pm * tstep : cA; const char* nB = has_next ? (const char*)g.Bt + (size_t)nxt.pn * tstep : cB;
        for (int t = 0; t < nt; t += 2) {
            const bool last = (t == nt - 2);
            const char* a1 = cA + (size_t)(t + 1) * kstep;
            const char* a2 = last ? nA : cA + (size_t)(t + 2) * kstep; const char* b2 = last ? nB : cB + (size_t)(t + 2) * kstep;
            const char* a3 = a2 + kstep; const char* b3 = b2 + kstep;
            if (last && has_next) S.a_ready(nxt);
            if constexpr (SP2) {
            PG8_LDB(B0, 0, 0); PG8_LDB(B1, 0, 1); PG8_SCHED; PG8_LDA(At, 0, 0); PG8_STAGE(PG8_SA(1, 1), a1 + hstep, voffA);
            PG8_WAIT_V(8); PG8_WAIT_L(0); PG8_BAR; PG8_MMA(0, 0, At, B0); PG8_MMA(0, 1, At, B1); PG8_BAR; PG8_SCHED;
            PG8_LDA(At, 0, 1); PG8_STAGE(PG8_SB(0, 0), b2, voffB); PG8_STAGE(PG8_SB(0, 1), b2 + hstep, voffB); PG8_STAGE(PG8_SA(0, 0), a2, voffA);
            PG8_WAIT_V(8); PG8_WAIT_L(0); PG8_BAR; PG8_MMA(1, 0, At, B0); PG8_MMA(1, 1, At, B1); PG8_BAR; PG8_SCHED;
            PG8_LDB(B0, 1, 0); PG8_LDB(B1, 1, 1); PG8_SCHED; PG8_LDA(At, 1, 0); PG8_STAGE(PG8_SA(0, 1), a2 + hstep, voffA);
            PG8_WAIT_V(8); PG8_WAIT_L(0); PG8_BAR; PG8_MMA(0, 0, At, B0); PG8_MMA(0, 1, At, B1); PG8_BAR; PG8_SCHED;
            PG8_LDA(At, 1, 1); PG8_STAGE(PG8_SB(1, 0), b3, voffB); PG8_STAGE(PG8_SB(1, 1), b3 + hstep, voffB); PG8_STAGE(PG8_SA(1, 0), a3, voffA);
            PG8_WAIT_V(8); PG8_WAIT_L(0); PG8_BAR; PG8_MMA(1, 0, At, B0); PG8_MMA(1, 1, At, B1); PG8_BAR; PG8_SCHED;
            } else {
            PG8_LDB(B0, 0, 0); PG8_SCHED; PG8_LDA(At, 0, 0); PG8_STAGE(PG8_SA(1, 1), a1 + hstep, voffA);
            PG8_WAIT_L(8); PG8_BAR; PG8_WAIT_L(0); PG8_MMA(0, 0, At, B0); PG8_BAR; PG8_SCHED;
            PG8_LDB(B1, 0, 1); PG8_STAGE(PG8_SB(0, 0), b2, voffB);
            PG8_BAR; PG8_WAIT_L(0); PG8_MMA(0, 1, At, B1); PG8_BAR;
            PG8_LDA(At, 0, 1); PG8_STAGE(PG8_SA(0, 0), a2, voffA);
            PG8_BAR; PG8_WAIT_L(0); PG8_MMA(1, 0, At, B0); PG8_BAR; PG8_SCHED;
            PG8_STAGE(PG8_SB(0, 1), b2 + hstep, voffB);
            PG8_WAIT_V(6); PG8_BAR; PG8_MMA(1, 1, At, B1); PG8_BAR;
            PG8_LDB(B0, 1, 0); PG8_SCHED; PG8_LDA(At, 1, 0); PG8_STAGE(PG8_SA(0, 1), a2 + hstep, voffA);
            PG8_WAIT_L(8); PG8_BAR; PG8_WAIT_L(0); PG8_MMA(0, 0, At, B0); PG8_BAR; PG8_SCHED;
            PG8_LDB(B1, 1, 1); PG8_STAGE(PG8_SB(1, 0), b3, voffB);
            PG8_BAR; PG8_WAIT_L(0); PG8_MMA(0, 1, At, B1); PG8_BAR;
            PG8_LDA(At, 1, 1); PG8_STAGE(PG8_SA(1, 0), a3, voffA);
            PG8_BAR; PG8_WAIT_L(0); PG8_MMA(1, 0, At, B0); PG8_BAR; PG8_SCHED;
            PG8_STAGE(PG8_SB(1, 1), b3 + hstep, voffB);
            PG8_WAIT_V(6); PG8_BAR; PG8_MMA(1, 1, At, B1); PG8_BAR;
            }
        }
        if constexpr (ALIGN_EPI) { if (wr == 0) PG8_BAR; }
        if constexpr (!Epi::AFTER_DRAIN) { E(acc, cur, wr, wc, fr, fq); S.done(cur); }
        if (!has_next) break;
#pragma unroll
        for (int a = 0; a < 2; ++a)
#pragma unroll
            for (int b = 0; b < 2; ++b)
#pragma unroll
                for (int m = 0; m < 4; ++m)
#pragma unroll
                    for (int n = 0; n < 2; ++n) acc[a][b][m][n] = (f32x4){0.f, 0.f, 0.f, 0.f};
        cur = nxt; cA = nA; cB = nB; ++ui;
        if constexpr (ALIGN_EPI) { if (wr == 1) PG8_BAR; }
    }
    PG8_WAIT_V(0);
    if constexpr (!ALIGN_EPI) { if (wr == 0) PG8_BAR; }
    PG8_BAR;
    if constexpr (Epi::AFTER_DRAIN) { E.fused(acc, cur, wr, wc, fr, fq, lds, wid, lane); S.done(cur); }
#undef PG8_SA
#undef PG8_SB
#undef PG8_STAGE
#undef PG8_LDA
#undef PG8_LDB
#undef PG8_MMA
#undef PG8_WAIT_V
#undef PG8_WAIT_L
#undef PG8_BAR
#undef PG8_SCHED
}
}

constexpr int BATCH = 32, SEQ = 2048, DM = 1024, M = BATCH * SEQ, NMETA = 16, TT = SEQ + NMETA;
constexpr int SKV = 2176, NPAD = SKV - TT;
constexpr int NIN = 5632, DFF = 2816, HD = 128;
constexpr float EPS = 1e-6f;
constexpr size_t MiB = 1u << 20;
constexpr size_t WS_WIN = 2 * MiB, WS_WOUT = 14 * MiB, WS_WFI = 16 * MiB, WS_WFO = 28 * MiB, WS_WG = 34 * MiB, WS_ROPE = 35 * MiB,
                 WS_METAP = 35 * MiB + 65536, WS_XRM = 35 * MiB + 262144, WS_SS = 36 * MiB,
                 WS_XN = 64 * MiB, WS_Q = 192 * MiB, WS_KRAW = 320 * MiB, WS_KF = 352 * MiB, WS_VF = 388 * MiB, WS_XR = 424 * MiB,
                 WS_GG = 552 * MiB, WS_GA = 680 * MiB, WS_HF = 808 * MiB, WS_END = 936 * MiB;
constexpr size_t WS_RT = WS_XN, WS_H1B = WS_XR, WS_ACT = WS_GG;
constexpr int LDS_BYTES = 147456;
#define LAS __attribute__((address_space(3)))
typedef unsigned short bf16_t;
typedef short bf16x8 __attribute__((ext_vector_type(8)));
typedef float f32x4 __attribute__((ext_vector_type(4)));
typedef float f32x2 __attribute__((ext_vector_type(2)));
typedef unsigned u32x4 __attribute__((ext_vector_type(4)));
typedef unsigned u32x2 __attribute__((ext_vector_type(2)));

__device__ __forceinline__ unsigned pk2(float lo, float hi) { unsigned r; asm volatile("v_cvt_pk_bf16_f32 %0, %1, %2" : "=v"(r) : "v"(lo), "v"(hi)); return r; }
__device__ __forceinline__ float bflo(unsigned w) { return __uint_as_float(w << 16); }
__device__ __forceinline__ float bfhi(unsigned w) { return __uint_as_float(w & 0xffff0000u); }
__device__ __forceinline__ float bf1(bf16_t v) { return __uint_as_float((unsigned)v << 16); }
__device__ __forceinline__ float sigm(float x) { return __builtin_amdgcn_rcpf(1.f + __builtin_amdgcn_exp2f(-1.4426950408889634f * x)); }
__device__ __forceinline__ float gelu_t(float x) { const float z = 1.5957691216057308f * (x + 0.044715f * x * x * x); return x * sigm(z); }
__device__ __forceinline__ float wave_sum(float v) {
#pragma unroll
    for (int o = 1; o < 64; o <<= 1) v += __shfl_xor(v, o);
    return v;
}
#define LDS_WAIT() asm volatile("s_waitcnt lgkmcnt(0)" ::: "memory")
#define LBAR() do { asm volatile("s_waitcnt lgkmcnt(0)" ::: "memory"); __builtin_amdgcn_s_barrier(); asm volatile("" ::: "memory"); } while (0)

struct Epi1 {
    static constexpr bool PERM = true, AFTER_DRAIN = false;
    bf16_t *Q, *KRAW, *VF, *XR, *GG, *GA;
    __device__ __forceinline__ void operator()(const pg8::f32x4 (&acc)[2][2][4][2], const pg8::Unit& u, int wr, int wc, int fr, int fq) const {
        const int pn = u.pn; const int row0 = u.pm * 256 + wr * 64 + fr; const int cl = wc * 32 + 8 * fq;
        if (pn >= 10 && pn < 18) {
#pragma unroll
            for (int ai = 0; ai < 2; ++ai)
#pragma unroll
                for (int m = 0; m < 4; ++m) { const size_t row = row0 + ai * 128 + m * 16;
                    float o[8];
#pragma unroll
                    for (int n = 0; n < 2; ++n)
#pragma unroll
                        for (int e = 0; e < 4; ++e) { const float x = acc[ai][0][m][n][e], y = acc[ai][1][m][n][e]; const float ez = __builtin_amdgcn_exp2f(x * fmaf(x * x, -0.10294324f, -2.3022082f)), ey = __builtin_amdgcn_exp2f(-1.4426950408889634f * y);
                            o[n * 4 + e] = x * __builtin_amdgcn_rcpf((1.f + ez) * (1.f + ey)); }
                    u32x4 w; w.x = pk2(o[0], o[1]); w.y = pk2(o[2], o[3]); w.z = pk2(o[4], o[5]); w.w = pk2(o[6], o[7]);
                    *(u32x4*)(GG + row * 1024 + (pn - 10) * 128 + cl) = w; }
            return;
        }
        bf16_t* base; int ld, colb; bool sg = false;
        if (pn < 4) { base = Q; ld = 1024; colb = pn * 256; }
        else if (pn == 4) { base = KRAW; ld = 256; colb = 0; }
        else if (pn == 5) { const int b = (u.pm * 256) >> 11, s0 = (u.pm * 256) & 2047;
            base = VF + ((size_t)(b * 2) * SKV + 16 + s0) * 128 - (size_t)(u.pm * 256) * 128; ld = 128; colb = 0; }
        else if (pn < 10) { base = XR; ld = 1024; colb = (pn - 6) * 256; }
        else { base = GA; ld = 1024; colb = (pn - 18) * 256; sg = true; }
        const size_t bjstep = (pn == 5) ? (size_t)SKV * 128 : 128;
#pragma unroll
        for (int ai = 0; ai < 2; ++ai)
#pragma unroll
            for (int m = 0; m < 4; ++m) { const size_t row = row0 + ai * 128 + m * 16;
#pragma unroll
                for (int bj = 0; bj < 2; ++bj) { pg8::f32x4 v0 = acc[ai][bj][m][0], v1 = acc[ai][bj][m][1];
                    if (sg) { v0 = (pg8::f32x4){sigm(v0[0]), sigm(v0[1]), sigm(v0[2]), sigm(v0[3])}; v1 = (pg8::f32x4){sigm(v1[0]), sigm(v1[1]), sigm(v1[2]), sigm(v1[3])}; }
                    u32x4 w; w.x = pk2(v0[0], v0[1]); w.y = pk2(v0[2], v0[3]); w.z = pk2(v1[0], v1[1]); w.w = pk2(v1[2], v1[3]);
                    *(u32x4*)(base + row * ld + colb + bj * bjstep + cl) = w; } }
    }
};
struct Epi2 {
    static constexpr bool PERM = true, AFTER_DRAIN = false;
    const float* X; float* H1; bf16_t* H1B; float* SS;
    __device__ __forceinline__ void operator()(const pg8::f32x4 (&acc)[2][2][4][2], const pg8::Unit& u, int wr, int wc, int fr, int fq) const {
        const int row0 = u.pm * 256 + wr * 64 + fr; const int c0 = u.pn * 256 + wc * 32 + 8 * fq;
#pragma unroll
        for (int ai = 0; ai < 2; ++ai)
#pragma unroll
            for (int m = 0; m < 4; ++m) { const size_t row = row0 + ai * 128 + m * 16; float ss = 0.f;
#pragma unroll
                for (int bj = 0; bj < 2; ++bj) { const size_t off = row * 1024 + c0 + bj * 128;
                    const pg8::f32x4 x0 = *(const pg8::f32x4*)(X + off), x1 = *(const pg8::f32x4*)(X + off + 4);
                    const pg8::f32x4 v0 = acc[ai][bj][m][0] + x0, v1 = acc[ai][bj][m][1] + x1;
                    *(pg8::f32x4*)(H1 + off) = v0; *(pg8::f32x4*)(H1 + off + 4) = v1;
                    u32x4 w; w.x = pk2(v0[0], v0[1]); w.y = pk2(v0[2], v0[3]); w.z = pk2(v1[0], v1[1]); w.w = pk2(v1[2], v1[3]);
                    *(u32x4*)(H1B + off) = w;
                    ss += (v0[0] * v0[0] + v0[1] * v0[1]) + (v0[2] * v0[2] + v0[3] * v0[3]) + (v1[0] * v1[0] + v1[1] * v1[1]) + (v1[2] * v1[2] + v1[3] * v1[3]); }
                ss += __shfl_xor(ss, 16); ss += __shfl_xor(ss, 32);
                if (fq == 0) SS[row * 16 + u.pn * 4 + wc] = ss;
                if (m & 1) asm volatile("" ::: "memory"); }
    }
};
struct Epi3 {
    static constexpr bool PERM = true, AFTER_DRAIN = false;
    const float* SS; bf16_t* ACT;
    __device__ __forceinline__ void operator()(const pg8::f32x4 (&acc)[2][2][4][2], const pg8::Unit& u, int wr, int wc, int fr, int fq) const {
        const int row0 = u.pm * 256 + wr * 64 + fr; const int c0 = u.pn * 128 + wc * 32 + 8 * fq;
#pragma unroll
        for (int ai = 0; ai < 2; ++ai)
#pragma unroll
            for (int m = 0; m < 4; ++m) { const size_t row = row0 + ai * 128 + m * 16;
                const pg8::f32x4* sp = (const pg8::f32x4*)(SS + row * 16); const pg8::f32x4 s0 = sp[0], s1 = sp[1], s2 = sp[2], s3 = sp[3];
                const float tot = ((s0[0] + s0[1]) + (s0[2] + s0[3])) + ((s1[0] + s1[1]) + (s1[2] + s1[3])) + ((s2[0] + s2[1]) + (s2[2] + s2[3])) + ((s3[0] + s3[1]) + (s3[2] + s3[3]));
                const float rstd = __builtin_amdgcn_rsqf(tot * (1.f / 1024.f) + EPS);
                float o[8];
#pragma unroll
                for (int n = 0; n < 2; ++n)
#pragma unroll
                    for (int e = 0; e < 4; ++e) { const float g = acc[ai][0][m][n][e] * rstd, uu = acc[ai][1][m][n][e] * rstd; o[n * 4 + e] = g * sigm(g) * uu; }
                u32x4 w; w.x = pk2(o[0], o[1]); w.y = pk2(o[2], o[3]); w.z = pk2(o[4], o[5]); w.w = pk2(o[6], o[7]);
                *(u32x4*)(ACT + row * DFF + c0) = w; }
    }
};
struct Epi4 {
    static constexpr bool PERM = true, AFTER_DRAIN = false;
    float* H1;
    __device__ __forceinline__ void operator()(const pg8::f32x4 (&acc)[2][2][4][2], const pg8::Unit& u, int wr, int wc, int fr, int fq) const {
        const int row0 = u.pm * 256 + wr * 64 + fr; const int c0 = u.pn * 256 + wc * 32 + 8 * fq;
#pragma unroll
        for (int ai = 0; ai < 2; ++ai)
#pragma unroll
            for (int m = 0; m < 4; ++m) { const size_t row = row0 + ai * 128 + m * 16;
#pragma unroll
                for (int bj = 0; bj < 2; ++bj) { const size_t off = row * 1024 + c0 + bj * 128;
                    const pg8::f32x4 x0 = *(const pg8::f32x4*)(H1 + off), x1 = *(const pg8::f32x4*)(H1 + off + 4);
                    *(pg8::f32x4*)(H1 + off) = acc[ai][bj][m][0] + x0; *(pg8::f32x4*)(H1 + off + 4) = acc[ai][bj][m][1] + x1; }
                if (m & 1) asm volatile("" ::: "memory"); }
    }
};

struct P {
    const float *x, *meta, *g1, *w_in, *conv_w, *conv_b, *rg_wa, *rg_ba, *rg_wx, *rg_bx, *rg_lam, *qg, *kg, *w_out, *g2, *w_fi, *w_fo;
    float* out; unsigned char* ws;
};
__device__ __forceinline__ void tr_item(const float* W, int K, int N, bf16_t* WT, int k0, int n0s, int n0d, const float* ksc, LAS float* scr, int lane) {
#pragma unroll 8
    for (int i = 0; i < 32; ++i) { const int kk = 2 * i + (lane >> 5); float v = W[(size_t)(k0 + kk) * N + n0s + (lane & 31)]; if (ksc) v *= ksc[k0 + kk]; scr[kk * 33 + (lane & 31)] = v; }
    LDS_WAIT(); asm volatile("" ::: "memory");
    const int c = lane & 7;
#pragma unroll
    for (int j = 0; j < 4; ++j) { const int n = (lane >> 3) + 8 * j; const LAS float* s = scr + (8 * c) * 33 + n;
        u32x4 o; o.x = pk2(s[0 * 33], s[1 * 33]); o.y = pk2(s[2 * 33], s[3 * 33]); o.z = pk2(s[4 * 33], s[5 * 33]); o.w = pk2(s[6 * 33], s[7 * 33]);
        *(u32x4*)(WT + (size_t)(n0d + n) * K + k0 + 8 * c) = o; }
    LDS_WAIT(); asm volatile("" ::: "memory");
}
__device__ __forceinline__ int win_src_col(int nd) {
    if (nd < 2560) return nd;
    if (nd < 4608) { const int r = nd - 2560, t = r >> 8, half = (r >> 7) & 1, c = r & 127; return (half ? 4608 : 2560) + 128 * t + c; }
    return 3584 + (nd - 4608);
}
__device__ __forceinline__ void p0_prologue(const P& p, unsigned char* ldsg, int vcu, int G) {
    const int tid = threadIdx.x, lane = tid & 63, wave = tid >> 6;
    unsigned char* ws = p.ws;
    if (blockIdx.x < 192) {
        float* xm = (float*)ldsg;
        float* red = (float*)(ldsg + 65536);
        for (int r = wave * 2; r < wave * 2 + 2; ++r) {
            const f32x4* xr = (const f32x4*)(p.meta + r * 1024) + lane; f32x4 v[4]; float s = 0.f;
#pragma unroll
            for (int j = 0; j < 4; ++j) { v[j] = xr[64 * j]; s += (v[j][0] * v[j][0] + v[j][1] * v[j][1]) + (v[j][2] * v[j][2] + v[j][3] * v[j][3]); }
            const float rstd = __builtin_amdgcn_rsqf(wave_sum(s) * (1.f / 1024.f) + EPS);
#pragma unroll
            for (int j = 0; j < 4; ++j) { const f32x4 g = ((const f32x4*)p.g1)[lane + 64 * j]; ((f32x4*)(xm + r * 1024))[lane + 64 * j] = v[j] * rstd * g; }
        }
        __syncthreads();
        float* METAP = (float*)(ws + WS_METAP); bf16_t* XRM = (bf16_t*)(ws + WS_XRM);
        for (int cgi = blockIdx.x; cgi < 192; cgi += G) {
            const int c = tid & 7, ks = tid >> 3, col = cgi * 8 + c; float acc[16];
#pragma unroll
            for (int r = 0; r < 16; ++r) acc[r] = 0.f;
#pragma unroll 4
            for (int k = ks * 16; k < ks * 16 + 16; ++k) { const float w = p.w_in[(size_t)k * NIN + 1024 + col];
#pragma unroll
                for (int r = 0; r < 16; ++r) acc[r] += xm[r * 1024 + k] * w; }
#pragma unroll
            for (int r = 0; r < 16; ++r) red[(ks * 16 + r) * 8 + c] = acc[r];
            __syncthreads();
            if (tid < 128) { const int r = tid >> 3, c2 = tid & 7; float s = 0.f;
                for (int q = 0; q < 64; ++q) s += red[(q * 16 + r) * 8 + c2];
                const int cc = cgi * 8 + c2; METAP[r * 1536 + cc] = s;
                if (cc >= 512) XRM[r * 1024 + cc - 512] = (bf16_t)(pk2(s, s) & 0xffffu); }
            __syncthreads();
        }
    }
    if (blockIdx.x == (unsigned)(G - 1)) {
        f32x2* ROPE = (f32x2*)(ws + WS_ROPE);
        for (int idx = tid; idx < 2048; idx += 512) { const int pos = idx >> 5, i = idx & 31;
            double invf = 1.0; for (int q = 0; q < i; ++q) invf *= 0.74989420933245582730;
            const double a = (double)pos * invf; const double nq = __builtin_rint(a * 0.63661977236758134308); const double r = (a - nq * 1.57079632679489655800) - nq * 6.123233995736766e-17;
            const double r2 = r * r;
            const double sn = r * (1.0 + r2 * (-1.0 / 6 + r2 * (1.0 / 120 + r2 * (-1.0 / 5040 + r2 * (1.0 / 362880 + r2 * (-1.0 / 39916800 + r2 * (1.0 / 6227020800.0)))))));
            const double cs = 1.0 + r2 * (-0.5 + r2 * (1.0 / 24 + r2 * (-1.0 / 720 + r2 * (1.0 / 40320 + r2 * (-1.0 / 3628800 + r2 * (1.0 / 479001600.0))))));
            const int qd = ((int)nq) & 3; double c, s;
            if (qd == 0) { c = cs; s = sn; } else if (qd == 1) { c = -sn; s = cs; } else if (qd == 2) { c = -cs; s = -sn; } else { c = sn; s = -cs; }
            ROPE[idx] = (f32x2){(float)c, (float)s}; }
    }
    LAS float* scr = (LAS float*)((LAS unsigned char*)ldsg + wave * 16384);
    const int gw = vcu * 8 + wave, NGW = G * 8;
    constexpr int I_IN = 16 * 176, I_OUT = 16 * 32, I_FI = 16 * 176, I_FO = 44 * 32, I_G = 32 * 8;
    constexpr int NITEMS = I_IN + I_OUT + I_FI + I_FO + I_G;
    for (int it = gw; it < NITEMS; it += NGW) {
        int r = it;
        if (r < I_IN) { const int kb = r / 176, nb = r % 176; tr_item(p.w_in, 1024, NIN, (bf16_t*)(ws + WS_WIN), 64 * kb, win_src_col(32 * nb), 32 * nb, nullptr, scr, lane); continue; } r -= I_IN;
        if (r < I_OUT) { const int kb = r / 32, nb = r % 32; tr_item(p.w_out, 1024, 1024, (bf16_t*)(ws + WS_WOUT), 64 * kb, 32 * nb, 32 * nb, nullptr, scr, lane); continue; } r -= I_OUT;
        if (r < I_FI) { const int kb = r / 176, nb = r % 176, nd = 32 * nb, t = nd >> 8, half = (nd >> 7) & 1, c = nd & 127;
            tr_item(p.w_fi, 1024, 2 * DFF, (bf16_t*)(ws + WS_WFI), 64 * kb, (half ? DFF : 0) + 128 * t + c, nd, p.g2, scr, lane); continue; } r -= I_FI;
        if (r < I_FO) { const int kb = r / 32, nb = r % 32; tr_item(p.w_fo, DFF, 1024, (bf16_t*)(ws + WS_WFO), 64 * kb, 32 * nb, 32 * nb, nullptr, scr, lane); continue; } r -= I_FO;
        { const int mi = r >> 3, sub = r & 7, gate = mi >> 4, dir = (mi >> 3) & 1, n = mi & 7, kb = sub >> 2, nb = sub & 3;
          const float* src = (gate ? p.rg_wx : p.rg_wa) + (size_t)(dir * 8 + n) * 16384;
          tr_item(src, 128, 128, (bf16_t*)(ws + WS_WG) + (size_t)((dir * 2 + gate) * 8 + n) * 16384, 64 * kb, 32 * nb, 32 * nb, nullptr, scr, lane); }
    }
    bf16_t* XN = (bf16_t*)(ws + WS_XN);
    f32x4 g[4];
#pragma unroll
    for (int j = 0; j < 4; ++j) g[j] = ((const f32x4*)p.g1)[lane + 64 * j];
    for (int m = gw; m < M; m += NGW) {
        const f32x4* xr = (const f32x4*)(p.x + (size_t)m * 1024) + lane; f32x4 v[4]; float s = 0.f;
#pragma unroll
        for (int j = 0; j < 4; ++j) { v[j] = __builtin_nontemporal_load(xr + 64 * j); s += (v[j][0] * v[j][0] + v[j][1] * v[j][1]) + (v[j][2] * v[j][2] + v[j][3] * v[j][3]); }
        const float rstd = __builtin_amdgcn_rsqf(wave_sum(s) * (1.f / 1024.f) + EPS);
        u32x2* o8 = (u32x2*)(XN + (size_t)m * 1024) + lane;
#pragma unroll
        for (int j = 0; j < 4; ++j) { const f32x4 y = v[j] * rstd * g[j]; o8[64 * j] = (u32x2){pk2(y[0], y[1]), pk2(y[2], y[3])}; }
    }
}

__device__ __forceinline__ void p2_kpass(const P& p, int vcu, int G) {
    unsigned char* ws = p.ws;
    const int tid = threadIdx.x, j = tid & 15;
    const int gidx = vcu * 32 + (tid >> 4), NG = G * 32;
    const bf16_t* KRAW = (const bf16_t*)(ws + WS_KRAW); bf16_t* KF = (bf16_t*)(ws + WS_KF); bf16_t* VF = (bf16_t*)(ws + WS_VF);
    const f32x2* ROPE = (const f32x2*)(ws + WS_ROPE); const float* METAP = (const float*)(ws + WS_METAP);
    float kg[8];
#pragma unroll
    for (int e = 0; e < 8; ++e) kg[e] = p.kg[8 * j + e];
    for (int task = gidx; task < 2 * M; task += NG) {
        const int row = task >> 1, h = task & 1, b = row >> 11, s = row & 2047;
        const u32x4 raw = *(const u32x4*)(KRAW + (size_t)row * 256 + h * 128 + 8 * j);
        float y[8] = {bflo(raw.x), bfhi(raw.x), bflo(raw.y), bfhi(raw.y), bflo(raw.z), bfhi(raw.z), bflo(raw.w), bfhi(raw.w)};
        float ss = 0.f;
#pragma unroll
        for (int e = 0; e < 8; ++e) ss += y[e] * y[e];
        ss += __shfl_xor(ss, 1); ss += __shfl_xor(ss, 2); ss += __shfl_xor(ss, 4); ss += __shfl_xor(ss, 8);
        const float rstd = __builtin_amdgcn_rsqf(ss * (1.f / 128.f) + EPS);
        const int pos = (j >> 3) ? (s & 63) : (s >> 6);
        const f32x4* cs = (const f32x4*)(ROPE + pos * 32 + 8 * (j & 3));
        float o[8];
#pragma unroll
        for (int e2 = 0; e2 < 4; ++e2) { const f32x4 c2 = cs[e2];
#pragma unroll
            for (int q = 0; q < 2; ++q) { const int e = 2 * e2 + q; const float v = y[e] * rstd * kg[e]; const float pr = __shfl_xor(v, 4);
                const float c = c2[2 * q], sn = c2[2 * q + 1]; o[e] = (j & 4) ? (v * c + pr * sn) : (v * c - pr * sn); } }
        u32x4 w; w.x = pk2(o[0], o[1]); w.y = pk2(o[2], o[3]); w.z = pk2(o[4], o[5]); w.w = pk2(o[6], o[7]);
        *(u32x4*)(KF + ((size_t)(b * 2 + h) * SKV + 16 + s) * 128 + 8 * j) = w;
    }
    for (int task = gidx; task < BATCH * 2 * 128; task += NG) {
        const int bh = task >> 7, pp = task & 127, h = bh & 1;
        u32x4 wk = (u32x4){0u, 0u, 0u, 0u}, wv = wk; int prow;
        if (pp < 16) { prow = pp;
            const float* mk = METAP + pp * 1536 + h * 128 + 8 * j; const float* mv = mk + 256;
            float y[8]; float ss = 0.f;
#pragma unroll
            for (int e = 0; e < 8; ++e) { y[e] = mk[e]; ss += y[e] * y[e]; }
            ss += __shfl_xor(ss, 1); ss += __shfl_xor(ss, 2); ss += __shfl_xor(ss, 4); ss += __shfl_xor(ss, 8);
            const float rstd = __builtin_amdgcn_rsqf(ss * (1.f / 128.f) + EPS);
#pragma unroll
            for (int e = 0; e < 8; ++e) y[e] = y[e] * rstd * kg[e];
            wk.x = pk2(y[0], y[1]); wk.y = pk2(y[2], y[3]); wk.z = pk2(y[4], y[5]); wk.w = pk2(y[6], y[7]);
            wv.x = pk2(mv[0], mv[1]); wv.y = pk2(mv[2], mv[3]); wv.z = pk2(mv[4], mv[5]); wv.w = pk2(mv[6], mv[7]);
        } else { prow = TT + (pp - 16); }
        *(u32x4*)(KF + ((size_t)bh * SKV + prow) * 128 + 8 * j) = wk;
        *(u32x4*)(VF + ((size_t)bh * SKV + prow) * 128 + 8 * j) = wv;
    }
}

constexpr int R_XC = 0, R_AS = 17408, R_US = R_AS + 33792, R_SEG = R_US + 33792, R_ST = R_SEG + 4096, R_CW = R_ST + 1024, R_END = R_CW + 2560;
__device__ __forceinline__ bf16x8 rnn_ld_row(const bf16_t* XRb, const bf16_t* XRMn, int pidx, int coff) {
    bf16x8 z = {0, 0, 0, 0, 0, 0, 0, 0};
    if (pidx < 0 || pidx >= TT) return z;
    if (pidx < NMETA) return *(const bf16x8*)(XRMn + pidx * 1024 + coff);
    return *(const bf16x8*)(XRb + (size_t)(pidx - NMETA) * 1024 + coff);
}
__device__ __forceinline__ void rnn_item(const P& p, unsigned char* ldsg, int b, int n) {
    unsigned char* ws = p.ws;
    const int tid = threadIdx.x, lane = tid & 63, w = tid >> 6, fr = lane & 15, fq = lane >> 4;
    bf16_t* XC = (bf16_t*)(ldsg + R_XC); float* AS = (float*)(ldsg + R_AS); float* US = (float*)(ldsg + R_US);
    float* SEG = (float*)(ldsg + R_SEG); float* ST = (float*)(ldsg + R_ST); float* CW = (float*)(ldsg + R_CW);
    const bf16_t* XRb = (const bf16_t*)(ws + WS_XR) + (size_t)b * SEQ * 1024 + 128 * n;
    const bf16_t* XRMn = (const bf16_t*)(ws + WS_XRM) + 128 * n;
    bf16_t* HF = (bf16_t*)(ws + WS_HF) + (size_t)b * SEQ * 1024 + 128 * n;
    const bf16_t* GG = (const bf16_t*)(ws + WS_GG) + (size_t)b * SEQ * 1024 + 128 * n;
    bf16_t* RT = (bf16_t*)(ws + WS_RT) + (size_t)b * SEQ * 1024 + 128 * n;
    const bf16_t* WG = (const bf16_t*)(ws + WS_WG);
    for (int i = tid; i < 640; i += 512) CW[i] = (i < 512) ? p.conv_w[(i >> 7) * 1024 + 128 * n + (i & 127)] : p.conv_b[128 * n + (i - 512)];
    const int tg0 = tid >> 4, coff0 = 8 * (tid & 15);
    for (int dir = 0; dir < 2; ++dir) {
        bf16x8 bfr[2][4];
#pragma unroll
        for (int gate = 0; gate < 2; ++gate)
#pragma unroll
            for (int ks = 0; ks < 4; ++ks) bfr[gate][ks] = *(const bf16x8*)(WG + ((size_t)((dir * 2 + gate) * 8 + n) * 128 + 16 * w + fr) * 128 + 32 * ks + 8 * fq);
        float ba4[4], bx4[4], ls4[4];
#pragma unroll
        for (int r = 0; r < 4; ++r) { const int cgl = dir * 1024 + 128 * n + 16 * w + 4 * fq + r; ba4[r] = -1.4426950408889634f * p.rg_ba[cgl]; bx4[r] = -1.4426950408889634f * p.rg_bx[cgl];
            const float lam = p.rg_lam[cgl]; const float y = __builtin_amdgcn_exp2f(-1.4426950408889634f * lam);
            float l1p; if (y < 0.05f) l1p = y * (1.f + y * (-0.5f + y * (1.f / 3 + y * (-0.25f + y * (0.2f + y * (-1.f / 6)))))); else l1p = __logf(1.f + y);
            ls4[r] = -8.f * 1.4426950408889634f * l1p; }
        if (tid < 128) ST[tid] = 0.f;
        __syncthreads();
        const int nch = dir == 0 ? 33 : 32;
        bf16x8 rows[5];
        { const int ci0 = dir == 0 ? 0 : 32; const int p00 = ci0 == 0 ? -48 : 16 + 64 * (ci0 - 1);
#pragma unroll
          for (int q = 0; q < 5; ++q) rows[q] = rnn_ld_row(XRb, XRMn, p00 + 2 * tg0 - 2 + q, coff0); }
        for (int c = 0; c < nch; ++c) {
            const int ci = dir == 0 ? c : 32 - c; const int p0 = ci == 0 ? -48 : 16 + 64 * (ci - 1);
            int tq = tid; asm volatile("" : "+v"(tq));
            const int lane = tq & 63, w = tq >> 6, fr = lane & 15, fq = lane >> 4, tg = tq >> 4, coff = 8 * (tq & 15), ch = tq & 127, sg = tq >> 7, otok = tq >> 3, ocol = 16 * (tq & 7);
            { float xf[5][8];
#pragma unroll
              for (int q = 0; q < 5; ++q)
#pragma unroll
                  for (int e = 0; e < 8; ++e) xf[q][e] = bf1((bf16_t)rows[q][e]);
              float o0[8], o1[8];
#pragma unroll
              for (int e = 0; e < 8; ++e) { const float w0 = CW[coff + e], w1 = CW[128 + coff + e], w2 = CW[256 + coff + e], w3 = CW[384 + coff + e], cb = CW[512 + coff + e];
                  o0[e] = cb + w0 * xf[0][e] + w1 * xf[1][e] + w2 * xf[2][e] + w3 * xf[3][e];
                  o1[e] = cb + w0 * xf[1][e] + w1 * xf[2][e] + w2 * xf[3][e] + w3 * xf[4][e]; }
              u32x4 a0, a1; a0.x = pk2(o0[0], o0[1]); a0.y = pk2(o0[2], o0[3]); a0.z = pk2(o0[4], o0[5]); a0.w = pk2(o0[6], o0[7]);
              a1.x = pk2(o1[0], o1[1]); a1.y = pk2(o1[2], o1[3]); a1.z = pk2(o1[4], o1[5]); a1.w = pk2(o1[6], o1[7]);
              *(u32x4*)(XC + (2 * tg) * 136 + coff) = a0; *(u32x4*)(XC + (2 * tg + 1) * 136 + coff) = a1; }
            if (c + 1 < nch) { const int cin = dir == 0 ? c + 1 : 32 - (c + 1); const int pn0 = cin == 0 ? -48 : 16 + 64 * (cin - 1);
#pragma unroll
                for (int q = 0; q < 5; ++q) rows[q] = rnn_ld_row(XRb, XRMn, pn0 + 2 * tg - 2 + q, coff); }
            u32x4 hfp[2], ggp[2];
            if (dir == 1) { const size_t ro = (size_t)(p0 - NMETA + otok) * 1024 + ocol;
                hfp[0] = *(const u32x4*)(HF + ro); hfp[1] = *(const u32x4*)(HF + ro + 8); ggp[0] = *(const u32x4*)(GG + ro); ggp[1] = *(const u32x4*)(GG + ro + 8); }
            LBAR();
            f32x4 accA[4], accX[4];
#pragma unroll
            for (int tb = 0; tb < 4; ++tb) { accA[tb] = (f32x4){0.f, 0.f, 0.f, 0.f}; accX[tb] = accA[tb];
#pragma unroll
                for (int ks = 0; ks < 4; ++ks) { const bf16x8 yv = *(const bf16x8*)(XC + (16 * tb + fr) * 136 + 32 * ks + 8 * fq);
                    accA[tb] = __builtin_amdgcn_mfma_f32_16x16x32_bf16(bfr[0][ks], yv, accA[tb], 0, 0, 0);
                    accX[tb] = __builtin_amdgcn_mfma_f32_16x16x32_bf16(bfr[1][ks], yv, accX[tb], 0, 0, 0); } }
#pragma unroll
            for (int tb = 0; tb < 4; ++tb) { const int tok = 16 * tb + fr; const u32x2 xw = *(const u32x2*)(XC + tok * 136 + 16 * w + 4 * fq);
                const float xc4[4] = {bflo(xw.x), bfhi(xw.x), bflo(xw.y), bfhi(xw.y)}; f32x4 av, uv;
#pragma unroll
                for (int r = 0; r < 4; ++r) { const float ea = __builtin_amdgcn_exp2f(fmaf(accA[tb][r], -1.4426950408889634f, ba4[r])), ei = __builtin_amdgcn_exp2f(fmaf(accX[tb][r], -1.4426950408889634f, bx4[r]));
                    const float rr = __builtin_amdgcn_rcpf(1.f + ea), ii = __builtin_amdgcn_rcpf(1.f + ei);
                    const float a = __builtin_amdgcn_exp2f(rr * ls4[r]); const float om = fmaf(-a, a, 1.f);
                    av[r] = a; uv[r] = __builtin_amdgcn_sqrtf(fmaxf(om, 0.f)) * (ii * xc4[r]); }
                if (ci == 0) { if (p0 + tok < 0) { av = (f32x4){1.f, 1.f, 1.f, 1.f}; uv = (f32x4){0.f, 0.f, 0.f, 0.f}; } }
                *(f32x4*)(AS + tok * 132 + 16 * w + 4 * fq) = av; *(f32x4*)(US + tok * 132 + 16 * w + 4 * fq) = uv; }
            LBAR();
            float hl[16], ac[16]; float hh = 0.f, aa = 1.f;
#pragma unroll
            for (int i = 0; i < 16; ++i) { const int t = dir == 0 ? 16 * sg + i : 63 - (16 * sg + i); const float a = AS[t * 132 + ch], u = US[t * 132 + ch]; hh = a * hh + u; aa *= a; hl[i] = hh; ac[i] = aa; }
            SEG[sg * 128 + ch] = aa; SEG[512 + sg * 128 + ch] = hh;
            LBAR();
            float carry = ST[(c & 1) * 128 + ch];
#pragma unroll
            for (int s2 = 0; s2 < 3; ++s2) if (s2 < sg) carry = SEG[s2 * 128 + ch] * carry + SEG[512 + s2 * 128 + ch];
            if (sg == 3) ST[((c + 1) & 1) * 128 + ch] = aa * carry + hh;
            if (ci > 0) {
#pragma unroll
                for (int i = 0; i < 16; ++i) { const int t = dir == 0 ? 16 * sg + i : 63 - (16 * sg + i); AS[t * 132 + ch] = hl[i] + ac[i] * carry; }
                LBAR();
                const size_t ro = (size_t)(p0 - NMETA + otok) * 1024 + ocol; const f32x4* hp = (const f32x4*)(AS + otok * 132 + ocol);
                const f32x4 h0 = hp[0], h1 = hp[1], h2 = hp[2], h3 = hp[3];
                if (dir == 0) {
                    u32x4 o0, o1; o0.x = pk2(h0[0], h0[1]); o0.y = pk2(h0[2], h0[3]); o0.z = pk2(h1[0], h1[1]); o0.w = pk2(h1[2], h1[3]);
                    o1.x = pk2(h2[0], h2[1]); o1.y = pk2(h2[2], h2[3]); o1.z = pk2(h3[0], h3[1]); o1.w = pk2(h3[2], h3[3]);
                    *(u32x4*)(HF + ro) = o0; *(u32x4*)(HF + ro + 8) = o1;
                } else {
#define RT2(H, HA, HB, G) pk2((bflo(H) + (HA)) * bflo(G), (bfhi(H) + (HB)) * bfhi(G))
                    u32x4 o0, o1; o0.x = RT2(hfp[0].x, h0[0], h0[1], ggp[0].x); o0.y = RT2(hfp[0].y, h0[2], h0[3], ggp[0].y); o0.z = RT2(hfp[0].z, h1[0], h1[1], ggp[0].z); o0.w = RT2(hfp[0].w, h1[2], h1[3], ggp[0].w);
                    o1.x = RT2(hfp[1].x, h2[0], h2[1], ggp[1].x); o1.y = RT2(hfp[1].y, h2[2], h2[3], ggp[1].y); o1.z = RT2(hfp[1].z, h3[0], h3[1], ggp[1].z); o1.w = RT2(hfp[1].w, h3[2], h3[3], ggp[1].w);
#undef RT2
                    *(u32x4*)(RT + ro) = o0; *(u32x4*)(RT + ro + 8) = o1;
                }
            }
        }
        __syncthreads();
    }
}

namespace att {
using bf16 = __hip_bfloat16;
constexpr int   D = 128, NW = 8, QBLK = 32, KVBLK = 64;
constexpr float SCALE = 0.088388347648318440f;
constexpr float THR = 8.f;
constexpr int SDEPTH = 2;
constexpr int NPADK = NPAD;
constexpr size_t SHM_V = KVBLK * D * 2, SHM_K = KVBLK * D * 2, SHM_ATTN = 2 * SHM_V + 2 * SHM_K + NW * 64 * 4;
using bf16x8 = __attribute__((ext_vector_type(8))) short;
using s16x4  = __attribute__((ext_vector_type(4))) short;
using f32x16 = __attribute__((ext_vector_type(16))) float;
using f32x8  = __attribute__((ext_vector_type(8))) float;
using u32x4  = __attribute__((ext_vector_type(4))) unsigned;
#define KSWZ(row, colB) ((row) * 256 + ((colB) ^ (((row) & 7) << 4)))
#define SBAR() __builtin_amdgcn_sched_barrier(0)
__device__ __forceinline__ int crow(int r, int hi) { return (r & 3) + 8 * (r >> 2) + 4 * hi; }
__device__ __forceinline__ unsigned cvtpk(float lo, float hi) {
  unsigned r; asm volatile("v_cvt_pk_bf16_f32 %0, %1, %2" : "=v"(r) : "v"(lo), "v"(hi)); return r;
}
template <typename TIn> struct Stage;
template <> struct Stage<bf16>  { using T = bf16x8;
  __device__ static __forceinline__ T ld8(const bf16* p) { return *reinterpret_cast<const bf16x8*>(p); }
  __device__ static __forceinline__ bf16x8 tobf(T x) { return x; } };
template <> struct Stage<float> { using T = f32x8;
  __device__ static __forceinline__ T ld8(const float* p) { return *reinterpret_cast<const f32x8*>(p); }
  __device__ static __forceinline__ bf16x8 tobf(T x) {
    u32x4 w = {cvtpk(x[0], x[1]), cvtpk(x[2], x[3]), cvtpk(x[4], x[5]), cvtpk(x[6], x[7])}; return *reinterpret_cast<bf16x8*>(&w); } };

__device__ __forceinline__ void partialSM(f32x16& p0, f32x16& p1, float& m_reg, float& mn, float& alpha) {
  constexpr float C = SCALE * 1.4426950408889634f;
  float pmax = p0[0]; for (int r = 1; r < 16; ++r) pmax = fmaxf(pmax, p0[r]); for (int r = 0; r < 16; ++r) pmax = fmaxf(pmax, p1[r]);
  { auto rr = __builtin_amdgcn_permlane32_swap(__float_as_uint(pmax), __float_as_uint(pmax), false, false);
    pmax = fmaxf(__uint_as_float(rr[0]), __uint_as_float(rr[1])); }
  if (__builtin_expect(__all(pmax - m_reg <= THR / SCALE), 1)) { mn = m_reg; alpha = 1.f; }
  else { mn = fmaxf(m_reg, pmax); alpha = __builtin_amdgcn_exp2f((m_reg - mn) * C); m_reg = mn; }
  float mnC = -mn * C;
  for (int r = 0; r < 16; ++r) p0[r] = fmaf(p0[r], C, mnC); for (int r = 0; r < 16; ++r) p1[r] = fmaf(p1[r], C, mnC);
  for (int r = 0; r < 16; ++r) p0[r] = __builtin_amdgcn_exp2f(p0[r]);
}
__device__ __forceinline__ void finishSM(f32x16& p0, f32x16& p1, float alpha, float& l_reg, bf16x8& pa0, bf16x8& pa1, bf16x8& pa2, bf16x8& pa3) {
  for (int r = 0; r < 16; ++r) p1[r] = __builtin_amdgcn_exp2f(p1[r]);
  float ps = 0; for (int r = 0; r < 16; ++r) ps += p0[r]; for (int r = 0; r < 16; ++r) ps += p1[r];
  { auto rr = __builtin_amdgcn_permlane32_swap(__float_as_uint(ps), __float_as_uint(ps), false, false);
    ps = __uint_as_float(rr[0]) + __uint_as_float(rr[1]); }
  l_reg = l_reg * alpha + ps;
#define PK4(P, BASE, OUT) do { unsigned a0 = cvtpk(P[BASE + 0], P[BASE + 1]), a1 = cvtpk(P[BASE + 2], P[BASE + 3]);   \
    unsigned b0 = cvtpk(P[BASE + 4], P[BASE + 5]), b1 = cvtpk(P[BASE + 6], P[BASE + 7]);                              \
    auto r0 = __builtin_amdgcn_permlane32_swap(a0, b0, false, false); auto r1 = __builtin_amdgcn_permlane32_swap(a1, b1, false, false); \
    u32x4 w = {r0[0], r1[0], r0[1], r1[1]}; OUT = *reinterpret_cast<bf16x8*>(&w); } while (0)
  PK4(p0, 0, pa0); PK4(p0, 8, pa1); PK4(p1, 0, pa2); PK4(p1, 8, pa3);
#undef PK4
}
__device__ __forceinline__ void qkt(f32x16& p0, f32x16& p1, const bf16* Ks, const bf16x8* qr, int r32, int hi) {
  p0 = f32x16{}; p1 = f32x16{};
  for (int d0 = 0; d0 < 8; ++d0) { int cb = (d0 * 16 + hi * 8) * 2;
    bf16x8 b0 = *reinterpret_cast<const bf16x8*>((const char*)Ks + KSWZ(r32, cb));
    bf16x8 b1 = *reinterpret_cast<const bf16x8*>((const char*)Ks + KSWZ(32 + r32, cb));
    p0 = __builtin_amdgcn_mfma_f32_32x32x16_bf16(b0, qr[d0], p0, 0, 0, 0);
    p1 = __builtin_amdgcn_mfma_f32_32x32x16_bf16(b1, qr[d0], p1, 0, 0, 0); }
}
__device__ __forceinline__ int v_st(int k, int c) { const int kk = (k & ~0xC) | ((k & 4) << 1) | ((k & 8) >> 1); return ((kk >> 3) * 4 + (c >> 5)) * 512 + ((kk & 7) * 32 + (c & 31)) * 2; }
__device__ __forceinline__ int v_rd_base(int lane) { return ((lane & 3) << 3) | (((lane >> 2) & 3) << 6) | (((lane >> 4) & 1) << 5) | (((lane >> 5) & 1) << 8); }
constexpr int v_rd_off(int d0, int ks, int half) { return d0 * 512 + ks * 4096 + half * 2048; }
template <int OFF> __device__ __forceinline__ s16x4 tr_read(int vb) {
  s16x4 r; asm volatile("ds_read_b64_tr_b16 %0, %1 offset:%2" : "=&v"(r) : "v"(vb), "i"(OFF) : "memory"); return r;
}
template <int D0> __device__ __forceinline__ void pv_one(f32x16& od, int vb, bf16x8 pa0, bf16x8 pa1, bf16x8 pa2, bf16x8 pa3) {
  const s16x4 l0 = tr_read<v_rd_off(D0, 0, 0)>(vb), h0 = tr_read<v_rd_off(D0, 0, 1)>(vb), l1 = tr_read<v_rd_off(D0, 1, 0)>(vb), h1 = tr_read<v_rd_off(D0, 1, 1)>(vb);
  const s16x4 l2 = tr_read<v_rd_off(D0, 2, 0)>(vb), h2 = tr_read<v_rd_off(D0, 2, 1)>(vb), l3 = tr_read<v_rd_off(D0, 3, 0)>(vb), h3 = tr_read<v_rd_off(D0, 3, 1)>(vb);
  asm volatile("s_waitcnt lgkmcnt(0)" ::: "memory"); SBAR();
#define PK(L, H) (bf16x8){L[0], L[1], L[2], L[3], H[0], H[1], H[2], H[3]}
  od = __builtin_amdgcn_mfma_f32_32x32x16_bf16(pa0, PK(l0, h0), od, 0, 0, 0);
  od = __builtin_amdgcn_mfma_f32_32x32x16_bf16(pa1, PK(l1, h1), od, 0, 0, 0);
  od = __builtin_amdgcn_mfma_f32_32x32x16_bf16(pa2, PK(l2, h2), od, 0, 0, 0);
  od = __builtin_amdgcn_mfma_f32_32x32x16_bf16(pa3, PK(l3, h3), od, 0, 0, 0);
#undef PK
}
__device__ __forceinline__ void pv_d0(f32x16* o, int vb, bf16x8 pa0, bf16x8 pa1, bf16x8 pa2, bf16x8 pa3) {
  pv_one<0>(o[0], vb, pa0, pa1, pa2, pa3); pv_one<1>(o[1], vb, pa0, pa1, pa2, pa3); pv_one<2>(o[2], vb, pa0, pa1, pa2, pa3); pv_one<3>(o[3], vb, pa0, pa1, pa2, pa3);
}

constexpr int LDQ = 1024, LDK = 128;
constexpr int OS_OFF = (int)SHM_ATTN, OS_WAVE = 32 * 136 * 2;
__device__ __forceinline__ void attn_unit(const bf16* __restrict__ Qb, const bf16* __restrict__ Kh, const bf16* __restrict__ Vh,
                                          const unsigned short* __restrict__ GAb, const unsigned short* __restrict__ RTb, unsigned short* __restrict__ MIXb,
                                          const float* __restrict__ qg, const float* __restrict__ ROPE, int s_base, int seq, char* lds) {
  using St = Stage<bf16>;
  int tid_o = threadIdx.x; asm volatile("" : "+v"(tid_o));
  const int tid = tid_o, wid = tid >> 6, lane = tid & 63, r32 = lane & 31, hi = lane >> 5;
  bf16* V_lds = (bf16*)lds; bf16* K_lds = (bf16*)(lds + 2 * SHM_V);
  float* ws = (float*)(lds + 2 * SHM_V + 2 * SHM_K) + wid * 64; float* li_l = ws; float* al_l = ws + 32;
  float m_reg = -1e30f, l_reg = 0; f32x16 o[4] = {}; bf16x8 qr[8];
  {
    const bf16* Qw = Qb + (long)(wid * QBLK + r32) * LDQ + hi * 8;
    float xf[8][8]; float ss = 0.f;
#pragma unroll
    for (int d0 = 0; d0 < 8; ++d0) { const bf16x8 raw = *reinterpret_cast<const bf16x8*>(Qw + d0 * 16);
#pragma unroll
      for (int e = 0; e < 8; ++e) { xf[d0][e] = __uint_as_float((unsigned)(unsigned short)raw[e] << 16); ss += xf[d0][e] * xf[d0][e]; } }
    ss += __shfl_xor(ss, 32);
    const float rstd = __builtin_amdgcn_rsqf(ss * (1.f / 128.f) + 1e-6f);
#pragma unroll
    for (int d0 = 0; d0 < 8; ++d0) { const float4 g0 = *reinterpret_cast<const float4*>(qg + d0 * 16 + hi * 8), g1 = *reinterpret_cast<const float4*>(qg + d0 * 16 + hi * 8 + 4);
      xf[d0][0] *= rstd * g0.x; xf[d0][1] *= rstd * g0.y; xf[d0][2] *= rstd * g0.z; xf[d0][3] *= rstd * g0.w;
      xf[d0][4] *= rstd * g1.x; xf[d0][5] *= rstd * g1.y; xf[d0][6] *= rstd * g1.z; xf[d0][7] *= rstd * g1.w; }
    const int s = s_base + wid * QBLK + r32;
#pragma unroll
    for (int ax = 0; ax < 2; ++ax) { const int pos = ax ? (s & 63) : (s >> 6);
#pragma unroll
      for (int dd = 0; dd < 2; ++dd) { const float4* cs = reinterpret_cast<const float4*>(ROPE + (pos * 32 + 16 * dd + 8 * hi) * 2); const int d1 = 4 * ax + dd, d2 = d1 + 2;
#pragma unroll
        for (int e2 = 0; e2 < 4; ++e2) { const float4 c4 = cs[e2];
          { const float x1 = xf[d1][2 * e2], x2 = xf[d2][2 * e2]; xf[d1][2 * e2] = x1 * c4.x - x2 * c4.y; xf[d2][2 * e2] = x2 * c4.x + x1 * c4.y; }
          { const float x1 = xf[d1][2 * e2 + 1], x2 = xf[d2][2 * e2 + 1]; xf[d1][2 * e2 + 1] = x1 * c4.z - x2 * c4.w; xf[d2][2 * e2 + 1] = x2 * c4.z + x1 * c4.w; } } } }
#pragma unroll
    for (int d0 = 0; d0 < 8; ++d0) { u32x4 w = {cvtpk(xf[d0][0], xf[d0][1]), cvtpk(xf[d0][2], xf[d0][3]), cvtpk(xf[d0][4], xf[d0][5]), cvtpk(xf[d0][6], xf[d0][7])}; qr[d0] = *reinterpret_cast<bf16x8*>(&w); }
  }
  const int sr = tid >> 4, sc = (tid & 15) * 8, vst0 = v_st(sr, sc), vst1 = v_st(32 + sr, sc);
  const int vb0 = (int)(uintptr_t)V_lds + v_rd_base(lane);
  struct { typename St::T vs0, vs1, ks0, ks1; } sr_[SDEPTH];
#define SLOAD(i, k0) do { sr_[i].vs0 = St::ld8(&Vh[(long)((k0) + sr) * LDK + sc]); sr_[i].vs1 = St::ld8(&Vh[(long)((k0) + 32 + sr) * LDK + sc]); \
    sr_[i].ks0 = St::ld8(&Kh[(long)((k0) + sr) * LDK + sc]); sr_[i].ks1 = St::ld8(&Kh[(long)((k0) + 32 + sr) * LDK + sc]); } while (0)
#define SWRITE(b, i) do { *(bf16x8*)((char*)V_lds + (b) * SHM_V + vst0) = St::tobf(sr_[i].vs0);          \
    *(bf16x8*)((char*)V_lds + (b) * SHM_V + vst1) = St::tobf(sr_[i].vs1); int kc = sc * 2;               \
    *(bf16x8*)((char*)K_lds + (b) * SHM_K + KSWZ(sr, kc)) = St::tobf(sr_[i].ks0);                       \
    *(bf16x8*)((char*)K_lds + (b) * SHM_K + KSWZ(32 + sr, kc)) = St::tobf(sr_[i].ks1); } while (0)
#define SWAIT() do { if constexpr (SDEPTH == 2) asm volatile("s_waitcnt vmcnt(4)" ::: "memory"); else asm volatile("s_waitcnt vmcnt(0)" ::: "memory"); } while (0)
#define RESC(a) do { if (__any((a) < 1.f)) { if (hi == 0) al_l[r32] = (a); asm volatile("s_waitcnt lgkmcnt(0)" ::: "memory"); \
    for (int d = 0; d < 4; ++d) for (int r = 0; r < 16; ++r) o[d][r] *= al_l[crow(r, hi)]; } } while (0)
  f32x16 pA0, pA1, pB0, pB1; float mnA, mnB, alA, alB; bf16x8 pa0, pa1, pa2, pa3; const int NT = seq / KVBLK;
  constexpr int SE = 0, SO = SDEPTH - 1;
  SLOAD(SE, 0); asm volatile("s_waitcnt vmcnt(0)" ::: "memory"); SWRITE(0, SE); __syncthreads();
  qkt(pA0, pA1, K_lds, qr, r32, hi); partialSM(pA0, pA1, m_reg, mnA, alA);
  SLOAD(SO, KVBLK); if constexpr (SDEPTH == 2) { if (2 < NT) SLOAD(SE, 2 * KVBLK); }
  SWAIT(); SWRITE(1, SO); __syncthreads();
  for (int j = 1; j + 1 < NT; j += 2) {
    SBAR(); qkt(pB0, pB1, (bf16*)((char*)K_lds + SHM_K), qr, r32, hi);
    finishSM(pA0, pA1, alA, l_reg, pa0, pa1, pa2, pa3); SBAR();
    SLOAD(SO, (j + SDEPTH) * KVBLK); SBAR();
    pv_d0(o, vb0, pa0, pa1, pa2, pa3); partialSM(pB0, pB1, m_reg, mnB, alB);
    __syncthreads(); SWAIT(); SWRITE(0, SE);
    RESC(alB); __syncthreads();
    SBAR(); qkt(pA0, pA1, K_lds, qr, r32, hi);
    finishSM(pB0, pB1, alB, l_reg, pa0, pa1, pa2, pa3); SBAR();
    if (SDEPTH == 1 || j + 3 < NT) SLOAD(SE, (j + 1 + SDEPTH) * KVBLK); SBAR();
    pv_d0(o, vb0 + (int)SHM_V, pa0, pa1, pa2, pa3); partialSM(pA0, pA1, m_reg, mnA, alA);
    __syncthreads(); SWAIT(); SWRITE(1, SO);
    RESC(alA); __syncthreads();
  }
  SBAR(); qkt(pB0, pB1, (bf16*)((char*)K_lds + SHM_K), qr, r32, hi);
  finishSM(pA0, pA1, alA, l_reg, pa0, pa1, pa2, pa3); SBAR();
  pv_d0(o, vb0, pa0, pa1, pa2, pa3); partialSM(pB0, pB1, m_reg, mnB, alB);
  __syncthreads(); RESC(alB);
  finishSM(pB0, pB1, alB, l_reg, pa0, pa1, pa2, pa3); SBAR();
  pv_d0(o, vb0 + (int)SHM_V, pa0, pa1, pa2, pa3);
  { constexpr float C = SCALE * 1.4426950408889634f; l_reg -= (float)NPADK * __builtin_amdgcn_exp2f(-m_reg * C); }
  int tid_e = tid; asm volatile("" : "+v"(tid_e)); const int lane_e = tid_e & 63, wid_e = tid_e >> 6;
  if (hi == 0) li_l[r32] = l_reg; asm volatile("s_waitcnt lgkmcnt(0)" ::: "memory");
  float rli[16];
#pragma unroll
  for (int r = 0; r < 16; ++r) rli[r] = __builtin_amdgcn_rcpf(li_l[crow(r, hi)]);
  unsigned short* osw = (unsigned short*)(lds + OS_OFF + wid_e * OS_WAVE);
#pragma unroll
  for (int r = 0; r < 16; ++r) { const int orow = crow(r, hi);
#pragma unroll
    for (int d0 = 0; d0 < 4; ++d0) { const float v = o[d0][r] * rli[r]; osw[orow * 136 + d0 * 32 + (lane_e & 31)] = (unsigned short)(cvtpk(v, v) & 0xffffu); } }
  asm volatile("s_waitcnt lgkmcnt(0)" ::: "memory");
#pragma unroll
  for (int k = 0; k < 8; ++k) { const int idx = k * 64 + lane_e, row = idx >> 4, chunk = idx & 15; const long go = (long)(wid_e * QBLK + row) * LDQ + chunk * 8;
    const u32x4 ov = *reinterpret_cast<const u32x4*>(osw + row * 136 + chunk * 8);
    const u32x4 ga = *reinterpret_cast<const u32x4*>(GAb + go), rt = *reinterpret_cast<const u32x4*>(RTb + go);
    u32x4 w;
#define MIX2(O, G, R) cvtpk(__uint_as_float((G) << 16) * __uint_as_float((O) << 16) + __uint_as_float((R) << 16), __uint_as_float((G) & 0xffff0000u) * __uint_as_float((O) & 0xffff0000u) + __uint_as_float((R) & 0xffff0000u))
    w.x = MIX2(ov.x, ga.x, rt.x); w.y = MIX2(ov.y, ga.y, rt.y); w.z = MIX2(ov.z, ga.z, rt.z); w.w = MIX2(ov.w, ga.w, rt.w);
#undef MIX2
    *reinterpret_cast<u32x4*>(MIXb + go) = w; }
  asm volatile("s_waitcnt lgkmcnt(0)" ::: "memory");
  __syncthreads();
#undef SLOAD
#undef SWRITE
#undef SWAIT
#undef RESC
}
#undef KSWZ
#undef SBAR
}

#define RLX_AGENT __ATOMIC_RELAXED, __HIP_MEMORY_SCOPE_AGENT
#define XB_TMO      128
#define XB_XCNT(j)  (256  + 64 * (j))
#define XB_XSUB(j)  (1280 + 64 * (j))
#define XB_XGEN(j)  (2304 + 64 * (j))
#define XB_TOP      3328
#define XB_TOPGEN   3392
#define XCD_BAR_WORDS 3456
#define XB_SPIN_CAP (1u << 18)

__device__ __forceinline__ unsigned xb_ld(unsigned* p)              { return __hip_atomic_load(p, __ATOMIC_RELAXED, __HIP_MEMORY_SCOPE_AGENT); }
__device__ __forceinline__ unsigned xb_add(unsigned* p, unsigned v) { return __hip_atomic_fetch_add(p, v, __ATOMIC_RELAXED, __HIP_MEMORY_SCOPE_AGENT); }
__device__ __forceinline__ unsigned xb_xcc_id() { return (unsigned)__builtin_amdgcn_s_getreg((3 << 11) | 20) & 0xFu; }
#define XB_SPIN(cond, bar) do { unsigned _sp = 0; while (cond) { __builtin_amdgcn_s_sleep(1); \
    if ((++_sp & 255u) == 0u) { if (xb_ld(&(bar)[XB_TMO])) break; if (_sp > XB_SPIN_CAP) { atomicAdd(&(bar)[XB_TMO], 1u); break; } } } } while (0)

struct XcdBarrier {
    unsigned* bar; unsigned x;
    volatile LAS unsigned* st;
};

__device__ __forceinline__ XcdBarrier xcd_barrier_post(unsigned* bar, volatile LAS unsigned* st) {
    XcdBarrier b; b.bar = bar; b.x = xb_xcc_id(); b.st = st;
    if (threadIdx.x == 0) (void)xb_add(&bar[XB_XCNT(b.x)], 1u);
    return b;
}
__device__ __forceinline__ void xcd_barrier_complete(unsigned* bar, unsigned x, unsigned& nloc, unsigned& nx) {
    const unsigned G = gridDim.x * gridDim.y * gridDim.z;
    unsigned sum, cnt, mine, sp = 0u;
    for (;;) {
        sum = 0u; cnt = 0u; mine = 0u;
#pragma unroll
        for (unsigned j = 0; j < 16; ++j) { const unsigned c = xb_ld(&bar[XB_XCNT(j)]); sum += c; cnt += (c > 0u) ? 1u : 0u; mine = (j == x) ? c : mine; }
        if (sum == G) break;
        __builtin_amdgcn_s_sleep(1);
        if ((++sp & 255u) == 0u) { if (xb_ld(&bar[XB_TMO])) break; if (sp > XB_SPIN_CAP) { atomicAdd(&bar[XB_TMO], 1u); break; } }
    }
    nloc = mine > 0u ? mine : 1u; nx = cnt > 0u ? cnt : 1u;
}

__device__ __forceinline__ void xcd_barrier(const XcdBarrier& b) {
    asm volatile("s_waitcnt vmcnt(0)" ::: "memory");
    __syncthreads();
    if (threadIdx.x == 0) {
        unsigned* bar = b.bar;
        __builtin_amdgcn_s_waitcnt(0);
        unsigned nloc = b.st[0], nx = b.st[1];
        if (nloc == 0u) { xcd_barrier_complete(bar, b.x, nloc, nx); b.st[0] = nloc; b.st[1] = nx; }
        const unsigned old = xb_add(&bar[XB_XSUB(b.x)], 1u);
        const unsigned gen = old / nloc;
        if (old + 1u == (gen + 1u) * nloc) {
            __builtin_amdgcn_fence(__ATOMIC_RELEASE, "agent");
            asm volatile("s_waitcnt vmcnt(0)" ::: "memory");
            const unsigned og = xb_add(&bar[XB_TOP], 1u);
            const unsigned tg = og / nx;
            if (og + 1u == (tg + 1u) * nx) xb_add(&bar[XB_TOPGEN], 1u);
            else XB_SPIN(xb_ld(&bar[XB_TOPGEN]) == tg, bar);
            __builtin_amdgcn_fence(__ATOMIC_ACQUIRE, "agent");
            xb_add(&bar[XB_XGEN(b.x)], 1u);
            asm volatile("s_waitcnt vmcnt(0)" ::: "memory");
        } else {
            XB_SPIN(xb_ld(&bar[XB_XGEN(b.x)]) == gen, bar);
            __builtin_amdgcn_fence(__ATOMIC_ACQUIRE, "agent");
            asm volatile("s_waitcnt vmcnt(0)" ::: "memory");
        }
    }
    __syncthreads();
}

#ifndef MK_N_LAUNCHES
#define MK_N_LAUNCHES 1
#endif
constexpr int N_PHASES = 7;
#ifndef PROBE_PHASE
#define PROBE_PHASE -1
#endif
#define REPS(k)
struct Args { const float* in[17]; float* out; unsigned char* ws; int ph_lo, ph_hi; };

__global__ void __launch_bounds__(512, 2) fwd_mega(Args a) {
    extern __shared__ __attribute__((aligned(16))) unsigned char lds[];
    cg::grid_group grid = cg::this_grid();
    const int G = gridDim.x; const int bx = blockIdx.x; const int vcu = (G % 8 == 0) ? (bx % 8) * (G / 8) + bx / 8 : bx;
    P p; p.x = a.in[0]; p.meta = a.in[1]; p.g1 = a.in[2]; p.w_in = a.in[3]; p.conv_w = a.in[4]; p.conv_b = a.in[5]; p.rg_wa = a.in[6]; p.rg_ba = a.in[7];
    p.rg_wx = a.in[8]; p.rg_bx = a.in[9]; p.rg_lam = a.in[10]; p.qg = a.in[11]; p.kg = a.in[12]; p.w_out = a.in[13]; p.g2 = a.in[14]; p.w_fi = a.in[15]; p.w_fo = a.in[16];
    p.out = a.out; p.ws = a.ws;
    unsigned char* ws = a.ws;
    const int lo = a.ph_lo, hi = a.ph_hi;
#ifndef PH_MASK
#define PH_MASK 127
#endif
#define IN(k) (((PH_MASK >> (k)) & 1) && lo <= (k) && (k) < hi)
#define SEAM(k) do { if (IN(k) && IN((k) + 1)) { if ((k) == 0) grid.sync(); else xcd_barrier(xbar); } } while (0)
    PG8_LAS unsigned char* ldsl = (PG8_LAS unsigned char*)lds;
    volatile LAS unsigned* xst = (volatile LAS unsigned*)(ldsl + LDS_BYTES - 64);
    if (threadIdx.x == 0) { xst[0] = 0u; xst[1] = 0u; }
    __syncthreads();
    XcdBarrier xbar; xbar.bar = (unsigned*)ws + 4096; xbar.x = 0; xbar.st = nullptr;
    if (hi - lo > 1) xbar = xcd_barrier_post((unsigned*)ws + 4096, xst);

    if (IN(0)) p0_prologue(p, lds, vcu, G);
    SEAM(0);
    if (IN(1)) REPS(1) {
        pg8::Gemm g{(const bf16_t*)(ws + WS_XN), (const bf16_t*)(ws + WS_WIN), M, NIN, 1024}; pg8::StaticOrder S; S.init(M, NIN, G, bx);
        Epi1 E{(bf16_t*)(ws + WS_Q), (bf16_t*)(ws + WS_KRAW), (bf16_t*)(ws + WS_VF), (bf16_t*)(ws + WS_XR), (bf16_t*)(ws + WS_GG), (bf16_t*)(ws + WS_GA)};
        pg8::gemm_phase<Epi1, pg8::StaticOrder, true, true>(ldsl, g, S, E);
    }
    SEAM(1);
    if (IN(2)) REPS(2) {
        p2_kpass(p, vcu, G);
        __syncthreads();
        for (int it = bx; it < BATCH * 8; it += G) rnn_item(p, lds, it >> 3, it & 7);
    }
    SEAM(2);
    if (IN(3)) {
        for (int i = 0;; ++i) { const int uid = i * G + vcu; if (uid >= BATCH * 2 * 32) break;
            const int pr = uid >> 5, j = uid & 31, b = pr >> 1, kvh = pr & 1, h = kvh * 4 + (j >> 3), qb = j & 7;
            const size_t qoff = ((size_t)b * SEQ + qb * 256) * 1024 + h * 128; const size_t koff = (size_t)(b * 2 + kvh) * SKV * 128;
            att::attn_unit((const att::bf16*)(ws + WS_Q) + qoff, (const att::bf16*)(ws + WS_KF) + koff, (const att::bf16*)(ws + WS_VF) + koff,
                           (const unsigned short*)(ws + WS_GA) + qoff, (const unsigned short*)(ws + WS_RT) + qoff, (unsigned short*)(ws + WS_Q) + qoff,
                           p.qg, (const float*)(ws + WS_ROPE), qb * 256, SKV, (char*)lds);
        }
    }
    SEAM(3);
    if (IN(4)) REPS(4) {
        pg8::Gemm g{(const bf16_t*)(ws + WS_Q), (const bf16_t*)(ws + WS_WOUT), M, 1024, 1024}; pg8::StaticOrder S; S.init(M, 1024, G, bx);
        Epi2 E{p.x, p.out, (bf16_t*)(ws + WS_H1B), (float*)(ws + WS_SS)};
        pg8::gemm_phase<Epi2, pg8::StaticOrder, true, true>(ldsl, g, S, E);
    }
    SEAM(4);
    if (IN(5)) REPS(5) {
        pg8::Gemm g{(const bf16_t*)(ws + WS_H1B), (const bf16_t*)(ws + WS_WFI), M, 2 * DFF, 1024}; pg8::StaticOrder S; S.init(M, 2 * DFF, G, bx);
        Epi3 E{(const float*)(ws + WS_SS), (bf16_t*)(ws + WS_ACT)};
        pg8::gemm_phase<Epi3, pg8::StaticOrder, true, true>(ldsl, g, S, E);
    }
    SEAM(5);
    if (IN(6)) {
        pg8::Gemm g{(const bf16_t*)(ws + WS_ACT), (const bf16_t*)(ws + WS_WFO), M, 1024, DFF}; pg8::StaticOrder S; S.init(M, 1024, G, bx);
        Epi4 E{p.out};
        pg8::gemm_phase<Epi4, pg8::StaticOrder, true, true>(ldsl, g, S, E);
    }
#undef IN
#undef SEAM
}

extern "C" void kernel_launch(void* const* d_in, const int* in_sizes, int n_in, void* d_out, int out_size, void* d_ws, size_t ws_size, hipStream_t stream) {
    static int grid = 0;
    if (grid == 0) {
        if (n_in != 17 || in_sizes[0] != M * DM || out_size != M * DM || ws_size < WS_END) {
            fprintf(stderr, "kernel_launch: shape mismatch n_in %d in0 %d out %d ws %zu (need %zu)\n", n_in, n_in > 0 ? in_sizes[0] : -1, out_size, ws_size, (size_t)WS_END); grid = -1; return; }
        int dev = 0, cus = 0, per_cu = 0;
        if (hipGetDevice(&dev) != hipSuccess || hipDeviceGetAttribute(&cus, hipDeviceAttributeMultiprocessorCount, dev) != hipSuccess) { grid = -1; return; }
        if (hipFuncSetAttribute((const void*)fwd_mega, hipFuncAttributeMaxDynamicSharedMemorySize, LDS_BYTES) != hipSuccess) { fprintf(stderr, "kernel_launch: hipFuncSetAttribute failed\n"); grid = -1; return; }
        if (hipOccupancyMaxActiveBlocksPerMultiprocessor(&per_cu, (const void*)fwd_mega, 512, LDS_BYTES) != hipSuccess || per_cu < 1) { fprintf(stderr, "kernel_launch: occupancy query says %d\n", per_cu); per_cu = 1; }
        (void)hipGetLastError();
        grid = cus * 1;
        fprintf(stderr, "kernel_launch: cus %d per_cu %d grid %d\n", cus, per_cu, grid);
    }
    if (grid < 0) return;
    if (hipMemsetAsync(d_ws, 0, 65536, stream) != hipSuccess) { fprintf(stderr, "kernel_launch: memset failed\n"); return; }
    Args a{};
    for (int i = 0; i < 17; ++i) a.in[i] = (const float*)d_in[i];
    a.out = (float*)d_out; a.ws = (unsigned char*)d_ws;
#if MK_N_LAUNCHES == 1
    a.ph_lo = 0; a.ph_hi = N_PHASES;
    void* args[] = {&a};
    hipError_t e = hipLaunchCooperativeKernel((const void*)fwd_mega, dim3(grid), dim3(512), args, LDS_BYTES, stream);
    if (e != hipSuccess) fprintf(stderr, "kernel_launch: cooperative launch failed: %s (grid %d)\n", hipGetErrorString(e), grid);
#else
    for (int ph = 0; ph < N_PHASES; ++ph) for (int rep = 0; rep < (ph == PROBE_PHASE ? 2 : 1); ++rep) { a.ph_lo = ph; a.ph_hi = ph + 1;
        hipLaunchKernelGGL(fwd_mega, dim3(grid), dim3(512), LDS_BYTES, stream, a);
        const hipError_t le = hipPeekAtLastError(); if (le != hipSuccess) { fprintf(stderr, "kernel_launch: launch %d failed: %s\n", ph, hipGetErrorName(le)); break; } }
#endif
}
```

```cpp
#define MK_N_LAUNCHES 1
#include <hip/hip_runtime.h>
#include <hip/hip_bf16.h>
#include <hip/hip_cooperative_groups.h>
#include <cstdio>
#include <cstdint>
namespace cg = cooperative_groups;
namespace pg8 {
#define PG8_LAS __attribute__((address_space(3)))
typedef unsigned short bf16_t;
typedef short bf16x8 __attribute__((ext_vector_type(8)));
typedef float f32x4 __attribute__((ext_vector_type(4)));
typedef unsigned u32x4 __attribute__((ext_vector_type(4)));
constexpr int BM = 256, BK = 64, HALF = 128, HTB = HALF * BK * 2  , STAGE_BYTES = 8 * HTB, NXCD = 8, WGM = 8;

__host__ __device__ __forceinline__ int lds_byte(int r, int c) { const int st = (r >> 4) * 2 + (c >> 5), rr = r & 15, cc = c & 31, ob = rr * 64 + cc * 2; return st * 1024 + (ob ^ (((ob >> 9) & 1) << 5)); }
__host__ __device__ __forceinline__ void stage_rc(int b, int& R, int& C) { const int st = b / 1024, sb = b % 1024, swz = sb ^ (((sb >> 9) & 1) << 5); R = (st >> 1) * 16 + swz / 64; C = (st & 1) * 32 + (swz % 64) / 2; }
__host__ __device__ __forceinline__ int perm32(int rho) { const int n = rho >> 4, i = rho & 15; return 8 * (i >> 2) + 4 * n + (i & 3); }

struct Unit { int pm, pn; };
struct Gemm { const bf16_t* A; const bf16_t* Bt; int M, N, K; };

struct StaticOrder {
    int nM, nN, nwg, G, c;
    __host__ __device__ void init(int M, int N, int G_, int c_) { nM = M / BM; nN = N / BM; nwg = nM * nN; G = G_; c = c_; }
    __host__ __device__ bool next(int i, Unit& u) const {
        const long L = (long)i * G + c; if (L >= nwg) return false;
        int wgid = (int)L; { const int q = nwg / NXCD, r = nwg % NXCD, xcd = wgid % NXCD, off = wgid / NXCD; wgid = (xcd < r ? xcd * (q + 1) : r * (q + 1) + (xcd - r) * q) + off; }
        const int nig = WGM * nN, gid = wgid / nig, fm = gid * WGM, gsz = (nM - fm) < WGM ? (nM - fm) : WGM;
        u.pm = fm + ((wgid % nig) % gsz); u.pn = (wgid % nig) / gsz; return true;
    }
    __device__ __forceinline__ void a_ready(const Unit&) const {}
    __device__ __forceinline__ void done(const Unit&) const {}
};

__device__ __forceinline__ unsigned cvt_pk_bf16(float lo, float hi) { unsigned r; asm volatile("v_cvt_pk_bf16_f32 %0, %1, %2" : "=v"(r) : "v"(lo), "v"(hi)); return r; }
typedef float f32x2 __attribute__((ext_vector_type(2)));
template <class Epi, class Sched, bool ALIGN_EPI = false, bool SP2 = false>
__device__ __forceinline__ void gemm_phase(PG8_LAS unsigned char* lds, const Gemm g, const Sched& S, const Epi& E) {
    const int tid = threadIdx.x, wid = __builtin_amdgcn_readfirstlane(tid >> 6), lane = tid & 63, wr = wid >> 2, wc = wid & 3, fr = lane & 15, fq = lane >> 4;
    const int K = g.K, nt = K / BK;
    unsigned voffA[2], voffB[2];
#pragma unroll
    for (int i = 0; i < 2; ++i) { int R, C; stage_rc(tid * 16 + i * 8192, R, C); const int Rb = Epi::PERM ? ((R & ~31) + perm32(R & 31)) : R;
        voffA[i] = (unsigned)(R * K + C) * 2u; voffB[i] = (unsigned)(Rb * K + C) * 2u; }
    const size_t kstep = (size_t)(BK * 2);
    const size_t hstep = (size_t)HALF * K * 2;
    const size_t tstep = 2 * hstep;
    const unsigned ldsw = (unsigned)wid * 1024u;
    const int aoff = lds_byte(wr * 64 + fr, fq * 8), boff = lds_byte(wc * 32 + fr, fq * 8);
#define PG8_SA(b, h) (((b) * 2 + (h)) * HTB)
#define PG8_SB(b, h) ((4 + (b) * 2 + (h)) * HTB)
#define PG8_STAGE(bufoff, gbase, voff) do { _Pragma("unroll") for (int _i = 0; _i < 2; ++_i) \
        __builtin_amdgcn_global_load_lds((const unsigned*)((const char*)(gbase) + (voff)[_i]), (PG8_LAS unsigned*)(lds + (bufoff) + ldsw + _i * 8192), 16, 0, 0); } while (0)
#define PG8_LDA(dst, b, h) do { _Pragma("unroll") for (int m = 0; m < 4; ++m) _Pragma("unroll") for (int k = 0; k < 2; ++k) dst[m][k] = *(const PG8_LAS bf16x8*)(lds + PG8_SA(b, h) + aoff + m * 2048 + k * 1024); } while (0)
#define PG8_LDB(dst, b, h) do { _Pragma("unroll") for (int n = 0; n < 2; ++n) _Pragma("unroll") for (int k = 0; k < 2; ++k) dst[n][k] = *(const PG8_LAS bf16x8*)(lds + PG8_SB(b, h) + boff + n * 2048 + k * 1024); } while (0)
#define PG8_MMA(ai, bj, At, Bt) do { __builtin_amdgcn_s_setprio(1); _Pragma("unroll") for (int m = 0; m < 4; ++m) _Pragma("unroll") for (int n = 0; n < 2; ++n) _Pragma("unroll") for (int k = 0; k < 2; ++k) \
        acc[ai][bj][m][n] = __builtin_amdgcn_mfma_f32_16x16x32_bf16(Bt[n][k], At[m][k], acc[ai][bj][m][n], 0, 0, 0); __builtin_amdgcn_s_setprio(0); } while (0)
#define PG8_WAIT_V(n) asm volatile("s_waitcnt vmcnt(" #n ")" ::: "memory")
#define PG8_WAIT_L(n) asm volatile("s_waitcnt lgkmcnt(" #n ")" ::: "memory")
#define PG8_BAR __builtin_amdgcn_s_barrier()
#define PG8_SCHED __builtin_amdgcn_sched_barrier(0)
    Unit cur, nxt; int ui = 0;
    if (!S.next(0, cur)) return;
    f32x4 acc[2][2][4][2];
    if constexpr (Epi::HAS_INIT) { E.init(acc, cur, wr, wc, fr, fq); } else {
#pragma unroll
    for (int a = 0; a < 2; ++a)
#pragma unroll
        for (int b = 0; b < 2; ++b)
#pragma unroll
            for (int m = 0; m < 4; ++m)
#pragma unroll
                for (int n = 0; n < 2; ++n) acc[a][b][m][n] = (f32x4){0.f, 0.f, 0.f, 0.f};
    }
    if constexpr (Epi::HAS_PRE) E.pre(cur, wr, wc, fr, fq);
    bf16x8 At[4][2], B0[2][2], B1[2][2];
    const char* cA = (const char*)g.A + (size_t)cur.pm * tstep; const char* cB = (const char*)g.Bt + (size_t)cur.pn * tstep;
    S.a_ready(cur);
    if constexpr (SP2) {
        PG8_STAGE(PG8_SB(0, 0), cB, voffB); PG8_STAGE(PG8_SB(0, 1), cB + hstep, voffB); PG8_STAGE(PG8_SA(0, 0), cA, voffA); PG8_STAGE(PG8_SA(0, 1), cA + hstep, voffA);
        if (wr == 1) PG8_BAR;
        PG8_WAIT_V(2); PG8_BAR;
        PG8_STAGE(PG8_SB(1, 0), cB + kstep, voffB); PG8_STAGE(PG8_SA(1, 0), cA + kstep, voffA); PG8_STAGE(PG8_SB(1, 1), cB + hstep + kstep, voffB);
        PG8_WAIT_V(6); PG8_BAR;
    } else {
        PG8_STAGE(PG8_SB(0, 0), cB, voffB); PG8_STAGE(PG8_SA(0, 0), cA, voffA); PG8_STAGE(PG8_SB(0, 1), cB + hstep, voffB); PG8_STAGE(PG8_SA(0, 1), cA + hstep, voffA);
        if (wr == 1) PG8_BAR;
        PG8_WAIT_V(4); PG8_BAR;
        PG8_STAGE(PG8_SB(1, 0), cB + kstep, voffB); PG8_STAGE(PG8_SA(1, 0), cA + kstep, voffA); PG8_STAGE(PG8_SB(1, 1), cB + hstep + kstep, voffB);
        PG8_WAIT_V(6); PG8_BAR;
    }
    for (;;) {
        const bool has_next = S.next(ui + 1, nxt);
        const char* nA = has_next ? (const char*)g.A + (size_t)nxt.pm * tstep : cA; const char* nB = has_next ? (const char*)g.Bt + (size_t)nxt.pn * tstep : cB;
        for (int t = 0; t < nt; t += 2) {
            const bool last = (t == nt - 2);
            const char* a1 = cA + (size_t)(t + 1) * kstep;
            const char* a2 = last ? nA : cA + (size_t)(t + 2) * kstep; const char* b2 = last ? nB : cB + (size_t)(t + 2) * kstep;
            const char* a3 = a2 + kstep; const char* b3 = b2 + kstep;
            if (last && has_next) S.a_ready(nxt);
            if constexpr (SP2) {
            PG8_LDB(B0, 0, 0); PG8_LDB(B1, 0, 1); PG8_SCHED; PG8_LDA(At, 0, 0); PG8_STAGE(PG8_SA(1, 1), a1 + hstep, voffA);
            PG8_WAIT_V(8); PG8_WAIT_L(0); PG8_BAR; PG8_MMA(0, 0, At, B0); PG8_MMA(0, 1, At, B1); PG8_BAR; PG8_SCHED;
            PG8_LDA(At, 0, 1); PG8_STAGE(PG8_SB(0, 0), b2, voffB); PG8_STAGE(PG8_SB(0, 1), b2 + hstep, voffB); PG8_STAGE(PG8_SA(0, 0), a2, voffA);
            PG8_WAIT_V(8); PG8_WAIT_L(0); PG8_BAR; PG8_MMA(1, 0, At, B0); PG8_MMA(1, 1, At, B1); PG8_BAR; PG8_SCHED;
            PG8_LDB(B0, 1, 0); PG8_LDB(B1, 1, 1); PG8_SCHED; PG8_LDA(At, 1, 0); PG8_STAGE(PG8_SA(0, 1), a2 + hstep, voffA);
            PG8_WAIT_V(8); PG8_WAIT_L(0); PG8_BAR; PG8_MMA(0, 0, At, B0); PG8_MMA(0, 1, At, B1); PG8_BAR; PG8_SCHED;
            PG8_LDA(At, 1, 1); PG8_STAGE(PG8_SB(1, 0), b3, voffB); PG8_STAGE(PG8_SB(1, 1), b3 + hstep, voffB); PG8_STAGE(PG8_SA(1, 0), a3, voffA);
            PG8_WAIT_V(8); PG8_WAIT_L(0); PG8_BAR; PG8_MMA(1, 0, At, B0); PG8_MMA(1, 1, At, B1); PG8_BAR; PG8_SCHED;
            } else {
            PG8_LDB(B0, 0, 0); PG8_SCHED; PG8_LDA(At, 0, 0); PG8_STAGE(PG8_SA(1, 1), a1 + hstep, voffA);
            PG8_WAIT_L(8); PG8_BAR; PG8_WAIT_L(0); PG8_MMA(0, 0, At, B0); PG8_BAR; PG8_SCHED;
            PG8_LDB(B1, 0, 1); PG8_STAGE(PG8_SB(0, 0), b2, voffB);
            PG8_BAR; PG8_WAIT_L(0); PG8_MMA(0, 1, At, B1); PG8_BAR;
            PG8_LDA(At, 0, 1); PG8_STAGE(PG8_SA(0, 0), a2, voffA);
            PG8_BAR; PG8_WAIT_L(0); PG8_MMA(1, 0, At, B0); PG8_BAR; PG8_SCHED;
            PG8_STAGE(PG8_SB(0, 1), b2 + hstep, voffB);
            PG8_WAIT_V(6); PG8_BAR; PG8_MMA(1, 1, At, B1); PG8_BAR;
            PG8_LDB(B0, 1, 0); PG8_SCHED; PG8_LDA(At, 1, 0); PG8_STAGE(PG8_SA(0, 1), a2 + hstep, voffA);
            PG8_WAIT_L(8); PG8_BAR; PG8_WAIT_L(0); PG8_MMA(0, 0, At, B0); PG8_BAR; PG8_SCHED;
            PG8_LDB(B1, 1, 1); PG8_STAGE(PG8_SB(1, 0), b3, voffB);
            PG8_BAR; PG8_WAIT_L(0); PG8_MMA(0, 1, At, B1); PG8_BAR;
            PG8_LDA(At, 1, 1); PG8_STAGE(PG8_SA(1, 0), a3, voffA);
            PG8_BAR; PG8_WAIT_L(0); PG8_MMA(1, 0, At, B0); PG8_BAR; PG8_SCHED;
            PG8_STAGE(PG8_SB(1, 1), b3 + hstep, voffB);
            PG8_WAIT_V(6); PG8_BAR; PG8_MMA(1, 1, At, B1); PG8_BAR;
            }
        }
        if constexpr (ALIGN_EPI) { if (wr == 0) PG8_BAR; }
        if constexpr (!Epi::AFTER_DRAIN) { E(acc, cur, wr, wc, fr, fq); S.done(cur); }
        if (!has_next) break;
        if constexpr (Epi::HAS_INIT) { E.init(acc, nxt, wr, wc, fr, fq); asm volatile("s_waitcnt vmcnt(0)" ::: "memory"); } else {
#pragma unroll
        for (int a = 0; a < 2; ++a)
#pragma unroll
            for (int b = 0; b < 2; ++b)
#pragma unroll
                for (int m = 0; m < 4; ++m)
#pragma unroll
                    for (int n = 0; n < 2; ++n) acc[a][b][m][n] = (f32x4){0.f, 0.f, 0.f, 0.f};
        }
        cur = nxt; cA = nA; cB = nB; ++ui;
        if constexpr (Epi::HAS_PRE) E.pre(cur, wr, wc, fr, fq);
        if constexpr (ALIGN_EPI) { if (wr == 1) PG8_BAR; }
    }
    PG8_WAIT_V(0);
    if constexpr (!ALIGN_EPI) { if (wr == 0) PG8_BAR; }
    PG8_BAR;
    if constexpr (Epi::AFTER_DRAIN) { E.fused(acc, cur, wr, wc, fr, fq, lds, wid, lane); S.done(cur); }
#undef PG8_SA
#undef PG8_SB
#undef PG8_STAGE
#undef PG8_LDA
#undef PG8_LDB
#undef PG8_MMA
#undef PG8_WAIT_V
#undef PG8_WAIT_L
#undef PG8_BAR
#undef PG8_SCHED
}
}

constexpr int BATCH = 32, SEQ = 2048, DM = 1024, M = BATCH * SEQ, NMETA = 16, TT = SEQ + NMETA;
constexpr int SKV = 2176, SKV_ATT = 2112, NPAD = SKV_ATT - TT;
constexpr int NIN = 5632, DFF = 2816, HD = 128;
constexpr float EPS = 1e-6f;
constexpr size_t MiB = 1u << 20;
constexpr size_t WS_WIN = 2 * MiB, WS_WOUT = 14 * MiB, WS_WFI = 16 * MiB, WS_WFO = 28 * MiB, WS_WG = 34 * MiB, WS_ROPE = 35 * MiB,
                 WS_METAP = 35 * MiB + 65536, WS_XRM = 35 * MiB + 262144, WS_SS = 36 * MiB,
                 WS_XN = 64 * MiB, WS_Q = 192 * MiB, WS_KRAW = 320 * MiB, WS_KF = 352 * MiB, WS_VF = 388 * MiB, WS_XR = 424 * MiB,
                 WS_GG = 552 * MiB, WS_GA = 680 * MiB, WS_HF = 808 * MiB, WS_END = 936 * MiB;
constexpr size_t WS_RT = WS_XN, WS_H1B = WS_XR, WS_ACT = WS_GG, WS_MIX = WS_HF;
constexpr int LDS_BYTES = 147456;
#define LAS __attribute__((address_space(3)))
typedef unsigned short bf16_t;
typedef short bf16x8 __attribute__((ext_vector_type(8)));
typedef float f32x4 __attribute__((ext_vector_type(4)));
typedef float f32x2 __attribute__((ext_vector_type(2)));
typedef unsigned u32x4 __attribute__((ext_vector_type(4)));
typedef unsigned u32x2 __attribute__((ext_vector_type(2)));

__device__ __forceinline__ unsigned pk2(float lo, float hi) { unsigned r; asm volatile("v_cvt_pk_bf16_f32 %0, %1, %2" : "=v"(r) : "v"(lo), "v"(hi)); return r; }
__device__ __forceinline__ float bflo(unsigned w) { return __uint_as_float(w << 16); }
__device__ __forceinline__ float bfhi(unsigned w) { return __uint_as_float(w & 0xffff0000u); }
__device__ __forceinline__ float bf1(bf16_t v) { return __uint_as_float((unsigned)v << 16); }
__device__ __forceinline__ float sigm(float x) { return __builtin_amdgcn_rcpf(1.f + __builtin_amdgcn_exp2f(-1.4426950408889634f * x)); }
__device__ __forceinline__ float gelu_t(float x) { const float z = 1.5957691216057308f * (x + 0.044715f * x * x * x); return x * sigm(z); }
__device__ __forceinline__ float wave_sum(float v) {
#pragma unroll
    for (int o = 1; o < 64; o <<= 1) v += __shfl_xor(v, o);
    return v;
}
#define LDS_WAIT() asm volatile("s_waitcnt lgkmcnt(0)" ::: "memory")
#define LBAR() do { asm volatile("s_waitcnt lgkmcnt(0)" ::: "memory"); __builtin_amdgcn_s_barrier(); asm volatile("" ::: "memory"); } while (0)

struct Epi1 {
    static constexpr bool PERM = true, AFTER_DRAIN = false, HAS_INIT = false, HAS_PRE = false;
    bf16_t *Q, *KRAW, *VF, *XR, *GG, *GA;
    __device__ __forceinline__ void operator()(const pg8::f32x4 (&acc)[2][2][4][2], const pg8::Unit& u, int wr, int wc, int fr, int fq) const {
        const int pn = u.pn; const int row0 = u.pm * 256 + wr * 64 + fr; const int cl = wc * 32 + 8 * fq;
        if (pn >= 10 && pn < 18) {
#pragma unroll
            for (int ai = 0; ai < 2; ++ai)
#pragma unroll
                for (int m = 0; m < 4; ++m) { const size_t row = row0 + ai * 128 + m * 16;
                    unsigned wv[4];
#pragma unroll
                    for (int n = 0; n < 2; ++n)
#pragma unroll
                        for (int e2 = 0; e2 < 2; ++e2) { const f32x2 x = {acc[ai][0][m][n][2 * e2], acc[ai][0][m][n][2 * e2 + 1]}, y = {acc[ai][1][m][n][2 * e2], acc[ai][1][m][n][2 * e2 + 1]};
                            const f32x2 tz = x * ((x * x) * (f32x2){-0.10294324f, -0.10294324f} + (f32x2){-2.3022082f, -2.3022082f}), ty = y * (f32x2){-1.4426950408889634f, -1.4426950408889634f};
                            const f32x2 dz = (f32x2){__builtin_amdgcn_exp2f(tz.x), __builtin_amdgcn_exp2f(tz.y)} + (f32x2){1.f, 1.f}, dy = (f32x2){__builtin_amdgcn_exp2f(ty.x), __builtin_amdgcn_exp2f(ty.y)} + (f32x2){1.f, 1.f};
                            const f32x2 dd = dz * dy; const f32x2 o = x * (f32x2){__builtin_amdgcn_rcpf(dd.x), __builtin_amdgcn_rcpf(dd.y)};
                            wv[n * 2 + e2] = pk2(o.x, o.y); }
                    u32x4 w; w.x = wv[0]; w.y = wv[1]; w.z = wv[2]; w.w = wv[3];
                    *(u32x4*)(GG + row * 1024 + (pn - 10) * 128 + cl) = w; }
            return;
        }
        bf16_t* base; int ld, colb; bool sg = false;
        if (pn < 4) { base = Q; ld = 1024; colb = pn * 256; }
        else if (pn == 4) { base = KRAW; ld = 256; colb = 0; }
        else if (pn == 5) { const int b = (u.pm * 256) >> 11, s0 = (u.pm * 256) & 2047;
            base = VF + ((size_t)(b * 2) * SKV + 16 + s0) * 128 - (size_t)(u.pm * 256) * 128; ld = 128; colb = 0; }
        else if (pn < 10) { base = XR; ld = 1024; colb = (pn - 6) * 256; }
        else { base = GA; ld = 1024; colb = (pn - 18) * 256; sg = true; }
        const size_t bjstep = (pn == 5) ? (size_t)SKV * 128 : 128;
#pragma unroll
        for (int ai = 0; ai < 2; ++ai)
#pragma unroll
            for (int m = 0; m < 4; ++m) { const size_t row = row0 + ai * 128 + m * 16;
#pragma unroll
                for (int bj = 0; bj < 2; ++bj) { pg8::f32x4 v0 = acc[ai][bj][m][0], v1 = acc[ai][bj][m][1];
                    if (sg) {
#define SG2(A, B) { const f32x2 t_ = (f32x2){A, B} * (f32x2){-1.4426950408889634f, -1.4426950408889634f}; const f32x2 d_ = (f32x2){__builtin_amdgcn_exp2f(t_.x), __builtin_amdgcn_exp2f(t_.y)} + (f32x2){1.f, 1.f}; A = __builtin_amdgcn_rcpf(d_.x); B = __builtin_amdgcn_rcpf(d_.y); }
                        SG2(v0[0], v0[1]) SG2(v0[2], v0[3]) SG2(v1[0], v1[1]) SG2(v1[2], v1[3])
#undef SG2
                    }
                    u32x4 w; w.x = pk2(v0[0], v0[1]); w.y = pk2(v0[2], v0[3]); w.z = pk2(v1[0], v1[1]); w.w = pk2(v1[2], v1[3]);
                    *(u32x4*)(base + row * ld + colb + bj * bjstep + cl) = w; } }
    }
};
struct Epi2 {
    static constexpr bool PERM = true, AFTER_DRAIN = false, HAS_INIT = true, HAS_PRE = false;
    const float* X; float* H1; bf16_t* H1B; float* SS;
    __device__ __forceinline__ void init(pg8::f32x4 (&acc)[2][2][4][2], const pg8::Unit& u, int wr, int wc, int fr, int fq) const {
        const int row0 = u.pm * 256 + wr * 64 + fr; const int c0 = u.pn * 256 + wc * 32 + 8 * fq;
#pragma unroll
        for (int ai = 0; ai < 2; ++ai)
#pragma unroll
            for (int m = 0; m < 4; ++m)
#pragma unroll
                for (int bj = 0; bj < 2; ++bj) { const size_t off = (size_t)(row0 + ai * 128 + m * 16) * 1024 + c0 + bj * 128;
                    acc[ai][bj][m][0] = *(const pg8::f32x4*)(X + off); acc[ai][bj][m][1] = *(const pg8::f32x4*)(X + off + 4); }
    }
    __device__ __forceinline__ void operator()(const pg8::f32x4 (&acc)[2][2][4][2], const pg8::Unit& u, int wr, int wc, int fr, int fq) const {
        const int row0 = u.pm * 256 + wr * 64 + fr; const int c0 = u.pn * 256 + wc * 32 + 8 * fq;
#pragma unroll
        for (int ai = 0; ai < 2; ++ai)
#pragma unroll
            for (int m = 0; m < 4; ++m) { const size_t row = row0 + ai * 128 + m * 16; float ss = 0.f;
#pragma unroll
                for (int bj = 0; bj < 2; ++bj) { const size_t off = row * 1024 + c0 + bj * 128;
                    const pg8::f32x4 v0 = acc[ai][bj][m][0], v1 = acc[ai][bj][m][1];
                    u32x4 w; w.x = pk2(v0[0], v0[1]); w.y = pk2(v0[2], v0[3]); w.z = pk2(v1[0], v1[1]); w.w = pk2(v1[2], v1[3]);
                    *(u32x4*)(H1B + off) = w;
                    ss += (v0[0] * v0[0] + v0[1] * v0[1]) + (v0[2] * v0[2] + v0[3] * v0[3]) + (v1[0] * v1[0] + v1[1] * v1[1]) + (v1[2] * v1[2] + v1[3] * v1[3]); }
                ss += __shfl_xor(ss, 16); ss += __shfl_xor(ss, 32);
                if (fq == 0) atomicAdd(SS + row, ss); }
    }
};
struct Epi3 {
    static constexpr bool PERM = true, AFTER_DRAIN = false, HAS_INIT = false, HAS_PRE = true;
    const float* SS; bf16_t* ACT; mutable float rs[8];
    __device__ __forceinline__ void pre(const pg8::Unit& u, int wr, int wc, int fr, int fq) const {
        const int row0 = u.pm * 256 + wr * 64 + fr;
#pragma unroll
        for (int ai = 0; ai < 2; ++ai)
#pragma unroll
            for (int m = 0; m < 4; ++m) rs[ai * 4 + m] = SS[row0 + ai * 128 + m * 16];
    }
    __device__ __forceinline__ void operator()(const pg8::f32x4 (&acc)[2][2][4][2], const pg8::Unit& u, int wr, int wc, int fr, int fq) const {
        const int row0 = u.pm * 256 + wr * 64 + fr; const int c0 = u.pn * 128 + wc * 32 + 8 * fq;
#pragma unroll
        for (int ai = 0; ai < 2; ++ai)
#pragma unroll
            for (int m = 0; m < 4; ++m) { const size_t row = row0 + ai * 128 + m * 16;
                const float rstd = __builtin_amdgcn_rsqf(rs[ai * 4 + m] * (1.f / 1024.f) + EPS);
                const float nrs = -1.4426950408889634f * rstd, rq = rstd * rstd; const f32x2 nrs2 = {nrs, nrs}, rq2 = {rq, rq}; unsigned wv[4];
#pragma unroll
                for (int n = 0; n < 2; ++n)
#pragma unroll
                    for (int e2 = 0; e2 < 2; ++e2) { const f32x2 ag = {acc[ai][0][m][n][2 * e2], acc[ai][0][m][n][2 * e2 + 1]}, au = {acc[ai][1][m][n][2 * e2], acc[ai][1][m][n][2 * e2 + 1]};
                        const f32x2 t = ag * nrs2;
                        const f32x2 d = (f32x2){__builtin_amdgcn_exp2f(t.x), __builtin_amdgcn_exp2f(t.y)} + (f32x2){1.f, 1.f};
                        const f32x2 o = (ag * au) * ((f32x2){__builtin_amdgcn_rcpf(d.x), __builtin_amdgcn_rcpf(d.y)} * rq2);
                        wv[n * 2 + e2] = pk2(o.x, o.y); }
                u32x4 w; w.x = wv[0]; w.y = wv[1]; w.z = wv[2]; w.w = wv[3];
                *(u32x4*)(ACT + row * DFF + c0) = w; }
    }
};
struct Epi4 {
    static constexpr bool PERM = true, AFTER_DRAIN = false, HAS_INIT = false, HAS_PRE = false;
    const bf16_t* H1B; float* OUT;
    __device__ __forceinline__ void operator()(const pg8::f32x4 (&acc)[2][2][4][2], const pg8::Unit& u, int wr, int wc, int fr, int fq) const {
        const int row0 = u.pm * 256 + wr * 64 + fr; const int c0 = u.pn * 256 + wc * 32 + 8 * fq;
#pragma unroll
        for (int ai = 0; ai < 2; ++ai)
#pragma unroll
            for (int m = 0; m < 4; ++m) {
#pragma unroll
                for (int bj = 0; bj < 2; ++bj) { const size_t off = (size_t)(row0 + ai * 128 + m * 16) * 1024 + c0 + bj * 128;
                    const u32x4 h = *(const u32x4*)(H1B + off);
                    const pg8::f32x4 x0 = (pg8::f32x4){bflo(h.x), bfhi(h.x), bflo(h.y), bfhi(h.y)}, x1 = (pg8::f32x4){bflo(h.z), bfhi(h.z), bflo(h.w), bfhi(h.w)};
                    __builtin_nontemporal_store(acc[ai][bj][m][0] + x0, (pg8::f32x4*)(OUT + off)); __builtin_nontemporal_store(acc[ai][bj][m][1] + x1, (pg8::f32x4*)(OUT + off + 4)); }
                }
    }
};

struct P {
    const float *x, *meta, *g1, *w_in, *conv_w, *conv_b, *rg_wa, *rg_ba, *rg_wx, *rg_bx, *rg_lam, *qg, *kg, *w_out, *g2, *w_fi, *w_fo;
    float* out; unsigned char* ws;
};
__device__ __forceinline__ void tr_item(const float* W, int K, int N, bf16_t* WT, int k0, int n0s, int n0d, const float* ksc, LAS float* scr, int lane) {
    float tv[32];
#pragma unroll
    for (int i = 0; i < 32; ++i) { const int kk = 2 * i + (lane >> 5); tv[i] = W[(size_t)(k0 + kk) * N + n0s + (lane & 31)]; }
    if (ksc) {
#pragma unroll
        for (int i = 0; i < 32; ++i) tv[i] *= ksc[k0 + 2 * i + (lane >> 5)]; }
#pragma unroll
    for (int i = 0; i < 32; ++i) { const int kk = 2 * i + (lane >> 5); scr[kk * 33 + (lane & 31)] = tv[i]; }
    LDS_WAIT(); asm volatile("" ::: "memory");
    const int c = lane & 7;
#pragma unroll
    for (int j = 0; j < 4; ++j) { const int n = (lane >> 3) + 8 * j; const LAS float* s = scr + (8 * c) * 33 + n;
        u32x4 o; o.x = pk2(s[0 * 33], s[1 * 33]); o.y = pk2(s[2 * 33], s[3 * 33]); o.z = pk2(s[4 * 33], s[5 * 33]); o.w = pk2(s[6 * 33], s[7 * 33]);
        *(u32x4*)(WT + (size_t)(n0d + n) * K + k0 + 8 * c) = o; }
    LDS_WAIT(); asm volatile("" ::: "memory");
}
__device__ __forceinline__ int win_src_col(int nd) {
    if (nd < 2560) return nd;
    if (nd < 4608) { const int r = nd - 2560, t = r >> 8, half = (r >> 7) & 1, c = r & 127; return (half ? 4608 : 2560) + 128 * t + c; }
    return 3584 + (nd - 4608);
}
__device__ __forceinline__ void p0_prologue(const P& p, unsigned char* ldsg, int vcu, int G) {
    const int tid = threadIdx.x, lane = tid & 63, wave = tid >> 6;
    unsigned char* ws = p.ws;
    if (blockIdx.x < 192) {
        float* xm = (float*)ldsg;
        float* red = (float*)(ldsg + 65536);
        for (int r = wave * 2; r < wave * 2 + 2; ++r) {
            const f32x4* xr = (const f32x4*)(p.meta + r * 1024) + lane; f32x4 v[4]; float s = 0.f;
#pragma unroll
            for (int j = 0; j < 4; ++j) { v[j] = xr[64 * j]; s += (v[j][0] * v[j][0] + v[j][1] * v[j][1]) + (v[j][2] * v[j][2] + v[j][3] * v[j][3]); }
            const float rstd = __builtin_amdgcn_rsqf(wave_sum(s) * (1.f / 1024.f) + EPS);
#pragma unroll
            for (int j = 0; j < 4; ++j) { const f32x4 g = ((const f32x4*)p.g1)[lane + 64 * j]; ((f32x4*)(xm + r * 1024))[lane + 64 * j] = v[j] * rstd * g; }
        }
        __syncthreads();
        float* METAP = (float*)(ws + WS_METAP); bf16_t* XRM = (bf16_t*)(ws + WS_XRM);
        for (int cgi = blockIdx.x; cgi < 192; cgi += G) {
            const int c = tid & 7, ks = tid >> 3, col = cgi * 8 + c; float acc[16];
#pragma unroll
            for (int r = 0; r < 16; ++r) acc[r] = 0.f;
#pragma unroll 16
            for (int k = ks * 16; k < ks * 16 + 16; ++k) { const float w = p.w_in[(size_t)k * NIN + 1024 + col];
#pragma unroll
                for (int r = 0; r < 16; ++r) acc[r] += xm[r * 1024 + k] * w; }
#pragma unroll
            for (int r = 0; r < 16; ++r) red[(ks * 16 + r) * 8 + c] = acc[r];
            __syncthreads();
            if (tid < 128) { const int r = tid >> 3, c2 = tid & 7; float s = 0.f;
                for (int q = 0; q < 64; ++q) s += red[(q * 16 + r) * 8 + c2];
                const int cc = cgi * 8 + c2; METAP[r * 1536 + cc] = s;
                if (cc >= 512) XRM[r * 1024 + cc - 512] = (bf16_t)(pk2(s, s) & 0xffffu); }
            __syncthreads();
        }
    }
    if (blockIdx.x == (unsigned)(G - 1)) {
        f32x2* ROPE = (f32x2*)(ws + WS_ROPE);
        for (int idx = tid; idx < 2048; idx += 512) { const int pos = idx >> 5, i = idx & 31;
            double invf = 1.0; for (int q = 0; q < i; ++q) invf *= 0.74989420933245582730;
            const double a = (double)pos * invf; const double nq = __builtin_rint(a * 0.63661977236758134308); const double r = (a - nq * 1.57079632679489655800) - nq * 6.123233995736766e-17;
            const double r2 = r * r;
            const double sn = r * (1.0 + r2 * (-1.0 / 6 + r2 * (1.0 / 120 + r2 * (-1.0 / 5040 + r2 * (1.0 / 362880 + r2 * (-1.0 / 39916800 + r2 * (1.0 / 6227020800.0)))))));
            const double cs = 1.0 + r2 * (-0.5 + r2 * (1.0 / 24 + r2 * (-1.0 / 720 + r2 * (1.0 / 40320 + r2 * (-1.0 / 3628800 + r2 * (1.0 / 479001600.0))))));
            const int qd = ((int)nq) & 3; double c, s;
            if (qd == 0) { c = cs; s = sn; } else if (qd == 1) { c = -sn; s = cs; } else if (qd == 2) { c = -cs; s = -sn; } else { c = sn; s = -cs; }
            ROPE[idx] = (f32x2){(float)c, (float)s}; }
    }
    for (int i = blockIdx.x * 512 + tid; i < M; i += G * 512) ((float*)(ws + WS_SS))[i] = 0.f;
    LAS float* scr = (LAS float*)((LAS unsigned char*)ldsg + wave * 16384);
    const int gw = vcu * 8 + wave, NGW = G * 8;
    constexpr int I_IN = 16 * 176, I_OUT = 16 * 32, I_FI = 16 * 176, I_FO = 44 * 32, I_G = 32 * 8;
    constexpr int NITEMS = I_IN + I_OUT + I_FI + I_FO + I_G;
    bf16_t* XN = (bf16_t*)(ws + WS_XN);
    f32x4 g[4];
#pragma unroll
    for (int j = 0; j < 4; ++j) g[j] = ((const f32x4*)p.g1)[lane + 64 * j];
    for (int pass = 0; pass < 2; ++pass) {
      if ((pass == 0) == ((wave & 1) == 0)) {
    for (int it = gw; it < NITEMS; it += NGW) {
        int r = it;
        if (r < I_IN) { const int kb = r / 176, nb = r % 176; tr_item(p.w_in, 1024, NIN, (bf16_t*)(ws + WS_WIN), 64 * kb, win_src_col(32 * nb), 32 * nb, nullptr, scr, lane); continue; } r -= I_IN;
        if (r < I_OUT) { const int kb = r / 32, nb = r % 32; tr_item(p.w_out, 1024, 1024, (bf16_t*)(ws + WS_WOUT), 64 * kb, 32 * nb, 32 * nb, nullptr, scr, lane); continue; } r -= I_OUT;
        if (r < I_FI) { const int kb = r / 176, nb = r % 176, nd = 32 * nb, t = nd >> 8, half = (nd >> 7) & 1, c = nd & 127;
            tr_item(p.w_fi, 1024, 2 * DFF, (bf16_t*)(ws + WS_WFI), 64 * kb, (half ? DFF : 0) + 128 * t + c, nd, p.g2, scr, lane); continue; } r -= I_FI;
        if (r < I_FO) { const int kb = r / 32, nb = r % 32; tr_item(p.w_fo, DFF, 1024, (bf16_t*)(ws + WS_WFO), 64 * kb, 32 * nb, 32 * nb, nullptr, scr, lane); continue; } r -= I_FO;
        { const int mi = r >> 3, sub = r & 7, gate = mi >> 4, dir = (mi >> 3) & 1, n = mi & 7, kb = sub >> 2, nb = sub & 3;
          const float* src = (gate ? p.rg_wx : p.rg_wa) + (size_t)(dir * 8 + n) * 16384;
          tr_item(src, 128, 128, (bf16_t*)(ws + WS_WG) + (size_t)((dir * 2 + gate) * 8 + n) * 16384, 64 * kb, 32 * nb, 32 * nb, nullptr, scr, lane); }
    }
      } else {
    for (int m = gw; m < M; m += 2 * NGW) {
        const int m2 = m + NGW;
        const f32x4* xr = (const f32x4*)(p.x + (size_t)m * 1024) + lane; const f32x4* xr2 = (const f32x4*)(p.x + (size_t)(m2 < M ? m2 : m) * 1024) + lane;
        f32x4 v[4], v2[4]; float s = 0.f, s2 = 0.f;
#pragma unroll
        for (int j = 0; j < 4; ++j) { v[j] = __builtin_nontemporal_load(xr + 64 * j); v2[j] = __builtin_nontemporal_load(xr2 + 64 * j); }
#pragma unroll
        for (int j = 0; j < 4; ++j) { s += (v[j][0] * v[j][0] + v[j][1] * v[j][1]) + (v[j][2] * v[j][2] + v[j][3] * v[j][3]); s2 += (v2[j][0] * v2[j][0] + v2[j][1] * v2[j][1]) + (v2[j][2] * v2[j][2] + v2[j][3] * v2[j][3]); }
        const float rstd = __builtin_amdgcn_rsqf(wave_sum(s) * (1.f / 1024.f) + EPS), rstd2 = __builtin_amdgcn_rsqf(wave_sum(s2) * (1.f / 1024.f) + EPS);
        u32x2* o8 = (u32x2*)(XN + (size_t)m * 1024) + lane;
#pragma unroll
        for (int j = 0; j < 4; ++j) { const f32x4 y = v[j] * rstd * g[j]; o8[64 * j] = (u32x2){pk2(y[0], y[1]), pk2(y[2], y[3])}; }
        if (m2 < M) { u32x2* o82 = (u32x2*)(XN + (size_t)m2 * 1024) + lane;
#pragma unroll
            for (int j = 0; j < 4; ++j) { const f32x4 y = v2[j] * rstd2 * g[j]; o82[64 * j] = (u32x2){pk2(y[0], y[1]), pk2(y[2], y[3])}; } }
    }
      }
    }
}

__device__ __forceinline__ void p2_kpass(const P& p, int vcu, int G) {
    unsigned char* ws = p.ws;
    const int tid = threadIdx.x, j = tid & 15;
    const int gidx = vcu * 32 + (tid >> 4), NG = G * 32;
    const bf16_t* KRAW = (const bf16_t*)(ws + WS_KRAW); bf16_t* KF = (bf16_t*)(ws + WS_KF); bf16_t* VF = (bf16_t*)(ws + WS_VF);
    const f32x2* ROPE = (const f32x2*)(ws + WS_ROPE); const float* METAP = (const float*)(ws + WS_METAP);
    float kg[8];
#pragma unroll
    for (int e = 0; e < 8; ++e) kg[e] = p.kg[8 * j + e];
    for (int task0 = gidx; task0 < 2 * M; task0 += 4 * NG) {
        u32x4 raw[4]; f32x4 csv[4][4];
#pragma unroll
        for (int q = 0; q < 4; ++q) { const int task = task0 + q * NG; const int tk = task < 2 * M ? task : task0; const int row = tk >> 1, h = tk & 1, s = row & 2047;
            raw[q] = *(const u32x4*)(KRAW + (size_t)row * 256 + h * 128 + 8 * j);
            const int pos = (j >> 3) ? (s & 63) : (s >> 6); const f32x4* cs = (const f32x4*)(ROPE + pos * 32 + 8 * (j & 3));
#pragma unroll
            for (int e2 = 0; e2 < 4; ++e2) csv[q][e2] = cs[e2]; }
#pragma unroll
        for (int q = 0; q < 4; ++q) { const int task = task0 + q * NG; if (task < 2 * M) { const int row = task >> 1, h = task & 1, b = row >> 11, s = row & 2047;
            float y[8] = {bflo(raw[q].x), bfhi(raw[q].x), bflo(raw[q].y), bfhi(raw[q].y), bflo(raw[q].z), bfhi(raw[q].z), bflo(raw[q].w), bfhi(raw[q].w)};
            float ss = 0.f;
#pragma unroll
            for (int e = 0; e < 8; ++e) ss += y[e] * y[e];
            ss += __shfl_xor(ss, 1); ss += __shfl_xor(ss, 2); ss += __shfl_xor(ss, 4); ss += __shfl_xor(ss, 8);
            const float rstd = __builtin_amdgcn_rsqf(ss * (1.f / 128.f) + EPS);
            float o[8];
#pragma unroll
            for (int e2 = 0; e2 < 4; ++e2) { const f32x4 c2 = csv[q][e2];
#pragma unroll
                for (int q2 = 0; q2 < 2; ++q2) { const int e = 2 * e2 + q2; const float v = y[e] * rstd * kg[e]; const float pr = __shfl_xor(v, 4);
                    const float c = c2[2 * q2], sn = c2[2 * q2 + 1]; o[e] = (j & 4) ? (v * c + pr * sn) : (v * c - pr * sn); } }
            u32x4 w; w.x = pk2(o[0], o[1]); w.y = pk2(o[2], o[3]); w.z = pk2(o[4], o[5]); w.w = pk2(o[6], o[7]);
            *(u32x4*)(KF + ((size_t)(b * 2 + h) * SKV + 16 + s) * 128 + 8 * j) = w; } }
    }
    for (int task = gidx; task < BATCH * 2 * 128; task += NG) {
        const int bh = task >> 7, pp = task & 127, h = bh & 1;
        u32x4 wk = (u32x4){0u, 0u, 0u, 0u}, wv = wk; int prow;
        if (pp < 16) { prow = pp;
            const float* mk = METAP + pp * 1536 + h * 128 + 8 * j; const float* mv = mk + 256;
            float y[8]; float ss = 0.f;
#pragma unroll
            for (int e = 0; e < 8; ++e) { y[e] = mk[e]; ss += y[e] * y[e]; }
            ss += __shfl_xor(ss, 1); ss += __shfl_xor(ss, 2); ss += __shfl_xor(ss, 4); ss += __shfl_xor(ss, 8);
            const float rstd = __builtin_amdgcn_rsqf(ss * (1.f / 128.f) + EPS);
#pragma unroll
            for (int e = 0; e < 8; ++e) y[e] = y[e] * rstd * kg[e];
            wk.x = pk2(y[0], y[1]); wk.y = pk2(y[2], y[3]); wk.z = pk2(y[4], y[5]); wk.w = pk2(y[6], y[7]);
            wv.x = pk2(mv[0], mv[1]); wv.y = pk2(mv[2], mv[3]); wv.z = pk2(mv[4], mv[5]); wv.w = pk2(mv[6], mv[7]);
        } else { prow = TT + (pp - 16); }
        *(u32x4*)(KF + ((size_t)bh * SKV + prow) * 128 + 8 * j) = wk;
        *(u32x4*)(VF + ((size_t)bh * SKV + prow) * 128 + 8 * j) = wv;
    }
}

__device__ __forceinline__ unsigned rt2_pk(unsigned H, float ha, float hb, unsigned G) { const f32x2 o = ((f32x2){bflo(H), bfhi(H)} + (f32x2){ha, hb}) * (f32x2){bflo(G), bfhi(G)}; return pk2(o.x, o.y); }
constexpr int R_XC = 0, R_AS = 17408, R_US = R_AS + 33792, R_SEG = R_US + 33792, R_ST = R_SEG + 4096, R_CW = R_ST + 1024, R_END = R_CW + 2560;
__device__ __forceinline__ bf16x8 rnn_ld_row(const bf16_t* XRb, const bf16_t* XRMn, int pidx, int coff) {
    bf16x8 z = {0, 0, 0, 0, 0, 0, 0, 0};
    if (pidx < 0 || pidx >= TT) return z;
    if (pidx < NMETA) return *(const bf16x8*)(XRMn + pidx * 1024 + coff);
    return *(const bf16x8*)(XRb + (size_t)(pidx - NMETA) * 1024 + coff);
}
__device__ __forceinline__ void rnn_item(const P& p, unsigned char* ldsg, int b, int n) {
    unsigned char* ws = p.ws;
    const int tid = threadIdx.x, lane = tid & 63, w = tid >> 6, fr = lane & 15, fq = lane >> 4;
    bf16_t* XC = (bf16_t*)(ldsg + R_XC); float* AS = (float*)(ldsg + R_AS); float* US = (float*)(ldsg + R_US);
    float* SEG = (float*)(ldsg + R_SEG); float* ST = (float*)(ldsg + R_ST); float* CW = (float*)(ldsg + R_CW);
    const bf16_t* XRb = (const bf16_t*)(ws + WS_XR) + (size_t)b * SEQ * 1024 + 128 * n;
    const bf16_t* XRMn = (const bf16_t*)(ws + WS_XRM) + 128 * n;
    bf16_t* HF = (bf16_t*)(ws + WS_HF) + (size_t)b * SEQ * 1024 + 128 * n;
    const bf16_t* GG = (const bf16_t*)(ws + WS_GG) + (size_t)b * SEQ * 1024 + 128 * n;
    bf16_t* RT = (bf16_t*)(ws + WS_RT) + (size_t)b * SEQ * 1024 + 128 * n;
    const bf16_t* WG = (const bf16_t*)(ws + WS_WG);
    const int tg0 = tid >> 4, coff0 = 8 * (tid & 15);
    float cwr[5][8];
#pragma unroll
    for (int q = 0; q < 4; ++q) { const f32x4 a = *(const f32x4*)(p.conv_w + q * 1024 + 128 * n + coff0), b2 = *(const f32x4*)(p.conv_w + q * 1024 + 128 * n + coff0 + 4);
        cwr[q][0] = a[0]; cwr[q][1] = a[1]; cwr[q][2] = a[2]; cwr[q][3] = a[3]; cwr[q][4] = b2[0]; cwr[q][5] = b2[1]; cwr[q][6] = b2[2]; cwr[q][7] = b2[3]; }
    { const f32x4 a = *(const f32x4*)(p.conv_b + 128 * n + coff0), b2 = *(const f32x4*)(p.conv_b + 128 * n + coff0 + 4);
      cwr[4][0] = a[0]; cwr[4][1] = a[1]; cwr[4][2] = a[2]; cwr[4][3] = a[3]; cwr[4][4] = b2[0]; cwr[4][5] = b2[1]; cwr[4][6] = b2[2]; cwr[4][7] = b2[3]; }
    for (int dir = 0; dir < 2; ++dir) {
        bf16x8 bfr[2][4];
#pragma unroll
        for (int gate = 0; gate < 2; ++gate)
#pragma unroll
            for (int ks = 0; ks < 4; ++ks) bfr[gate][ks] = *(const bf16x8*)(WG + ((size_t)((dir * 2 + gate) * 8 + n) * 128 + 16 * w + fr) * 128 + 32 * ks + 8 * fq);
        float ba4[4], bx4[4], ls4[4];
#pragma unroll
        for (int r = 0; r < 4; ++r) { const int cgl = dir * 1024 + 128 * n + 16 * w + 4 * fq + r; ba4[r] = -1.4426950408889634f * p.rg_ba[cgl]; bx4[r] = -1.4426950408889634f * p.rg_bx[cgl];
            const float lam = p.rg_lam[cgl]; const float y = __builtin_amdgcn_exp2f(-1.4426950408889634f * lam);
            float l1p; if (y < 0.05f) l1p = y * (1.f + y * (-0.5f + y * (1.f / 3 + y * (-0.25f + y * (0.2f + y * (-1.f / 6)))))); else l1p = __logf(1.f + y);
            ls4[r] = -8.f * 1.4426950408889634f * l1p; }
        if (tid < 128) ST[tid] = 0.f;
        __syncthreads();
        const int nch = dir == 0 ? 33 : 32;
        bf16x8 rows[5];
        { const int ci0 = dir == 0 ? 0 : 32; const int p00 = ci0 == 0 ? -48 : 16 + 64 * (ci0 - 1);
#pragma unroll
          for (int q = 0; q < 5; ++q) rows[q] = rnn_ld_row(XRb, XRMn, p00 + 2 * tg0 - 2 + q, coff0); }
        for (int c = 0; c < nch; ++c) {
            const int ci = dir == 0 ? c : 32 - c; const int p0 = ci == 0 ? -48 : 16 + 64 * (ci - 1);
            const int tq = tid;
            const int lane = tq & 63, w = tq >> 6, fr = lane & 15, fq = lane >> 4, tg = tq >> 4, coff = 8 * (tq & 15), ch = tq & 127, sg = tq >> 7, otok = tq >> 3, ocol = 16 * (tq & 7);
            { f32x2 xf[5][4];
#pragma unroll
              for (int q = 0; q < 5; ++q) { const u32x4 rw = __builtin_bit_cast(u32x4, rows[q]);
                  xf[q][0] = (f32x2){bflo(rw.x), bfhi(rw.x)}; xf[q][1] = (f32x2){bflo(rw.y), bfhi(rw.y)}; xf[q][2] = (f32x2){bflo(rw.z), bfhi(rw.z)}; xf[q][3] = (f32x2){bflo(rw.w), bfhi(rw.w)}; }
              unsigned w0v[4], w1v[4];
#pragma unroll
              for (int e2 = 0; e2 < 4; ++e2) { const f32x2 w0 = {cwr[0][2 * e2], cwr[0][2 * e2 + 1]}, w1 = {cwr[1][2 * e2], cwr[1][2 * e2 + 1]}, w2 = {cwr[2][2 * e2], cwr[2][2 * e2 + 1]}, w3 = {cwr[3][2 * e2], cwr[3][2 * e2 + 1]}, cb = {cwr[4][2 * e2], cwr[4][2 * e2 + 1]};
                  const f32x2 o0 = w3 * xf[3][e2] + (w2 * xf[2][e2] + (w1 * xf[1][e2] + (w0 * xf[0][e2] + cb)));
                  const f32x2 o1 = w3 * xf[4][e2] + (w2 * xf[3][e2] + (w1 * xf[2][e2] + (w0 * xf[1][e2] + cb)));
                  w0v[e2] = pk2(o0.x, o0.y); w1v[e2] = pk2(o1.x, o1.y); }
              u32x4 a0, a1; a0.x = w0v[0]; a0.y = w0v[1]; a0.z = w0v[2]; a0.w = w0v[3]; a1.x = w1v[0]; a1.y = w1v[1]; a1.z = w1v[2]; a1.w = w1v[3];
              *(u32x4*)(XC + (2 * tg) * 136 + coff) = a0; *(u32x4*)(XC + (2 * tg + 1) * 136 + coff) = a1; }
            if (c + 1 < nch) { const int cin = dir == 0 ? c + 1 : 32 - (c + 1); const int pn0 = cin == 0 ? -48 : 16 + 64 * (cin - 1);
                if (cin >= 2 && cin <= 31) {
                    const bf16_t* rp = XRb + (size_t)(pn0 - NMETA + 2 * tg - 2) * 1024 + coff;
#pragma unroll
                    for (int q = 0; q < 5; ++q) rows[q] = *(const bf16x8*)(rp + q * 1024);
                } else {
#pragma unroll
                    for (int q = 0; q < 5; ++q) rows[q] = rnn_ld_row(XRb, XRMn, pn0 + 2 * tg - 2 + q, coff); } }
            u32x4 hfp[2], ggp[2];
            if (dir == 1) { const size_t ro = (size_t)(p0 - NMETA + otok) * 1024 + ocol;
                hfp[0] = *(const u32x4*)(HF + ro); hfp[1] = *(const u32x4*)(HF + ro + 8); ggp[0] = *(const u32x4*)(GG + ro); ggp[1] = *(const u32x4*)(GG + ro + 8); }
            LBAR();
            f32x4 accA[4], accX[4];
#pragma unroll
            for (int tb = 0; tb < 4; ++tb) { accA[tb] = (f32x4){0.f, 0.f, 0.f, 0.f}; accX[tb] = accA[tb];
#pragma unroll
                for (int ks = 0; ks < 4; ++ks) { const bf16x8 yv = *(const bf16x8*)(XC + (16 * tb + fr) * 136 + 32 * ks + 8 * fq);
                    accA[tb] = __builtin_amdgcn_mfma_f32_16x16x32_bf16(bfr[0][ks], yv, accA[tb], 0, 0, 0);
                    accX[tb] = __builtin_amdgcn_mfma_f32_16x16x32_bf16(bfr[1][ks], yv, accX[tb], 0, 0, 0); } }
#pragma unroll
            for (int tb = 0; tb < 4; ++tb) { const int tok = 16 * tb + fr; const u32x2 xw = *(const u32x2*)(XC + tok * 136 + 16 * w + 4 * fq);
                f32x4 av, uv;
#pragma unroll
                for (int h2 = 0; h2 < 2; ++h2) { const unsigned xwh = h2 ? xw.y : xw.x; const f32x2 xc2 = {bflo(xwh), bfhi(xwh)};
                    const f32x2 pa = {accA[tb][2 * h2], accA[tb][2 * h2 + 1]}, px = {accX[tb][2 * h2], accX[tb][2 * h2 + 1]};
                    const f32x2 ta = pa * (f32x2){-1.4426950408889634f, -1.4426950408889634f} + (f32x2){ba4[2 * h2], ba4[2 * h2 + 1]};
                    const f32x2 tx = px * (f32x2){-1.4426950408889634f, -1.4426950408889634f} + (f32x2){bx4[2 * h2], bx4[2 * h2 + 1]};
                    const f32x2 da = (f32x2){__builtin_amdgcn_exp2f(ta.x), __builtin_amdgcn_exp2f(ta.y)} + (f32x2){1.f, 1.f};
                    const f32x2 di = (f32x2){__builtin_amdgcn_exp2f(tx.x), __builtin_amdgcn_exp2f(tx.y)} + (f32x2){1.f, 1.f};
                    const f32x2 rr = {__builtin_amdgcn_rcpf(da.x), __builtin_amdgcn_rcpf(da.y)}, ii = {__builtin_amdgcn_rcpf(di.x), __builtin_amdgcn_rcpf(di.y)};
                    const f32x2 la = rr * (f32x2){ls4[2 * h2], ls4[2 * h2 + 1]};
                    const f32x2 a2 = {__builtin_amdgcn_exp2f(la.x), __builtin_amdgcn_exp2f(la.y)};
                    const f32x2 om = (f32x2){1.f, 1.f} - a2 * a2;
                    const f32x2 sq = {__builtin_amdgcn_sqrtf(om.x), __builtin_amdgcn_sqrtf(om.y)};
                    const f32x2 u2 = sq * (ii * xc2);
                    av[2 * h2] = a2.x; av[2 * h2 + 1] = a2.y; uv[2 * h2] = u2.x; uv[2 * h2 + 1] = u2.y; }
                *(f32x4*)(AS + tok * 132 + 16 * w + 4 * fq) = av; *(f32x4*)(US + tok * 132 + 16 * w + 4 * fq) = uv; }
            if (ci == 0) {
#pragma unroll
                for (int tb = 0; tb < 3; ++tb) { const int tok = 16 * tb + fr; *(f32x4*)(AS + tok * 132 + 16 * w + 4 * fq) = (f32x4){1.f, 1.f, 1.f, 1.f}; *(f32x4*)(US + tok * 132 + 16 * w + 4 * fq) = (f32x4){0.f, 0.f, 0.f, 0.f}; } }
            LBAR();
            float hl[16], ac[16]; float hh = 0.f, aa = 1.f;
            const int tstep = dir == 0 ? 132 : -132; int sidx = (dir == 0 ? 16 * sg : 63 - 16 * sg) * 132 + ch;
#pragma unroll
            for (int i = 0; i < 16; ++i) { const float a = AS[sidx], u = US[sidx]; sidx += tstep; hh = a * hh + u; aa *= a; hl[i] = hh; ac[i] = aa; }
            SEG[sg * 128 + ch] = aa; SEG[512 + sg * 128 + ch] = hh;
            LBAR();
            float carry = ST[(c & 1) * 128 + ch];
#pragma unroll
            for (int s2 = 0; s2 < 3; ++s2) if (s2 < sg) carry = SEG[s2 * 128 + ch] * carry + SEG[512 + s2 * 128 + ch];
            if (sg == 3) ST[((c + 1) & 1) * 128 + ch] = aa * carry + hh;
            if (ci > 0) {
                int widx = (dir == 0 ? 16 * sg : 63 - 16 * sg) * 132 + ch;
#pragma unroll
                for (int i = 0; i < 16; i += 2) { const f32x2 hv = (f32x2){hl[i], hl[i + 1]} + (f32x2){ac[i], ac[i + 1]} * (f32x2){carry, carry};
                    AS[widx] = hv.x; AS[widx + tstep] = hv.y; widx += 2 * tstep; }
                LBAR();
                const size_t ro = (size_t)(p0 - NMETA + otok) * 1024 + ocol; const f32x4* hp = (const f32x4*)(AS + otok * 132 + ocol);
                const f32x4 h0 = hp[0], h1 = hp[1], h2 = hp[2], h3 = hp[3];
                if (dir == 0) {
                    u32x4 o0, o1; o0.x = pk2(h0[0], h0[1]); o0.y = pk2(h0[2], h0[3]); o0.z = pk2(h1[0], h1[1]); o0.w = pk2(h1[2], h1[3]);
                    o1.x = pk2(h2[0], h2[1]); o1.y = pk2(h2[2], h2[3]); o1.z = pk2(h3[0], h3[1]); o1.w = pk2(h3[2], h3[3]);
                    *(u32x4*)(HF + ro) = o0; *(u32x4*)(HF + ro + 8) = o1;
                } else {
#define RT2(H, HA, HB, G) rt2_pk(H, HA, HB, G)
                    u32x4 o0, o1; o0.x = RT2(hfp[0].x, h0[0], h0[1], ggp[0].x); o0.y = RT2(hfp[0].y, h0[2], h0[3], ggp[0].y); o0.z = RT2(hfp[0].z, h1[0], h1[1], ggp[0].z); o0.w = RT2(hfp[0].w, h1[2], h1[3], ggp[0].w);
                    o1.x = RT2(hfp[1].x, h2[0], h2[1], ggp[1].x); o1.y = RT2(hfp[1].y, h2[2], h2[3], ggp[1].y); o1.z = RT2(hfp[1].z, h3[0], h3[1], ggp[1].z); o1.w = RT2(hfp[1].w, h3[2], h3[3], ggp[1].w);
#undef RT2
                    *(u32x4*)(RT + ro) = o0; *(u32x4*)(RT + ro + 8) = o1;
                }
            }
        }
        __syncthreads();
    }
}

namespace att {
using bf16 = __hip_bfloat16;
constexpr int   D = 128, NW = 8, QBLK = 32, KVBLK = 64;
constexpr float SCALE = 0.088388347648318440f;
constexpr float THR = 8.f;
constexpr int SDEPTH = 2;
constexpr int NPADK = NPAD;
constexpr size_t SHM_V = KVBLK * D * 2, SHM_K = KVBLK * D * 2, SHM_ATTN = 2 * SHM_V + 2 * SHM_K + NW * 64 * 4;
using bf16x8 = __attribute__((ext_vector_type(8))) short;
using s16x4  = __attribute__((ext_vector_type(4))) short;
using f32x16 = __attribute__((ext_vector_type(16))) float;
using f32x8  = __attribute__((ext_vector_type(8))) float;
using u32x4  = __attribute__((ext_vector_type(4))) unsigned;
#define KSWZ(row, colB) ((row) * 256 + ((colB) ^ (((row) & 7) << 4)))
#define SBAR() __builtin_amdgcn_sched_barrier(0)
__device__ __forceinline__ int crow(int r, int hi) { return (r & 3) + 8 * (r >> 2) + 4 * hi; }
__device__ __forceinline__ unsigned cvtpk(float lo, float hi) {
  unsigned r; asm volatile("v_cvt_pk_bf16_f32 %0, %1, %2" : "=v"(r) : "v"(lo), "v"(hi)); return r;
}
template <typename TIn> struct Stage;
template <> struct Stage<bf16>  { using T = bf16x8;
  __device__ static __forceinline__ T ld8(const bf16* p) { return *reinterpret_cast<const bf16x8*>(p); }
  __device__ static __forceinline__ bf16x8 tobf(T x) { return x; } };
template <> struct Stage<float> { using T = f32x8;
  __device__ static __forceinline__ T ld8(const float* p) { return *reinterpret_cast<const f32x8*>(p); }
  __device__ static __forceinline__ bf16x8 tobf(T x) {
    u32x4 w = {cvtpk(x[0], x[1]), cvtpk(x[2], x[3]), cvtpk(x[4], x[5]), cvtpk(x[6], x[7])}; return *reinterpret_cast<bf16x8*>(&w); } };

__device__ __forceinline__ void partialSM(f32x16& p0, f32x16& p1, float& m_reg, float& mn, float& alpha) {
  constexpr float C = SCALE * 1.4426950408889634f;
  float pmax = p0[0]; for (int r = 1; r < 16; ++r) pmax = fmaxf(pmax, p0[r]); for (int r = 0; r < 16; ++r) pmax = fmaxf(pmax, p1[r]);
  { auto rr = __builtin_amdgcn_permlane32_swap(__float_as_uint(pmax), __float_as_uint(pmax), false, false);
    pmax = fmaxf(__uint_as_float(rr[0]), __uint_as_float(rr[1])); }
  if (__builtin_expect(__all(pmax - m_reg <= THR / SCALE), 1)) { mn = m_reg; alpha = 1.f; }
  else { mn = fmaxf(m_reg, pmax); alpha = __builtin_amdgcn_exp2f((m_reg - mn) * C); m_reg = mn; }
  float mnC = -mn * C;
  for (int r = 0; r < 16; ++r) p0[r] = fmaf(p0[r], C, mnC); for (int r = 0; r < 16; ++r) p1[r] = fmaf(p1[r], C, mnC);
  for (int r = 0; r < 16; ++r) p0[r] = __builtin_amdgcn_exp2f(p0[r]);
}
__device__ __forceinline__ void partialSM_fixed(f32x16& p0, f32x16& p1, float mnC) {
  constexpr float C = SCALE * 1.4426950408889634f;
  for (int r = 0; r < 16; ++r) p0[r] = fmaf(p0[r], C, mnC); for (int r = 0; r < 16; ++r) p1[r] = fmaf(p1[r], C, mnC);
  for (int r = 0; r < 16; ++r) p0[r] = __builtin_amdgcn_exp2f(p0[r]);
}
__device__ __forceinline__ void finishSM(f32x16& p0, f32x16& p1, float alpha, float& l_reg, bf16x8& pa0, bf16x8& pa1, bf16x8& pa2, bf16x8& pa3) {
  for (int r = 0; r < 16; ++r) p1[r] = __builtin_amdgcn_exp2f(p1[r]);
  float ps = 0; for (int r = 0; r < 16; ++r) ps += p0[r]; for (int r = 0; r < 16; ++r) ps += p1[r];
  { auto rr = __builtin_amdgcn_permlane32_swap(__float_as_uint(ps), __float_as_uint(ps), false, false);
    ps = __uint_as_float(rr[0]) + __uint_as_float(rr[1]); }
  l_reg = l_reg * alpha + ps;
#define PK4(P, BASE, OUT) do { unsigned a0 = cvtpk(P[BASE + 0], P[BASE + 1]), a1 = cvtpk(P[BASE + 2], P[BASE + 3]);   \
    unsigned b0 = cvtpk(P[BASE + 4], P[BASE + 5]), b1 = cvtpk(P[BASE + 6], P[BASE + 7]);                              \
    auto r0 = __builtin_amdgcn_permlane32_swap(a0, b0, false, false); auto r1 = __builtin_amdgcn_permlane32_swap(a1, b1, false, false); \
    u32x4 w = {r0[0], r1[0], r0[1], r1[1]}; OUT = *reinterpret_cast<bf16x8*>(&w); } while (0)
  PK4(p0, 0, pa0); PK4(p0, 8, pa1); PK4(p1, 0, pa2); PK4(p1, 8, pa3);
#undef PK4
}
__device__ __forceinline__ void qkt(f32x16& p0, f32x16& p1, const bf16* Ks, const bf16x8* qr, int r32, int hi) {
  p0 = f32x16{}; p1 = f32x16{};
  for (int d0 = 0; d0 < 8; ++d0) { int cb = (d0 * 16 + hi * 8) * 2;
    bf16x8 b0 = *reinterpret_cast<const bf16x8*>((const char*)Ks + KSWZ(r32, cb));
    bf16x8 b1 = *reinterpret_cast<const bf16x8*>((const char*)Ks + KSWZ(32 + r32, cb));
    p0 = __builtin_amdgcn_mfma_f32_32x32x16_bf16(b0, qr[d0], p0, 0, 0, 0);
    p1 = __builtin_amdgcn_mfma_f32_32x32x16_bf16(b1, qr[d0], p1, 0, 0, 0); }
}
__device__ __forceinline__ void qkt_ref(f32x16& p0, f32x16& p1, const bf16* Ks, const bf16x8* qr, int r32, int hi, const f32x16& cinit) {
  p0 = cinit; p1 = cinit;
  for (int d0 = 0; d0 < 8; ++d0) { int cb = (d0 * 16 + hi * 8) * 2;
    bf16x8 b0 = *reinterpret_cast<const bf16x8*>((const char*)Ks + KSWZ(r32, cb));
    bf16x8 b1 = *reinterpret_cast<const bf16x8*>((const char*)Ks + KSWZ(32 + r32, cb));
    p0 = __builtin_amdgcn_mfma_f32_32x32x16_bf16(b0, qr[d0], p0, 0, 0, 0);
    p1 = __builtin_amdgcn_mfma_f32_32x32x16_bf16(b1, qr[d0], p1, 0, 0, 0); }
}
__device__ __forceinline__ void partialSM_ref(f32x16& p0) { for (int r = 0; r < 16; ++r) p0[r] = __builtin_amdgcn_exp2f(p0[r]); }
typedef __bf16 bf16x2_t __attribute__((ext_vector_type(2)));
__device__ __forceinline__ float dot2_ones(unsigned w, float acc) { return __builtin_amdgcn_fdot2_f32_bf16(__builtin_bit_cast(bf16x2_t, w), __builtin_bit_cast(bf16x2_t, 0x3f803f80u), acc, false); }
__device__ __forceinline__ void finishSM_ref(f32x16& p0, f32x16& p1, float& lpart, bf16x8& pa0, bf16x8& pa1, bf16x8& pa2, bf16x8& pa3) {
  for (int r = 0; r < 16; ++r) p1[r] = __builtin_amdgcn_exp2f(p1[r]);
#define PK4D(P, BASE, OUT) do { unsigned a0 = cvtpk(P[BASE + 0], P[BASE + 1]), a1 = cvtpk(P[BASE + 2], P[BASE + 3]);   \
    unsigned b0 = cvtpk(P[BASE + 4], P[BASE + 5]), b1 = cvtpk(P[BASE + 6], P[BASE + 7]);                              \
    auto r0 = __builtin_amdgcn_permlane32_swap(a0, b0, false, false); auto r1 = __builtin_amdgcn_permlane32_swap(a1, b1, false, false); \
    u32x4 w = {r0[0], r1[0], r0[1], r1[1]}; OUT = *reinterpret_cast<bf16x8*>(&w);                                     \
      \
    lpart = dot2_ones(w.x, lpart); lpart = dot2_ones(w.y, lpart); lpart = dot2_ones(w.z, lpart); lpart = dot2_ones(w.w, lpart); } while (0)
  PK4D(p0, 0, pa0); PK4D(p0, 8, pa1); PK4D(p1, 0, pa2); PK4D(p1, 8, pa3);
#undef PK4D
}
__device__ __forceinline__ int v_st(int k, int c) { const int kk = (k & ~0xC) | ((k & 4) << 1) | ((k & 8) >> 1); return ((kk >> 3) * 4 + (c >> 5)) * 512 + ((kk & 7) * 32 + (c & 31)) * 2; }
__device__ __forceinline__ int v_rd_base(int lane) { return ((lane & 3) << 3) | (((lane >> 2) & 3) << 6) | (((lane >> 4) & 1) << 5) | (((lane >> 5) & 1) << 8); }
constexpr int v_rd_off(int d0, int ks, int half) { return d0 * 512 + ks * 4096 + half * 2048; }
template <int OFF> __device__ __forceinline__ s16x4 tr_read(int vb) {
  s16x4 r; asm volatile("ds_read_b64_tr_b16 %0, %1 offset:%2" : "=&v"(r) : "v"(vb), "i"(OFF) : "memory"); return r;
}
template <int D0> __device__ __forceinline__ void pv_one(f32x16& od, int vb, bf16x8 pa0, bf16x8 pa1, bf16x8 pa2, bf16x8 pa3) {
  const s16x4 l0 = tr_read<v_rd_off(D0, 0, 0)>(vb), h0 = tr_read<v_rd_off(D0, 0, 1)>(vb), l1 = tr_read<v_rd_off(D0, 1, 0)>(vb), h1 = tr_read<v_rd_off(D0, 1, 1)>(vb);
  const s16x4 l2 = tr_read<v_rd_off(D0, 2, 0)>(vb), h2 = tr_read<v_rd_off(D0, 2, 1)>(vb), l3 = tr_read<v_rd_off(D0, 3, 0)>(vb), h3 = tr_read<v_rd_off(D0, 3, 1)>(vb);
  asm volatile("s_waitcnt lgkmcnt(0)" ::: "memory"); SBAR();
#define PK(L, H) (bf16x8){L[0], L[1], L[2], L[3], H[0], H[1], H[2], H[3]}
  od = __builtin_amdgcn_mfma_f32_32x32x16_bf16(pa0, PK(l0, h0), od, 0, 0, 0);
  od = __builtin_amdgcn_mfma_f32_32x32x16_bf16(pa1, PK(l1, h1), od, 0, 0, 0);
  od = __builtin_amdgcn_mfma_f32_32x32x16_bf16(pa2, PK(l2, h2), od, 0, 0, 0);
  od = __builtin_amdgcn_mfma_f32_32x32x16_bf16(pa3, PK(l3, h3), od, 0, 0, 0);
#undef PK
}
__device__ __forceinline__ void pv_d0(f32x16* o, int vb, bf16x8 pa0, bf16x8 pa1, bf16x8 pa2, bf16x8 pa3) {
  pv_one<0>(o[0], vb, pa0, pa1, pa2, pa3); pv_one<1>(o[1], vb, pa0, pa1, pa2, pa3); pv_one<2>(o[2], vb, pa0, pa1, pa2, pa3); pv_one<3>(o[3], vb, pa0, pa1, pa2, pa3);
}

constexpr int LDQ = 1024, LDK = 128;
constexpr int OS_OFF = (int)SHM_ATTN, OS_WAVE = 32 * 136 * 2;
template <bool FIXED>
__device__ __forceinline__ void attn_unit(const bf16* __restrict__ Qb, const bf16* __restrict__ Kh, const bf16* __restrict__ Vh,
                                          const unsigned short* __restrict__ GAb, const unsigned short* __restrict__ RTb, unsigned short* __restrict__ MIXb,
                                          const float* __restrict__ qg, const float* __restrict__ ROPE, int s_base, int seq, char* lds, float mfix) {
  using St = Stage<bf16>;
  int tid_o = threadIdx.x; asm volatile("" : "+v"(tid_o));
  const int tid = tid_o, wid = tid >> 6, lane = tid & 63, r32 = lane & 31, hi = lane >> 5;
  bf16* V_lds = (bf16*)lds; bf16* K_lds = (bf16*)(lds + 2 * SHM_V);
  float* ws = (float*)(lds + 2 * SHM_V + 2 * SHM_K) + wid * 64; float* li_l = ws; float* al_l = ws + 32;
  float m_reg = FIXED ? mfix : -1e30f, l_reg = 0; f32x16 o[4] = {}; bf16x8 qr[8];
  const float mfixC = -mfix * (SCALE * 1.4426950408889634f);
#define PSM(P0, P1, MN, AL) do { if constexpr (FIXED) { partialSM_ref(P0); AL = 1.f; MN = mfix; } else partialSM(P0, P1, m_reg, MN, AL); } while (0)
#define QKT(P0, P1, KS) qkt(P0, P1, KS, qr, r32, hi)
#define FSM(P0, P1, AL) do { if constexpr (FIXED) finishSM_ref(P0, P1, l_reg, pa0, pa1, pa2, pa3); else finishSM(P0, P1, AL, l_reg, pa0, pa1, pa2, pa3); } while (0)
  const int sr = tid >> 4, sc = (tid & 15) * 8, vst0 = v_st(sr, sc), vst1 = v_st(32 + sr, sc);
  const int vb0 = (int)(uintptr_t)V_lds + v_rd_base(lane);
  struct { typename St::T vs0, vs1, ks0, ks1; } sr_[SDEPTH];
#define SLOAD(i, k0) do { sr_[i].vs0 = St::ld8(&Vh[(long)((k0) + sr) * LDK + sc]); sr_[i].vs1 = St::ld8(&Vh[(long)((k0) + 32 + sr) * LDK + sc]); \
    sr_[i].ks0 = St::ld8(&Kh[(long)((k0) + sr) * LDK + sc]); sr_[i].ks1 = St::ld8(&Kh[(long)((k0) + 32 + sr) * LDK + sc]); } while (0)
#define SWRITE(b, i) do { *(bf16x8*)((char*)V_lds + (b) * SHM_V + vst0) = St::tobf(sr_[i].vs0);          \
    *(bf16x8*)((char*)V_lds + (b) * SHM_V + vst1) = St::tobf(sr_[i].vs1); int kc = sc * 2;               \
    *(bf16x8*)((char*)K_lds + (b) * SHM_K + KSWZ(sr, kc)) = St::tobf(sr_[i].ks0);                       \
    *(bf16x8*)((char*)K_lds + (b) * SHM_K + KSWZ(32 + sr, kc)) = St::tobf(sr_[i].ks1); } while (0)
#define SWAIT() do { if constexpr (SDEPTH == 2) asm volatile("s_waitcnt vmcnt(4)" ::: "memory"); else asm volatile("s_waitcnt vmcnt(0)" ::: "memory"); } while (0)
#define RESC(a) do { if (__any((a) < 1.f)) { if (hi == 0) al_l[r32] = (a); asm volatile("s_waitcnt lgkmcnt(0)" ::: "memory"); \
    for (int d = 0; d < 4; ++d) for (int r = 0; r < 16; ++r) o[d][r] *= al_l[crow(r, hi)]; } } while (0)
  f32x16 pA0, pA1, pB0, pB1; float mnA, mnB, alA, alB; bf16x8 pa0, pa1, pa2, pa3; const int NT = seq / KVBLK;
  constexpr int SE = 0, SO = SDEPTH - 1;
  SLOAD(SE, 0);
  {
    const bf16* Qw = Qb + (long)(wid * QBLK + r32) * LDQ + hi * 8;
    float xf[8][8]; float ss = 0.f;
#pragma unroll
    for (int d0 = 0; d0 < 8; ++d0) { const bf16x8 raw = *reinterpret_cast<const bf16x8*>(Qw + d0 * 16);
#pragma unroll
      for (int e = 0; e < 8; ++e) { xf[d0][e] = __uint_as_float((unsigned)(unsigned short)raw[e] << 16); ss += xf[d0][e] * xf[d0][e]; } }
    ss += __shfl_xor(ss, 32);
    const float rstd = __builtin_amdgcn_rsqf(ss * (1.f / 128.f) + 1e-6f) * (FIXED ? SCALE * 1.4426950408889634f : 1.f);
#pragma unroll
    for (int d0 = 0; d0 < 8; ++d0) { const float4 g0 = *reinterpret_cast<const float4*>(qg + d0 * 16 + hi * 8), g1 = *reinterpret_cast<const float4*>(qg + d0 * 16 + hi * 8 + 4);
      xf[d0][0] *= rstd * g0.x; xf[d0][1] *= rstd * g0.y; xf[d0][2] *= rstd * g0.z; xf[d0][3] *= rstd * g0.w;
      xf[d0][4] *= rstd * g1.x; xf[d0][5] *= rstd * g1.y; xf[d0][6] *= rstd * g1.z; xf[d0][7] *= rstd * g1.w; }
    const int s = s_base + wid * QBLK + r32;
#pragma unroll
    for (int ax = 0; ax < 2; ++ax) { const int pos = ax ? (s & 63) : (s >> 6);
#pragma unroll
      for (int dd = 0; dd < 2; ++dd) { const float4* cs = reinterpret_cast<const float4*>(ROPE + (pos * 32 + 16 * dd + 8 * hi) * 2); const int d1 = 4 * ax + dd, d2 = d1 + 2;
#pragma unroll
        for (int e2 = 0; e2 < 4; ++e2) { const float4 c4 = cs[e2];
          { const float x1 = xf[d1][2 * e2], x2 = xf[d2][2 * e2]; xf[d1][2 * e2] = x1 * c4.x - x2 * c4.y; xf[d2][2 * e2] = x2 * c4.x + x1 * c4.y; }
          { const float x1 = xf[d1][2 * e2 + 1], x2 = xf[d2][2 * e2 + 1]; xf[d1][2 * e2 + 1] = x1 * c4.z - x2 * c4.w; xf[d2][2 * e2 + 1] = x2 * c4.z + x1 * c4.w; } } } }
#pragma unroll
    for (int d0 = 0; d0 < 8; ++d0) { u32x4 w = {cvtpk(xf[d0][0], xf[d0][1]), cvtpk(xf[d0][2], xf[d0][3]), cvtpk(xf[d0][4], xf[d0][5]), cvtpk(xf[d0][6], xf[d0][7])}; qr[d0] = *reinterpret_cast<bf16x8*>(&w); }
  }
  asm volatile("s_waitcnt vmcnt(0)" ::: "memory"); SWRITE(0, SE); __syncthreads();
  QKT(pA0, pA1, K_lds); PSM(pA0, pA1, mnA, alA);
  SLOAD(SO, KVBLK); if constexpr (SDEPTH == 2) { if (2 < NT) SLOAD(SE, 2 * KVBLK); }
  SWAIT(); SWRITE(1, SO); __syncthreads();
  for (int j = 1; j + 1 < NT; j += 2) {
    SBAR(); QKT(pB0, pB1, (bf16*)((char*)K_lds + SHM_K));
    FSM(pA0, pA1, alA); SBAR();
    SLOAD(SO, (j + SDEPTH) * KVBLK); SBAR();
    pv_d0(o, vb0, pa0, pa1, pa2, pa3); PSM(pB0, pB1, mnB, alB);
    __syncthreads(); SWAIT(); SWRITE(0, SE);
    if constexpr (!FIXED) RESC(alB); __syncthreads();
    SBAR(); QKT(pA0, pA1, K_lds);
    FSM(pB0, pB1, alB); SBAR();
    if (SDEPTH == 1 || j + 3 < NT) SLOAD(SE, (j + 1 + SDEPTH) * KVBLK); SBAR();
    pv_d0(o, vb0 + (int)SHM_V, pa0, pa1, pa2, pa3); PSM(pA0, pA1, mnA, alA);
    __syncthreads(); SWAIT(); SWRITE(1, SO);
    if constexpr (!FIXED) RESC(alA); __syncthreads();
  }
  if (NT & 1) {
    if constexpr (FIXED) {
      static_assert(NPADK == 48, "tail mask written for 16 real keys in the last tile");
      for (int r = 8; r < 16; ++r) pA0[r] = 0.f; for (int r = 0; r < 16; ++r) pA1[r] = -1e30f; }
    SBAR(); FSM(pA0, pA1, alA); SBAR();
    pv_d0(o, vb0, pa0, pa1, pa2, pa3);
  } else {
  SBAR(); QKT(pB0, pB1, (bf16*)((char*)K_lds + SHM_K));
  FSM(pA0, pA1, alA); SBAR();
  pv_d0(o, vb0, pa0, pa1, pa2, pa3); PSM(pB0, pB1, mnB, alB);
  __syncthreads(); if constexpr (!FIXED) RESC(alB);
  FSM(pB0, pB1, alB); SBAR();
  pv_d0(o, vb0 + (int)SHM_V, pa0, pa1, pa2, pa3);
  }
  if constexpr (FIXED) { auto rr = __builtin_amdgcn_permlane32_swap(__float_as_uint(l_reg), __float_as_uint(l_reg), false, false); l_reg = __uint_as_float(rr[0]) + __uint_as_float(rr[1]); }
  if constexpr (!FIXED) { constexpr float C = SCALE * 1.4426950408889634f; l_reg -= (float)NPADK * __builtin_amdgcn_exp2f(-m_reg * C); }
  static_assert(!FIXED || true, "");
  int tid_e = tid; asm volatile("" : "+v"(tid_e)); const int lane_e = tid_e & 63, wid_e = tid_e >> 6;
  const int hi_e = lane_e >> 5, r32_e = lane_e & 31; float* li_e = (float*)(lds + 2 * SHM_V + 2 * SHM_K) + wid_e * 64;
  if (hi_e == 0) li_e[r32_e] = l_reg; asm volatile("s_waitcnt lgkmcnt(0)" ::: "memory");
  float rli[16];
#pragma unroll
  for (int r = 0; r < 16; ++r) rli[r] = __builtin_amdgcn_rcpf(li_e[crow(r, hi_e)]);
  unsigned short* osw = (unsigned short*)(lds + OS_OFF + wid_e * OS_WAVE);
#pragma unroll
  for (int r = 0; r < 16; ++r) { const int orow = crow(r, hi_e);
#pragma unroll
    for (int d0 = 0; d0 < 4; ++d0) { const float v = o[d0][r] * rli[r]; osw[orow * 136 + d0 * 32 + (lane_e & 31)] = (unsigned short)(cvtpk(v, v) & 0xffffu); } }
  asm volatile("s_waitcnt lgkmcnt(0)" ::: "memory");
#pragma unroll
  for (int k = 0; k < 8; ++k) { const int idx = k * 64 + lane_e, row = idx >> 4, chunk = idx & 15; const long go = (long)(wid_e * QBLK + row) * LDQ + chunk * 8;
    const u32x4 ov = *reinterpret_cast<const u32x4*>(osw + row * 136 + chunk * 8);
    const u32x4 ga = *reinterpret_cast<const u32x4*>(GAb + go), rt = *reinterpret_cast<const u32x4*>(RTb + go);
    u32x4 w;
#define MIX2(O, G, R) cvtpk(__uint_as_float((G) << 16) * __uint_as_float((O) << 16) + __uint_as_float((R) << 16), __uint_as_float((G) & 0xffff0000u) * __uint_as_float((O) & 0xffff0000u) + __uint_as_float((R) & 0xffff0000u))
    w.x = MIX2(ov.x, ga.x, rt.x); w.y = MIX2(ov.y, ga.y, rt.y); w.z = MIX2(ov.z, ga.z, rt.z); w.w = MIX2(ov.w, ga.w, rt.w);
#undef MIX2
    *reinterpret_cast<u32x4*>(MIXb + go) = w; }
  asm volatile("s_waitcnt lgkmcnt(0)" ::: "memory");
  __syncthreads();
#undef PSM
#undef QKT
#undef FSM
#undef SLOAD
#undef SWRITE
#undef SWAIT
#undef RESC
}
#undef KSWZ
#undef SBAR
}

#define RLX_AGENT __ATOMIC_RELAXED, __HIP_MEMORY_SCOPE_AGENT
#define XB_TMO      128
#define XB_XCNT(j)  (256  + 64 * (j))
#define XB_XSUB(j)  (1280 + 64 * (j))
#define XB_XGEN(j)  (2304 + 64 * (j))
#define XB_TOP      3328
#define XB_TOPGEN   3392
#define XCD_BAR_WORDS 3456
#define XB_SPIN_CAP (1u << 18)

__device__ __forceinline__ unsigned xb_ld(unsigned* p)              { return __hip_atomic_load(p, __ATOMIC_RELAXED, __HIP_MEMORY_SCOPE_AGENT); }
__device__ __forceinline__ unsigned xb_add(unsigned* p, unsigned v) { return __hip_atomic_fetch_add(p, v, __ATOMIC_RELAXED, __HIP_MEMORY_SCOPE_AGENT); }
__device__ __forceinline__ unsigned xb_xcc_id() { return (unsigned)__builtin_amdgcn_s_getreg((3 << 11) | 20) & 0xFu; }
#define XB_SPIN(cond, bar) do { unsigned _sp = 0; while (cond) { __builtin_amdgcn_s_sleep(1); \
    if ((++_sp & 255u) == 0u) { if (xb_ld(&(bar)[XB_TMO])) break; if (_sp > XB_SPIN_CAP) { atomicAdd(&(bar)[XB_TMO], 1u); break; } } } } while (0)

struct XcdBarrier {
    unsigned* bar; unsigned x;
    volatile LAS unsigned* st;
};

__device__ __forceinline__ XcdBarrier xcd_barrier_post(unsigned* bar, volatile LAS unsigned* st) {
    XcdBarrier b; b.bar = bar; b.x = xb_xcc_id(); b.st = st;
    if (threadIdx.x == 0) (void)xb_add(&bar[XB_XCNT(b.x)], 1u);
    return b;
}
__device__ __forceinline__ void xcd_barrier_complete(unsigned* bar, unsigned x, unsigned& nloc, unsigned& nx) {
    const unsigned G = gridDim.x * gridDim.y * gridDim.z;
    unsigned sum, cnt, mine, sp = 0u;
    for (;;) {
        sum = 0u; cnt = 0u; mine = 0u;
#pragma unroll
        for (unsigned j = 0; j < 16; ++j) { const unsigned c = xb_ld(&bar[XB_XCNT(j)]); sum += c; cnt += (c > 0u) ? 1u : 0u; mine = (j == x) ? c : mine; }
        if (sum == G) break;
        __builtin_amdgcn_s_sleep(1);
        if ((++sp & 255u) == 0u) { if (xb_ld(&bar[XB_TMO])) break; if (sp > XB_SPIN_CAP) { atomicAdd(&bar[XB_TMO], 1u); break; } }
    }
    nloc = mine > 0u ? mine : 1u; nx = cnt > 0u ? cnt : 1u;
}

__device__ __forceinline__ void xcd_barrier(const XcdBarrier& b) {
    asm volatile("s_waitcnt vmcnt(0)" ::: "memory");
    __syncthreads();
    if (threadIdx.x == 0) {
        unsigned* bar = b.bar;
        __builtin_amdgcn_s_waitcnt(0);
        unsigned nloc = b.st[0], nx = b.st[1];
        if (nloc == 0u) { xcd_barrier_complete(bar, b.x, nloc, nx); b.st[0] = nloc; b.st[1] = nx; }
        const unsigned old = xb_add(&bar[XB_XSUB(b.x)], 1u);
        const unsigned gen = old / nloc;
        if (old + 1u == (gen + 1u) * nloc) {
            __builtin_amdgcn_fence(__ATOMIC_RELEASE, "agent");
            asm volatile("s_waitcnt vmcnt(0)" ::: "memory");
            const unsigned og = xb_add(&bar[XB_TOP], 1u);
            const unsigned tg = og / nx;
            if (og + 1u == (tg + 1u) * nx) xb_add(&bar[XB_TOPGEN], 1u);
            else XB_SPIN(xb_ld(&bar[XB_TOPGEN]) == tg, bar);
            __builtin_amdgcn_fence(__ATOMIC_ACQUIRE, "agent");
            xb_add(&bar[XB_XGEN(b.x)], 1u);
            asm volatile("s_waitcnt vmcnt(0)" ::: "memory");
        } else {
            XB_SPIN(xb_ld(&bar[XB_XGEN(b.x)]) == gen, bar);
            __builtin_amdgcn_fence(__ATOMIC_ACQUIRE, "agent");
            asm volatile("s_waitcnt vmcnt(0)" ::: "memory");
        }
    }
    __syncthreads();
}

#ifndef MK_N_LAUNCHES
#define MK_N_LAUNCHES 1
#endif
constexpr int N_PHASES = 7;
#ifndef STAG4
#define STAG4 1000
#endif
#ifndef STAG6
#define STAG6 800
#endif
#define STAGGER(ticks) do { const unsigned long long t0_ = __builtin_amdgcn_s_memrealtime(); const unsigned long long dl_ = (unsigned long long)((bx >> 3) & 3) * (ticks); while (__builtin_amdgcn_s_memrealtime() - t0_ < dl_) __builtin_amdgcn_s_sleep(8); } while (0)
#ifndef PROBE_PHASE
#define PROBE_PHASE -1
#endif
#define REPS(k)
struct Args { const float* in[17]; float* out; unsigned char* ws; int ph_lo, ph_hi; };

template <class T> __device__ __forceinline__ T* as_global(T* v) { __attribute__((address_space(1))) T* g; asm volatile("" : "=s"(g) : "0"(v)); return (T*)g; }
__device__ __forceinline__ void load_P(P& p) {
    typedef __attribute__((address_space(4))) const unsigned char* kp_t; typedef __attribute__((address_space(4))) const float* const* kin_t;
    kp_t kp = (kp_t)__builtin_amdgcn_kernarg_segment_ptr(); asm volatile("" : "+s"(kp));
#define GPTR(T, v) (as_global<T>((T*)(v)))
    kin_t in = (kin_t)kp;
    p.x = GPTR(const float, in[0]); p.meta = GPTR(const float, in[1]); p.g1 = GPTR(const float, in[2]); p.w_in = GPTR(const float, in[3]); p.conv_w = GPTR(const float, in[4]); p.conv_b = GPTR(const float, in[5]);
    p.rg_wa = GPTR(const float, in[6]); p.rg_ba = GPTR(const float, in[7]); p.rg_wx = GPTR(const float, in[8]); p.rg_bx = GPTR(const float, in[9]); p.rg_lam = GPTR(const float, in[10]); p.qg = GPTR(const float, in[11]);
    p.kg = GPTR(const float, in[12]); p.w_out = GPTR(const float, in[13]); p.g2 = GPTR(const float, in[14]); p.w_fi = GPTR(const float, in[15]); p.w_fo = GPTR(const float, in[16]);
    p.out = GPTR(float, *(__attribute__((address_space(4))) float* const*)(kp + 136)); p.ws = GPTR(unsigned char, *(__attribute__((address_space(4))) unsigned char* const*)(kp + 144));
#undef GPTR
}
static_assert(sizeof(Args) == 160, "Args layout (17 input pointers, out, ws, two ints) is what load_P reads");
__global__ void __launch_bounds__(512, 2) fwd_mega(Args a) {
    extern __shared__ __attribute__((aligned(16))) unsigned char lds[];
    cg::grid_group grid = cg::this_grid();
    const int G = gridDim.x; const int bx = blockIdx.x; const int vcu = (G % 8 == 0) ? (bx % 8) * (G / 8) + bx / 8 : bx;
    unsigned char* ws = a.ws;
    const int lo = a.ph_lo, hi = a.ph_hi;
#ifndef PH_MASK
#define PH_MASK 127
#endif
#define IN(k) (((PH_MASK >> (k)) & 1) && lo <= (k) && (k) < hi)
#define SEAM(k) do { if (IN(k) && IN((k) + 1)) xcd_barrier(xbar); } while (0)
    PG8_LAS unsigned char* ldsl = (PG8_LAS unsigned char*)lds;
    volatile LAS unsigned* xst = (volatile LAS unsigned*)(ldsl + LDS_BYTES - 64);
    if (threadIdx.x == 0) { xst[0] = 0u; xst[1] = 0u; }
    __syncthreads();
    XcdBarrier xbar; xbar.bar = (unsigned*)ws + 4096; xbar.x = 0; xbar.st = nullptr;
    if (hi - lo > 1) {
        if (bx == 0) for (int i = threadIdx.x; i < XCD_BAR_WORDS; i += 512) __hip_atomic_store((unsigned*)ws + 4096 + i, 0u, __ATOMIC_RELAXED, __HIP_MEMORY_SCOPE_AGENT);
        grid.sync(); xbar = xcd_barrier_post((unsigned*)ws + 4096, xst); }

    if (IN(0)) { P p; load_P(p); p0_prologue(p, lds, vcu, G); }
    SEAM(0);
    if (IN(1)) REPS(1) {
        pg8::Gemm g{(const bf16_t*)(ws + WS_XN), (const bf16_t*)(ws + WS_WIN), M, NIN, 1024}; pg8::StaticOrder S; S.init(M, NIN, G, bx);
        Epi1 E{(bf16_t*)(ws + WS_Q), (bf16_t*)(ws + WS_KRAW), (bf16_t*)(ws + WS_VF), (bf16_t*)(ws + WS_XR), (bf16_t*)(ws + WS_GG), (bf16_t*)(ws + WS_GA)};
        pg8::gemm_phase<Epi1, pg8::StaticOrder, true, true>(ldsl, g, S, E);
    }
    SEAM(1);
    if (IN(2)) REPS(2) {
        P p; load_P(p);
        p2_kpass(p, vcu, G);
        __syncthreads();
        for (int it = bx; it < BATCH * 8; it += G) rnn_item(p, lds, it >> 3, it & 7);
    }
    SEAM(2);
    if (IN(3)) {
        P pq; load_P(pq);
        float gqa = 0.f, gka = 0.f;
        for (int i = 0; i < 128; ++i) { gqa = fmaxf(gqa, fabsf(pq.qg[i])); gka = fmaxf(gka, fabsf(pq.kg[i])); }
        const float mfix = __builtin_bit_cast(float, __builtin_amdgcn_readfirstlane(__builtin_bit_cast(int, 128.f * 1.02f * gqa * gka)));
        const bool fixed_ok = (mfix * 0.0883883476f <= 30.f) && (mfix > 0.f);
#define ATT_LOOP(FX) for (int i = 0;; ++i) { const int uid = i * G + vcu; if (uid >= BATCH * 2 * 32) break; \
            const int pr = uid >> 5, j = uid & 31, b = pr >> 1, kvh = pr & 1, h = kvh * 4 + (j >> 3), qb = j & 7; \
            const size_t qoff = ((size_t)b * SEQ + qb * 256) * 1024 + h * 128; const size_t koff = (size_t)(b * 2 + kvh) * SKV * 128; \
            att::attn_unit<FX>((const att::bf16*)(ws + WS_Q) + qoff, (const att::bf16*)(ws + WS_KF) + koff, (const att::bf16*)(ws + WS_VF) + koff, \
                           (const unsigned short*)(ws + WS_GA) + qoff, (const unsigned short*)(ws + WS_RT) + qoff, (unsigned short*)(ws + WS_Q) + qoff, \
                           pq.qg, (const float*)(ws + WS_ROPE), qb * 256, SKV_ATT, (char*)lds, mfix); }
        if (fixed_ok) { ATT_LOOP(true) } else { ATT_LOOP(false) }
#undef ATT_LOOP
    }
    SEAM(3);
    if (IN(4)) REPS(4) {
        pg8::Gemm g{(const bf16_t*)(ws + WS_Q), (const bf16_t*)(ws + WS_WOUT), M, 1024, 1024}; pg8::StaticOrder S; S.init(M, 1024, G, bx);
        P p; load_P(p);
        Epi2 E{p.x, p.out, (bf16_t*)(ws + WS_H1B), (float*)(ws + WS_SS)};
        pg8::gemm_phase<Epi2, pg8::StaticOrder, true, true>(ldsl, g, S, E);
    }
    SEAM(4);
    if (IN(5)) REPS(5) {
        pg8::Gemm g{(const bf16_t*)(ws + WS_H1B), (const bf16_t*)(ws + WS_WFI), M, 2 * DFF, 1024}; pg8::StaticOrder S; S.init(M, 2 * DFF, G, bx);
        Epi3 E{(const float*)(ws + WS_SS), (bf16_t*)(ws + WS_ACT), {}};
        pg8::gemm_phase<Epi3, pg8::StaticOrder, true, true>(ldsl, g, S, E);
    }
    SEAM(5);
    if (IN(6)) {
        pg8::Gemm g{(const bf16_t*)(ws + WS_ACT), (const bf16_t*)(ws + WS_WFO), M, 1024, DFF}; pg8::StaticOrder S; S.init(M, 1024, G, bx);
        P p; load_P(p);
        Epi4 E{(const bf16_t*)(ws + WS_H1B), p.out};
        pg8::gemm_phase<Epi4, pg8::StaticOrder, true, true>(ldsl, g, S, E);
    }
#undef IN
#undef SEAM
}

extern "C" void kernel_launch(void* const* d_in, const int* in_sizes, int n_in, void* d_out, int out_size, void* d_ws, size_t ws_size, hipStream_t stream) {
    static int grid = 0;
    if (grid == 0) {
        if (n_in != 17 || in_sizes[0] != M * DM || out_size != M * DM || ws_size < WS_END) {
            fprintf(stderr, "kernel_launch: shape mismatch n_in %d in0 %d out %d ws %zu (need %zu)\n", n_in, n_in > 0 ? in_sizes[0] : -1, out_size, ws_size, (size_t)WS_END); grid = -1; return; }
        int dev = 0, cus = 0, per_cu = 0;
        if (hipGetDevice(&dev) != hipSuccess || hipDeviceGetAttribute(&cus, hipDeviceAttributeMultiprocessorCount, dev) != hipSuccess) { grid = -1; return; }
        if (hipFuncSetAttribute((const void*)fwd_mega, hipFuncAttributeMaxDynamicSharedMemorySize, LDS_BYTES) != hipSuccess) { fprintf(stderr, "kernel_launch: hipFuncSetAttribute failed\n"); grid = -1; return; }
        if (hipOccupancyMaxActiveBlocksPerMultiprocessor(&per_cu, (const void*)fwd_mega, 512, LDS_BYTES) != hipSuccess || per_cu < 1) { fprintf(stderr, "kernel_launch: occupancy query says %d\n", per_cu); per_cu = 1; }
        (void)hipGetLastError();
        grid = cus * 1;
        fprintf(stderr, "kernel_launch: cus %d per_cu %d grid %d\n", cus, per_cu, grid);
    }
    if (grid < 0) return;
    Args a{};
    for (int i = 0; i < 17; ++i) a.in[i] = (const float*)d_in[i];
    a.out = (float*)d_out; a.ws = (unsigned char*)d_ws;
#if MK_N_LAUNCHES == 1
    a.ph_lo = 0; a.ph_hi = N_PHASES;
    void* args[] = {&a};
    hipError_t e = hipLaunchCooperativeKernel((const void*)fwd_mega, dim3(grid), dim3(512), args, LDS_BYTES, stream);
    if (e != hipSuccess) fprintf(stderr, "kernel_launch: cooperative launch failed: %s (grid %d)\n", hipGetErrorString(e), grid);
#else
    for (int ph = 0; ph < N_PHASES; ++ph) for (int rep = 0; rep < (ph == PROBE_PHASE ? 2 : 1); ++rep) { a.ph_lo = ph; a.ph_hi = ph + 1;
        hipLaunchKernelGGL(fwd_mega, dim3(grid), dim3(512), LDS_BYTES, stream, a);
        const hipError_t le = hipPeekAtLastError(); if (le != hipSuccess) { fprintf(stderr, "kernel_launch: launch %d failed: %s\n", ph, hipGetErrorName(le)); break; } }
#endif
}
```

```cpp
#define MK_N_LAUNCHES 1
#include <hip/hip_runtime.h>
#include <hip/hip_bf16.h>
#include <hip/hip_cooperative_groups.h>
#include <cstdio>
#include <cstdint>
namespace cg = cooperative_groups;
namespace pg8 {
#define PG8_LAS __attribute__((address_space(3)))
typedef unsigned short bf16_t;
typedef short bf16x8 __attribute__((ext_vector_type(8)));
typedef float f32x4 __attribute__((ext_vector_type(4)));
typedef unsigned u32x4 __attribute__((ext_vector_type(4)));
constexpr int BM = 256, BK = 64, HALF = 128, HTB = HALF * BK * 2  , STAGE_BYTES = 8 * HTB, NXCD = 8, WGM = 8;

__host__ __device__ __forceinline__ int lds_byte(int r, int c) { const int st = (r >> 4) * 2 + (c >> 5), rr = r & 15, cc = c & 31, ob = rr * 64 + cc * 2; return st * 1024 + (ob ^ (((ob >> 9) & 1) << 5)); }
__host__ __device__ __forceinline__ void stage_rc(int b, int& R, int& C) { const int st = b / 1024, sb = b % 1024, swz = sb ^ (((sb >> 9) & 1) << 5); R = (st >> 1) * 16 + swz / 64; C = (st & 1) * 32 + (swz % 64) / 2; }
__host__ __device__ __forceinline__ int perm32(int rho) { const int n = rho >> 4, i = rho & 15; return 8 * (i >> 2) + 4 * n + (i & 3); }

struct Unit { int pm, pn; };
struct Gemm { const bf16_t* A; const bf16_t* Bt; int M, N, K; };

struct StaticOrder {
    int nM, nN, nwg, G, c;
    __host__ __device__ void init(int M, int N, int G_, int c_) { nM = M / BM; nN = N / BM; nwg = nM * nN; G = G_; c = c_; }
    __host__ __device__ bool next(int i, Unit& u) const {
        const long L = (long)i * G + c; if (L >= nwg) return false;
        int wgid = (int)L; { const int q = nwg / NXCD, r = nwg % NXCD, xcd = wgid % NXCD, off = wgid / NXCD; wgid = (xcd < r ? xcd * (q + 1) : r * (q + 1) + (xcd - r) * q) + off; }
        const int nig = WGM * nN, gid = wgid / nig, fm = gid * WGM, gsz = (nM - fm) < WGM ? (nM - fm) : WGM;
        u.pm = fm + ((wgid % nig) % gsz); u.pn = (wgid % nig) / gsz; return true;
    }
    __device__ __forceinline__ void a_ready(const Unit&) const {}
    __device__ __forceinline__ void done(const Unit&) const {}
};

__device__ __forceinline__ unsigned cvt_pk_bf16(float lo, float hi) { unsigned r; asm volatile("v_cvt_pk_bf16_f32 %0, %1, %2" : "=v"(r) : "v"(lo), "v"(hi)); return r; }
typedef float f32x2 __attribute__((ext_vector_type(2)));
template <class Epi, class Sched, bool ALIGN_EPI = false, bool SP2 = false>
__device__ __forceinline__ void gemm_phase(PG8_LAS unsigned char* lds, const Gemm g, const Sched& S, const Epi& E) {
    const int tid = threadIdx.x, wid = __builtin_amdgcn_readfirstlane(tid >> 6), lane = tid & 63, wr = wid >> 2, wc = wid & 3, fr = lane & 15, fq = lane >> 4;
    const int K = g.K, nt = K / BK;
    unsigned voffA[2], voffB[2];
#pragma unroll
    for (int i = 0; i < 2; ++i) { int R, C; stage_rc(tid * 16 + i * 8192, R, C); const int Rb = Epi::PERM ? ((R & ~31) + perm32(R & 31)) : R;
        voffA[i] = (unsigned)(R * K + C) * 2u; voffB[i] = (unsigned)(Rb * K + C) * 2u; }
    const size_t kstep = (size_t)(BK * 2);
    const size_t hstep = (size_t)HALF * K * 2;
    const size_t tstep = 2 * hstep;
    const unsigned ldsw = (unsigned)wid * 1024u;
    const int aoff = lds_byte(wr * 64 + fr, fq * 8), boff = lds_byte(wc * 32 + fr, fq * 8);
#define PG8_SA(b, h) (((b) * 2 + (h)) * HTB)
#define PG8_SB(b, h) ((4 + (b) * 2 + (h)) * HTB)
#define PG8_STAGE(bufoff, gbase, voff) do { _Pragma("unroll") for (int _i = 0; _i < 2; ++_i) \
        __builtin_amdgcn_global_load_lds((const unsigned*)((const char*)(gbase) + (voff)[_i]), (PG8_LAS unsigned*)(lds + (bufoff) + ldsw + _i * 8192), 16, 0, 0); } while (0)
#define PG8_LDA(dst, b, h) do { _Pragma("unroll") for (int m = 0; m < 4; ++m) _Pragma("unroll") for (int k = 0; k < 2; ++k) dst[m][k] = *(const PG8_LAS bf16x8*)(lds + PG8_SA(b, h) + aoff + m * 2048 + k * 1024); } while (0)
#define PG8_LDB(dst, b, h) do { _Pragma("unroll") for (int n = 0; n < 2; ++n) _Pragma("unroll") for (int k = 0; k < 2; ++k) dst[n][k] = *(const PG8_LAS bf16x8*)(lds + PG8_SB(b, h) + boff + n * 2048 + k * 1024); } while (0)
#define PG8_MMA(ai, bj, At, Bt) do { __builtin_amdgcn_s_setprio(1); _Pragma("unroll") for (int m = 0; m < 4; ++m) _Pragma("unroll") for (int n = 0; n < 2; ++n) _Pragma("unroll") for (int k = 0; k < 2; ++k) \
        acc[ai][bj][m][n] = __builtin_amdgcn_mfma_f32_16x16x32_bf16(Bt[n][k], At[m][k], acc[ai][bj][m][n], 0, 0, 0); __builtin_amdgcn_s_setprio(0); } while (0)
#define PG8_WAIT_V(n) asm volatile("s_waitcnt vmcnt(" #n ")" ::: "memory")
#define PG8_WAIT_L(n) asm volatile("s_waitcnt lgkmcnt(" #n ")" ::: "memory")
#define PG8_BAR __builtin_amdgcn_s_barrier()
#define PG8_SCHED __builtin_amdgcn_sched_barrier(0)
    Unit cur, nxt; int ui = 0;
    if (!S.next(0, cur)) return;
    f32x4 acc[2][2][4][2];
    if constexpr (Epi::HAS_INIT) { E.init(acc, cur, wr, wc, fr, fq); } else {
#pragma unroll
    for (int a = 0; a < 2; ++a)
#pragma unroll
        for (int b = 0; b < 2; ++b)
#pragma unroll
            for (int m = 0; m < 4; ++m)
#pragma unroll
                for (int n = 0; n < 2; ++n) acc[a][b][m][n] = (f32x4){0.f, 0.f, 0.f, 0.f};
    }
    if constexpr (Epi::HAS_PRE) E.pre(cur, wr, wc, fr, fq);
    bf16x8 At[4][2], B0[2][2], B1[2][2];
    const char* cA = (const char*)g.A + (size_t)cur.pm * tstep; const char* cB = (const char*)g.Bt + (size_t)cur.pn * tstep;
    S.a_ready(cur);
    if constexpr (SP2) {
        PG8_STAGE(PG8_SB(0, 0), cB, voffB); PG8_STAGE(PG8_SB(0, 1), cB + hstep, voffB); PG8_STAGE(PG8_SA(0, 0), cA, voffA); PG8_STAGE(PG8_SA(0, 1), cA + hstep, voffA);
        if (wr == 1) PG8_BAR;
        PG8_WAIT_V(2); PG8_BAR;
        PG8_STAGE(PG8_SB(1, 0), cB + kstep, voffB); PG8_STAGE(PG8_SA(1, 0), cA + kstep, voffA); PG8_STAGE(PG8_SB(1, 1), cB + hstep + kstep, voffB);
        PG8_WAIT_V(6); PG8_BAR;
    } else {
        PG8_STAGE(PG8_SB(0, 0), cB, voffB); PG8_STAGE(PG8_SA(0, 0), cA, voffA); PG8_STAGE(PG8_SB(0, 1), cB + hstep, voffB); PG8_STAGE(PG8_SA(0, 1), cA + hstep, voffA);
        if (wr == 1) PG8_BAR;
        PG8_WAIT_V(4); PG8_BAR;
        PG8_STAGE(PG8_SB(1, 0), cB + kstep, voffB); PG8_STAGE(PG8_SA(1, 0), cA + kstep, voffA); PG8_STAGE(PG8_SB(1, 1), cB + hstep + kstep, voffB);
        PG8_WAIT_V(6); PG8_BAR;
    }
    for (;;) {
        const bool has_next = S.next(ui + 1, nxt);
        const char* nA = has_next ? (const char*)g.A + (size_t)nxt.pm * tstep : cA; const char* nB = has_next ? (const char*)g.Bt + (size_t)nxt.pn * tstep : cB;
        for (int t = 0; t < nt; t += 2) {
            const bool last = (t == nt - 2);
            const char* a1 = cA + (size_t)(t + 1) * kstep;
            const char* a2 = last ? nA : cA + (size_t)(t + 2) * kstep; const char* b2 = last ? nB : cB + (size_t)(t + 2) * kstep;
            const char* a3 = a2 + kstep; const char* b3 = b2 + kstep;
            if (last && has_next) S.a_ready(nxt);
            if constexpr (SP2) {
            PG8_LDB(B0, 0, 0); PG8_LDB(B1, 0, 1); PG8_SCHED; PG8_LDA(At, 0, 0); PG8_STAGE(PG8_SA(1, 1), a1 + hstep, voffA);
            PG8_WAIT_V(8); PG8_WAIT_L(0); PG8_BAR; PG8_MMA(0, 0, At, B0); PG8_MMA(0, 1, At, B1); PG8_BAR; PG8_SCHED;
            PG8_LDA(At, 0, 1); PG8_STAGE(PG8_SB(0, 0), b2, voffB); PG8_STAGE(PG8_SB(0, 1), b2 + hstep, voffB); PG8_STAGE(PG8_SA(0, 0), a2, voffA);
            PG8_WAIT_V(8); PG8_WAIT_L(0); PG8_BAR; PG8_MMA(1, 0, At, B0); PG8_MMA(1, 1, At, B1); PG8_BAR; PG8_SCHED;
            PG8_LDB(B0, 1, 0); PG8_LDB(B1, 1, 1); PG8_SCHED; PG8_LDA(At, 1, 0); PG8_STAGE(PG8_SA(0, 1), a2 + hstep, voffA);
            PG8_WAIT_V(8); PG8_WAIT_L(0); PG8_BAR; PG8_MMA(0, 0, At, B0); PG8_MMA(0, 1, At, B1); PG8_BAR; PG8_SCHED;
            PG8_LDA(At, 1, 1); PG8_STAGE(PG8_SB(1, 0), b3, voffB); PG8_STAGE(PG8_SB(1, 1), b3 + hstep, voffB); PG8_STAGE(PG8_SA(1, 0), a3, voffA);
            PG8_WAIT_V(8); PG8_WAIT_L(0); PG8_BAR; PG8_MMA(1, 0, At, B0); PG8_MMA(1, 1, At, B1); PG8_BAR; PG8_SCHED;
            } else {
            PG8_LDB(B0, 0, 0); PG8_SCHED; PG8_LDA(At, 0, 0); PG8_STAGE(PG8_SA(1, 1), a1 + hstep, voffA);
            PG8_WAIT_L(8); PG8_BAR; PG8_WAIT_L(0); PG8_MMA(0, 0, At, B0); PG8_BAR; PG8_SCHED;
            PG8_LDB(B1, 0, 1); PG8_STAGE(PG8_SB(0, 0), b2, voffB);
            PG8_BAR; PG8_WAIT_L(0); PG8_MMA(0, 1, At, B1); PG8_BAR;
            PG8_LDA(At, 0, 1); PG8_STAGE(PG8_SA(0, 0), a2, voffA);
            PG8_BAR; PG8_WAIT_L(0); PG8_MMA(1, 0, At, B0); PG8_BAR; PG8_SCHED;
            PG8_STAGE(PG8_SB(0, 1), b2 + hstep, voffB);
            PG8_WAIT_V(6); PG8_BAR; PG8_MMA(1, 1, At, B1); PG8_BAR;
            PG8_LDB(B0, 1, 0); PG8_SCHED; PG8_LDA(At, 1, 0); PG8_STAGE(PG8_SA(0, 1), a2 + hstep, voffA);
            PG8_WAIT_L(8); PG8_BAR; PG8_WAIT_L(0); PG8_MMA(0, 0, At, B0); PG8_BAR; PG8_SCHED;
            PG8_LDB(B1, 1, 1); PG8_STAGE(PG8_SB(1, 0), b3, voffB);
            PG8_BAR; PG8_WAIT_L(0); PG8_MMA(0, 1, At, B1); PG8_BAR;
            PG8_LDA(At, 1, 1); PG8_STAGE(PG8_SA(1, 0), a3, voffA);
            PG8_BAR; PG8_WAIT_L(0); PG8_MMA(1, 0, At, B0); PG8_BAR; PG8_SCHED;
            PG8_STAGE(PG8_SB(1, 1), b3 + hstep, voffB);
            PG8_WAIT_V(6); PG8_BAR; PG8_MMA(1, 1, At, B1); PG8_BAR;
            }
        }
        if constexpr (ALIGN_EPI) { if (wr == 0) PG8_BAR; }
        if constexpr (!Epi::AFTER_DRAIN) { E(acc, cur, wr, wc, fr, fq); S.done(cur); }
        if (!has_next) break;
        if constexpr (Epi::HAS_INIT) { E.init(acc, nxt, wr, wc, fr, fq); asm volatile("s_waitcnt vmcnt(0)" ::: "memory"); } else {
#pragma unroll
        for (int a = 0; a < 2; ++a)
#pragma unroll
            for (int b = 0; b < 2; ++b)
#pragma unroll
                for (int m = 0; m < 4; ++m)
#pragma unroll
                    for (int n = 0; n < 2; ++n) acc[a][b][m][n] = (f32x4){0.f, 0.f, 0.f, 0.f};
        }
        cur = nxt; cA = nA; cB = nB; ++ui;
        if constexpr (Epi::HAS_PRE) E.pre(cur, wr, wc, fr, fq);
        if constexpr (ALIGN_EPI) { if (wr == 1) PG8_BAR; }
    }
    PG8_WAIT_V(0);
    if constexpr (!ALIGN_EPI) { if (wr == 0) PG8_BAR; }
    PG8_BAR;
    if constexpr (Epi::AFTER_DRAIN) { E.fused(acc, cur, wr, wc, fr, fq, lds, wid, lane); S.done(cur); }
#undef PG8_SA
#undef PG8_SB
#undef PG8_STAGE
#undef PG8_LDA
#undef PG8_LDB
#undef PG8_MMA
#undef PG8_WAIT_V
#undef PG8_WAIT_L
#undef PG8_BAR
#undef PG8_SCHED
}
}

constexpr int BATCH = 32, SEQ = 2048, DM = 1024, M = BATCH * SEQ, NMETA = 16, TT = SEQ + NMETA;
constexpr int SKV = 2176, SKV_ATT = 2112, NPAD = SKV_ATT - TT;
constexpr int NIN = 5632, DFF = 2816, HD = 128;
constexpr float EPS = 1e-6f;
constexpr size_t MiB = 1u << 20;
constexpr size_t WS_WIN = 2 * MiB, WS_WOUT = 14 * MiB, WS_WFI = 16 * MiB, WS_WFO = 28 * MiB, WS_WG = 34 * MiB, WS_ROPE = 35 * MiB,
                 WS_METAP = 35 * MiB + 65536, WS_XRM = 35 * MiB + 262144, WS_SS = 36 * MiB,
                 WS_XN = 64 * MiB, WS_Q = 192 * MiB, WS_KRAW = 320 * MiB, WS_KF = 352 * MiB, WS_VF = 388 * MiB, WS_XR = 424 * MiB,
                 WS_GG = 552 * MiB, WS_GA = 680 * MiB, WS_HF = 808 * MiB, WS_END = 936 * MiB;
constexpr size_t WS_RT = WS_XN, WS_H1B = WS_XR, WS_ACT = WS_GG, WS_MIX = WS_HF;
constexpr int LDS_BYTES = 147456;
#define LAS __attribute__((address_space(3)))
typedef unsigned short bf16_t;
typedef short bf16x8 __attribute__((ext_vector_type(8)));
typedef float f32x4 __attribute__((ext_vector_type(4)));
typedef float f32x2 __attribute__((ext_vector_type(2)));
typedef unsigned u32x4 __attribute__((ext_vector_type(4)));
typedef unsigned u32x2 __attribute__((ext_vector_type(2)));

__device__ __forceinline__ unsigned pk2(float lo, float hi) { unsigned r; asm volatile("v_cvt_pk_bf16_f32 %0, %1, %2" : "=v"(r) : "v"(lo), "v"(hi)); return r; }
__device__ __forceinline__ float bflo(unsigned w) { return __uint_as_float(w << 16); }
__device__ __forceinline__ float bfhi(unsigned w) { return __uint_as_float(w & 0xffff0000u); }
__device__ __forceinline__ float bf1(bf16_t v) { return __uint_as_float((unsigned)v << 16); }
__device__ __forceinline__ float sigm(float x) { return __builtin_amdgcn_rcpf(1.f + __builtin_amdgcn_exp2f(-1.4426950408889634f * x)); }
__device__ __forceinline__ float gelu_t(float x) { const float z = 1.5957691216057308f * (x + 0.044715f * x * x * x); return x * sigm(z); }
__device__ __forceinline__ float wave_sum(float v) {
#pragma unroll
    for (int o = 1; o < 64; o <<= 1) v += __shfl_xor(v, o);
    return v;
}
#define LDS_WAIT() asm volatile("s_waitcnt lgkmcnt(0)" ::: "memory")
#define LBAR() do { asm volatile("s_waitcnt lgkmcnt(0)" ::: "memory"); __builtin_amdgcn_s_barrier(); asm volatile("" ::: "memory"); } while (0)

struct Epi1 {
    static constexpr bool PERM = true, AFTER_DRAIN = false, HAS_INIT = false, HAS_PRE = false;
    bf16_t *Q, *KRAW, *VF, *XR, *GG, *GA;
    __device__ __forceinline__ void operator()(const pg8::f32x4 (&acc)[2][2][4][2], const pg8::Unit& u, int wr, int wc, int fr, int fq) const {
        const int pn = u.pn; const int row0 = u.pm * 256 + wr * 64 + fr; const int cl = wc * 32 + 8 * fq;
        if (pn >= 10 && pn < 18) {
#pragma unroll
            for (int ai = 0; ai < 2; ++ai)
#pragma unroll
                for (int m = 0; m < 4; ++m) { const size_t row = row0 + ai * 128 + m * 16;
                    unsigned wv[4];
#pragma unroll
                    for (int n = 0; n < 2; ++n)
#pragma unroll
                        for (int e2 = 0; e2 < 2; ++e2) { const f32x2 x = {acc[ai][0][m][n][2 * e2], acc[ai][0][m][n][2 * e2 + 1]}, y = {acc[ai][1][m][n][2 * e2], acc[ai][1][m][n][2 * e2 + 1]};
                            const f32x2 tz = x * ((x * x) * (f32x2){-0.10294324f, -0.10294324f} + (f32x2){-2.3022082f, -2.3022082f}), ty = y * (f32x2){-1.4426950408889634f, -1.4426950408889634f};
                            const f32x2 dz = (f32x2){__builtin_amdgcn_exp2f(tz.x), __builtin_amdgcn_exp2f(tz.y)} + (f32x2){1.f, 1.f}, dy = (f32x2){__builtin_amdgcn_exp2f(ty.x), __builtin_amdgcn_exp2f(ty.y)} + (f32x2){1.f, 1.f};
                            const f32x2 dd = dz * dy; const f32x2 o = x * (f32x2){__builtin_amdgcn_rcpf(dd.x), __builtin_amdgcn_rcpf(dd.y)};
                            wv[n * 2 + e2] = pk2(o.x, o.y); }
                    u32x4 w; w.x = wv[0]; w.y = wv[1]; w.z = wv[2]; w.w = wv[3];
                    *(u32x4*)(GG + row * 1024 + (pn - 10) * 128 + cl) = w; }
            return;
        }
        bf16_t* base; int ld, colb; bool sg = false;
        if (pn < 4) { base = Q; ld = 1024; colb = pn * 256; }
        else if (pn == 4) { base = KRAW; ld = 256; colb = 0; }
        else if (pn == 5) { const int b = (u.pm * 256) >> 11, s0 = (u.pm * 256) & 2047;
            base = VF + ((size_t)(b * 2) * SKV + 16 + s0) * 128 - (size_t)(u.pm * 256) * 128; ld = 128; colb = 0; }
        else if (pn < 10) { base = XR; ld = 1024; colb = (pn - 6) * 256; }
        else { base = GA; ld = 1024; colb = (pn - 18) * 256; sg = true; }
        const size_t bjstep = (pn == 5) ? (size_t)SKV * 128 : 128;
#pragma unroll
        for (int ai = 0; ai < 2; ++ai)
#pragma unroll
            for (int m = 0; m < 4; ++m) { const size_t row = row0 + ai * 128 + m * 16;
#pragma unroll
                for (int bj = 0; bj < 2; ++bj) { pg8::f32x4 v0 = acc[ai][bj][m][0], v1 = acc[ai][bj][m][1];
                    if (sg) {
#define SG2(A, B) { const f32x2 t_ = (f32x2){A, B} * (f32x2){-1.4426950408889634f, -1.4426950408889634f}; const f32x2 d_ = (f32x2){__builtin_amdgcn_exp2f(t_.x), __builtin_amdgcn_exp2f(t_.y)} + (f32x2){1.f, 1.f}; A = __builtin_amdgcn_rcpf(d_.x); B = __builtin_amdgcn_rcpf(d_.y); }
                        SG2(v0[0], v0[1]) SG2(v0[2], v0[3]) SG2(v1[0], v1[1]) SG2(v1[2], v1[3])
#undef SG2
                    }
                    u32x4 w; w.x = pk2(v0[0], v0[1]); w.y = pk2(v0[2], v0[3]); w.z = pk2(v1[0], v1[1]); w.w = pk2(v1[2], v1[3]);
                    *(u32x4*)(base + row * ld + colb + bj * bjstep + cl) = w; } }
    }
};
struct Epi2 {
    static constexpr bool PERM = true, AFTER_DRAIN = false, HAS_INIT = true, HAS_PRE = false;
    const float* X; float* H1; bf16_t* H1B; float* SS;
    __device__ __forceinline__ void init(pg8::f32x4 (&acc)[2][2][4][2], const pg8::Unit& u, int wr, int wc, int fr, int fq) const {
        const int row0 = u.pm * 256 + wr * 64 + fr; const int c0 = u.pn * 256 + wc * 32 + 8 * fq;
#pragma unroll
        for (int ai = 0; ai < 2; ++ai)
#pragma unroll
            for (int m = 0; m < 4; ++m)
#pragma unroll
                for (int bj = 0; bj < 2; ++bj) { const size_t off = (size_t)(row0 + ai * 128 + m * 16) * 1024 + c0 + bj * 128;
                    acc[ai][bj][m][0] = *(const pg8::f32x4*)(X + off); acc[ai][bj][m][1] = *(const pg8::f32x4*)(X + off + 4); }
    }
    __device__ __forceinline__ void operator()(const pg8::f32x4 (&acc)[2][2][4][2], const pg8::Unit& u, int wr, int wc, int fr, int fq) const {
        const int row0 = u.pm * 256 + wr * 64 + fr; const int c0 = u.pn * 256 + wc * 32 + 8 * fq;
#pragma unroll
        for (int ai = 0; ai < 2; ++ai)
#pragma unroll
            for (int m = 0; m < 4; ++m) { const size_t row = row0 + ai * 128 + m * 16; float ss = 0.f;
#pragma unroll
                for (int bj = 0; bj < 2; ++bj) { const size_t off = row * 1024 + c0 + bj * 128;
                    const pg8::f32x4 v0 = acc[ai][bj][m][0], v1 = acc[ai][bj][m][1];
                    u32x4 w; w.x = pk2(v0[0], v0[1]); w.y = pk2(v0[2], v0[3]); w.z = pk2(v1[0], v1[1]); w.w = pk2(v1[2], v1[3]);
                    *(u32x4*)(H1B + off) = w;
                    ss += (v0[0] * v0[0] + v0[1] * v0[1]) + (v0[2] * v0[2] + v0[3] * v0[3]) + (v1[0] * v1[0] + v1[1] * v1[1]) + (v1[2] * v1[2] + v1[3] * v1[3]); }
                ss += __shfl_xor(ss, 16); ss += __shfl_xor(ss, 32);
                if (fq == 0) atomicAdd(SS + row, ss); }
    }
};
struct Epi3 {
    static constexpr bool PERM = true, AFTER_DRAIN = false, HAS_INIT = false, HAS_PRE = true;
    const float* SS; bf16_t* ACT; mutable float rs[8];
    __device__ __forceinline__ void pre(const pg8::Unit& u, int wr, int wc, int fr, int fq) const {
        const int row0 = u.pm * 256 + wr * 64 + fr;
#pragma unroll
        for (int ai = 0; ai < 2; ++ai)
#pragma unroll
            for (int m = 0; m < 4; ++m) rs[ai * 4 + m] = SS[row0 + ai * 128 + m * 16];
    }
    __device__ __forceinline__ void operator()(const pg8::f32x4 (&acc)[2][2][4][2], const pg8::Unit& u, int wr, int wc, int fr, int fq) const {
        const int row0 = u.pm * 256 + wr * 64 + fr; const int c0 = u.pn * 128 + wc * 32 + 8 * fq;
#pragma unroll
        for (int ai = 0; ai < 2; ++ai)
#pragma unroll
            for (int m = 0; m < 4; ++m) { const size_t row = row0 + ai * 128 + m * 16;
                const float rstd = __builtin_amdgcn_rsqf(rs[ai * 4 + m] * (1.f / 1024.f) + EPS);
                const float nrs = -1.4426950408889634f * rstd, rq = rstd * rstd; const f32x2 nrs2 = {nrs, nrs}, rq2 = {rq, rq}; unsigned wv[4];
#pragma unroll
                for (int n = 0; n < 2; ++n)
#pragma unroll
                    for (int e2 = 0; e2 < 2; ++e2) { const f32x2 ag = {acc[ai][0][m][n][2 * e2], acc[ai][0][m][n][2 * e2 + 1]}, au = {acc[ai][1][m][n][2 * e2], acc[ai][1][m][n][2 * e2 + 1]};
                        const f32x2 t = ag * nrs2;
                        const f32x2 d = (f32x2){__builtin_amdgcn_exp2f(t.x), __builtin_amdgcn_exp2f(t.y)} + (f32x2){1.f, 1.f};
                        const f32x2 o = (ag * au) * ((f32x2){__builtin_amdgcn_rcpf(d.x), __builtin_amdgcn_rcpf(d.y)} * rq2);
                        wv[n * 2 + e2] = pk2(o.x, o.y); }
                u32x4 w; w.x = wv[0]; w.y = wv[1]; w.z = wv[2]; w.w = wv[3];
                *(u32x4*)(ACT + row * DFF + c0) = w; }
    }
};
struct Epi4 {
    static constexpr bool PERM = true, AFTER_DRAIN = false, HAS_INIT = false, HAS_PRE = false;
    const bf16_t* H1B; float* OUT;
    __device__ __forceinline__ void operator()(const pg8::f32x4 (&acc)[2][2][4][2], const pg8::Unit& u, int wr, int wc, int fr, int fq) const {
        const int row0 = u.pm * 256 + wr * 64 + fr; const int c0 = u.pn * 256 + wc * 32 + 8 * fq;
#pragma unroll
        for (int ai = 0; ai < 2; ++ai)
#pragma unroll
            for (int m = 0; m < 4; ++m) {
#pragma unroll
                for (int bj = 0; bj < 2; ++bj) { const size_t off = (size_t)(row0 + ai * 128 + m * 16) * 1024 + c0 + bj * 128;
                    const u32x4 h = *(const u32x4*)(H1B + off);
                    const pg8::f32x4 x0 = (pg8::f32x4){bflo(h.x), bfhi(h.x), bflo(h.y), bfhi(h.y)}, x1 = (pg8::f32x4){bflo(h.z), bfhi(h.z), bflo(h.w), bfhi(h.w)};
                    __builtin_nontemporal_store(acc[ai][bj][m][0] + x0, (pg8::f32x4*)(OUT + off)); __builtin_nontemporal_store(acc[ai][bj][m][1] + x1, (pg8::f32x4*)(OUT + off + 4)); }
                }
    }
};

struct P {
    const float *x, *meta, *g1, *w_in, *conv_w, *conv_b, *rg_wa, *rg_ba, *rg_wx, *rg_bx, *rg_lam, *qg, *kg, *w_out, *g2, *w_fi, *w_fo;
    float* out; unsigned char* ws;
};
__device__ __forceinline__ void tr_item(const float* W, int K, int N, bf16_t* WT, int k0, int n0s, int n0d, const float* ksc, LAS float* scr, int lane) {
    float tv[32];
#pragma unroll
    for (int i = 0; i < 32; ++i) { const int kk = 2 * i + (lane >> 5); tv[i] = W[(size_t)(k0 + kk) * N + n0s + (lane & 31)]; }
    if (ksc) {
#pragma unroll
        for (int i = 0; i < 32; ++i) tv[i] *= ksc[k0 + 2 * i + (lane >> 5)]; }
#pragma unroll
    for (int i = 0; i < 32; ++i) { const int kk = 2 * i + (lane >> 5); scr[kk * 33 + (lane & 31)] = tv[i]; }
    LDS_WAIT(); asm volatile("" ::: "memory");
    const int c = lane & 7;
#pragma unroll
    for (int j = 0; j < 4; ++j) { const int n = (lane >> 3) + 8 * j; const LAS float* s = scr + (8 * c) * 33 + n;
        u32x4 o; o.x = pk2(s[0 * 33], s[1 * 33]); o.y = pk2(s[2 * 33], s[3 * 33]); o.z = pk2(s[4 * 33], s[5 * 33]); o.w = pk2(s[6 * 33], s[7 * 33]);
        *(u32x4*)(WT + (size_t)(n0d + n) * K + k0 + 8 * c) = o; }
    LDS_WAIT(); asm volatile("" ::: "memory");
}
__device__ __forceinline__ int win_src_col(int nd) {
    if (nd < 2560) return nd;
    if (nd < 4608) { const int r = nd - 2560, t = r >> 8, half = (r >> 7) & 1, c = r & 127; return (half ? 4608 : 2560) + 128 * t + c; }
    return 3584 + (nd - 4608);
}
__device__ __forceinline__ void p0_prologue(const P& p, unsigned char* ldsg, int vcu, int G) {
    const int tid = threadIdx.x, lane = tid & 63, wave = tid >> 6;
    unsigned char* ws = p.ws;
    if (blockIdx.x < 192) {
        float* xm = (float*)ldsg;
        float* red = (float*)(ldsg + 65536);
        for (int r = wave * 2; r < wave * 2 + 2; ++r) {
            const f32x4* xr = (const f32x4*)(p.meta + r * 1024) + lane; f32x4 v[4]; float s = 0.f;
#pragma unroll
            for (int j = 0; j < 4; ++j) { v[j] = xr[64 * j]; s += (v[j][0] * v[j][0] + v[j][1] * v[j][1]) + (v[j][2] * v[j][2] + v[j][3] * v[j][3]); }
            const float rstd = __builtin_amdgcn_rsqf(wave_sum(s) * (1.f / 1024.f) + EPS);
#pragma unroll
            for (int j = 0; j < 4; ++j) { const f32x4 g = ((const f32x4*)p.g1)[lane + 64 * j]; ((f32x4*)(xm + r * 1024))[lane + 64 * j] = v[j] * rstd * g; }
        }
        __syncthreads();
        float* METAP = (float*)(ws + WS_METAP); bf16_t* XRM = (bf16_t*)(ws + WS_XRM);
        for (int cgi = blockIdx.x; cgi < 192; cgi += G) {
            const int c = tid & 7, ks = tid >> 3, col = cgi * 8 + c; float acc[16];
#pragma unroll
            for (int r = 0; r < 16; ++r) acc[r] = 0.f;
#pragma unroll 16
            for (int k = ks * 16; k < ks * 16 + 16; ++k) { const float w = p.w_in[(size_t)k * NIN + 1024 + col];
#pragma unroll
                for (int r = 0; r < 16; ++r) acc[r] += xm[r * 1024 + k] * w; }
#pragma unroll
            for (int r = 0; r < 16; ++r) red[(ks * 16 + r) * 8 + c] = acc[r];
            __syncthreads();
            if (tid < 128) { const int r = tid >> 3, c2 = tid & 7; float s0 = 0.f, s1 = 0.f, s2 = 0.f, s3 = 0.f;
#pragma unroll 4
                for (int q = 0; q < 16; ++q) { s0 += red[(q * 16 + r) * 8 + c2]; s1 += red[((q + 16) * 16 + r) * 8 + c2]; s2 += red[((q + 32) * 16 + r) * 8 + c2]; s3 += red[((q + 48) * 16 + r) * 8 + c2]; }
                const float s = (s0 + s1) + (s2 + s3);
                const int cc = cgi * 8 + c2; METAP[r * 1536 + cc] = s;
                if (cc >= 512) XRM[r * 1024 + cc - 512] = (bf16_t)(pk2(s, s) & 0xffffu); }
            __syncthreads();
        }
    }
    if (blockIdx.x == (unsigned)(G - 1)) {
        f32x2* ROPE = (f32x2*)(ws + WS_ROPE);
        for (int idx = tid; idx < 2048; idx += 512) { const int pos = idx >> 5, i = idx & 31;
            double invf = 1.0; for (int q = 0; q < i; ++q) invf *= 0.74989420933245582730;
            const double a = (double)pos * invf; const double nq = __builtin_rint(a * 0.63661977236758134308); const double r = (a - nq * 1.57079632679489655800) - nq * 6.123233995736766e-17;
            const double r2 = r * r;
            const double sn = r * (1.0 + r2 * (-1.0 / 6 + r2 * (1.0 / 120 + r2 * (-1.0 / 5040 + r2 * (1.0 / 362880 + r2 * (-1.0 / 39916800 + r2 * (1.0 / 6227020800.0)))))));
            const double cs = 1.0 + r2 * (-0.5 + r2 * (1.0 / 24 + r2 * (-1.0 / 720 + r2 * (1.0 / 40320 + r2 * (-1.0 / 3628800 + r2 * (1.0 / 479001600.0))))));
            const int qd = ((int)nq) & 3; double c, s;
            if (qd == 0) { c = cs; s = sn; } else if (qd == 1) { c = -sn; s = cs; } else if (qd == 2) { c = -cs; s = -sn; } else { c = sn; s = -cs; }
            ROPE[idx] = (f32x2){(float)c, (float)s}; }
    }
    for (int i = blockIdx.x * 512 + tid; i < M; i += G * 512) ((float*)(ws + WS_SS))[i] = 0.f;
    LAS float* scr = (LAS float*)((LAS unsigned char*)ldsg + wave * 16384);
    const int gw = vcu * 8 + wave, NGW = G * 8;
    constexpr int I_IN = 16 * 176, I_OUT = 16 * 32, I_FI = 16 * 176, I_FO = 44 * 32, I_G = 32 * 8;
    constexpr int NITEMS = I_IN + I_OUT + I_FI + I_FO + I_G;
    bf16_t* XN = (bf16_t*)(ws + WS_XN);
    f32x4 g[4];
#pragma unroll
    for (int j = 0; j < 4; ++j) g[j] = ((const f32x4*)p.g1)[lane + 64 * j];
    for (int pass = 0; pass < 2; ++pass) {
      if ((pass == 0) == ((wave & 1) == 0)) {
    for (int it = gw; it < NITEMS; it += NGW) {
        int r = it;
        if (r < I_IN) { const int kb = r / 176, nb = r % 176; tr_item(p.w_in, 1024, NIN, (bf16_t*)(ws + WS_WIN), 64 * kb, win_src_col(32 * nb), 32 * nb, nullptr, scr, lane); continue; } r -= I_IN;
        if (r < I_OUT) { const int kb = r / 32, nb = r % 32; tr_item(p.w_out, 1024, 1024, (bf16_t*)(ws + WS_WOUT), 64 * kb, 32 * nb, 32 * nb, nullptr, scr, lane); continue; } r -= I_OUT;
        if (r < I_FI) { const int kb = r / 176, nb = r % 176, nd = 32 * nb, t = nd >> 8, half = (nd >> 7) & 1, c = nd & 127;
            tr_item(p.w_fi, 1024, 2 * DFF, (bf16_t*)(ws + WS_WFI), 64 * kb, (half ? DFF : 0) + 128 * t + c, nd, p.g2, scr, lane); continue; } r -= I_FI;
        if (r < I_FO) { const int kb = r / 32, nb = r % 32; tr_item(p.w_fo, DFF, 1024, (bf16_t*)(ws + WS_WFO), 64 * kb, 32 * nb, 32 * nb, nullptr, scr, lane); continue; } r -= I_FO;
        { const int mi = r >> 3, sub = r & 7, gate = mi >> 4, dir = (mi >> 3) & 1, n = mi & 7, kb = sub >> 2, nb = sub & 3;
          const float* src = (gate ? p.rg_wx : p.rg_wa) + (size_t)(dir * 8 + n) * 16384;
          tr_item(src, 128, 128, (bf16_t*)(ws + WS_WG) + (size_t)((dir * 2 + gate) * 8 + n) * 16384, 64 * kb, 32 * nb, 32 * nb, nullptr, scr, lane); }
    }
      } else {
    for (int m = gw; m < M; m += 2 * NGW) {
        const int m2 = m + NGW;
        const f32x4* xr = (const f32x4*)(p.x + (size_t)m * 1024) + lane; const f32x4* xr2 = (const f32x4*)(p.x + (size_t)(m2 < M ? m2 : m) * 1024) + lane;
        f32x4 v[4], v2[4]; float s = 0.f, s2 = 0.f;
#pragma unroll
        for (int j = 0; j < 4; ++j) { v[j] = __builtin_nontemporal_load(xr + 64 * j); v2[j] = __builtin_nontemporal_load(xr2 + 64 * j); }
#pragma unroll
        for (int j = 0; j < 4; ++j) { s += (v[j][0] * v[j][0] + v[j][1] * v[j][1]) + (v[j][2] * v[j][2] + v[j][3] * v[j][3]); s2 += (v2[j][0] * v2[j][0] + v2[j][1] * v2[j][1]) + (v2[j][2] * v2[j][2] + v2[j][3] * v2[j][3]); }
        const float rstd = __builtin_amdgcn_rsqf(wave_sum(s) * (1.f / 1024.f) + EPS), rstd2 = __builtin_amdgcn_rsqf(wave_sum(s2) * (1.f / 1024.f) + EPS);
        u32x2* o8 = (u32x2*)(XN + (size_t)m * 1024) + lane;
#pragma unroll
        for (int j = 0; j < 4; ++j) { const f32x4 y = v[j] * rstd * g[j]; o8[64 * j] = (u32x2){pk2(y[0], y[1]), pk2(y[2], y[3])}; }
        if (m2 < M) { u32x2* o82 = (u32x2*)(XN + (size_t)m2 * 1024) + lane;
#pragma unroll
            for (int j = 0; j < 4; ++j) { const f32x4 y = v2[j] * rstd2 * g[j]; o82[64 * j] = (u32x2){pk2(y[0], y[1]), pk2(y[2], y[3])}; } }
    }
      }
    }
}

__device__ __forceinline__ void p2_kpass(const P& p, int vcu, int G) {
    unsigned char* ws = p.ws;
    const int tid = threadIdx.x, j = tid & 15;
    const int gidx = vcu * 32 + (tid >> 4), NG = G * 32;
    const bf16_t* KRAW = (const bf16_t*)(ws + WS_KRAW); bf16_t* KF = (bf16_t*)(ws + WS_KF); bf16_t* VF = (bf16_t*)(ws + WS_VF);
    const f32x2* ROPE = (const f32x2*)(ws + WS_ROPE); const float* METAP = (const float*)(ws + WS_METAP);
    float kg[8];
#pragma unroll
    for (int e = 0; e < 8; ++e) kg[e] = p.kg[8 * j + e];
    for (int task0 = gidx; task0 < 2 * M; task0 += 4 * NG) {
        u32x4 raw[4]; f32x4 csv[4][4];
#pragma unroll
        for (int q = 0; q < 4; ++q) { const int task = task0 + q * NG; const int tk = task < 2 * M ? task : task0; const int row = tk >> 1, h = tk & 1, s = row & 2047;
            raw[q] = *(const u32x4*)(KRAW + (size_t)row * 256 + h * 128 + 8 * j);
            const int pos = (j >> 3) ? (s & 63) : (s >> 6); const f32x4* cs = (const f32x4*)(ROPE + pos * 32 + 8 * (j & 3));
#pragma unroll
            for (int e2 = 0; e2 < 4; ++e2) csv[q][e2] = cs[e2]; }
#pragma unroll
        for (int q = 0; q < 4; ++q) { const int task = task0 + q * NG; if (task < 2 * M) { const int row = task >> 1, h = task & 1, b = row >> 11, s = row & 2047;
            float y[8] = {bflo(raw[q].x), bfhi(raw[q].x), bflo(raw[q].y), bfhi(raw[q].y), bflo(raw[q].z), bfhi(raw[q].z), bflo(raw[q].w), bfhi(raw[q].w)};
            float ss = 0.f;
#pragma unroll
            for (int e = 0; e < 8; ++e) ss += y[e] * y[e];
            ss += __shfl_xor(ss, 1); ss += __shfl_xor(ss, 2); ss += __shfl_xor(ss, 4); ss += __shfl_xor(ss, 8);
            const float rstd = __builtin_amdgcn_rsqf(ss * (1.f / 128.f) + EPS);
            float o[8];
#pragma unroll
            for (int e2 = 0; e2 < 4; ++e2) { const f32x4 c2 = csv[q][e2];
#pragma unroll
                for (int q2 = 0; q2 < 2; ++q2) { const int e = 2 * e2 + q2; const float v = y[e] * rstd * kg[e]; const float pr = __shfl_xor(v, 4);
                    const float c = c2[2 * q2], sn = c2[2 * q2 + 1]; o[e] = (j & 4) ? (v * c + pr * sn) : (v * c - pr * sn); } }
            u32x4 w; w.x = pk2(o[0], o[1]); w.y = pk2(o[2], o[3]); w.z = pk2(o[4], o[5]); w.w = pk2(o[6], o[7]);
            *(u32x4*)(KF + ((size_t)(b * 2 + h) * SKV + 16 + s) * 128 + 8 * j) = w; } }
    }
    for (int task = gidx; task < BATCH * 2 * 128; task += NG) {
        const int bh = task >> 7, pp = task & 127, h = bh & 1;
        u32x4 wk = (u32x4){0u, 0u, 0u, 0u}, wv = wk; int prow;
        if (pp < 16) { prow = pp;
            const float* mk = METAP + pp * 1536 + h * 128 + 8 * j; const float* mv = mk + 256;
            float y[8]; float ss = 0.f;
#pragma unroll
            for (int e = 0; e < 8; ++e) { y[e] = mk[e]; ss += y[e] * y[e]; }
            ss += __shfl_xor(ss, 1); ss += __shfl_xor(ss, 2); ss += __shfl_xor(ss, 4); ss += __shfl_xor(ss, 8);
            const float rstd = __builtin_amdgcn_rsqf(ss * (1.f / 128.f) + EPS);
#pragma unroll
            for (int e = 0; e < 8; ++e) y[e] = y[e] * rstd * kg[e];
            wk.x = pk2(y[0], y[1]); wk.y = pk2(y[2], y[3]); wk.z = pk2(y[4], y[5]); wk.w = pk2(y[6], y[7]);
            wv.x = pk2(mv[0], mv[1]); wv.y = pk2(mv[2], mv[3]); wv.z = pk2(mv[4], mv[5]); wv.w = pk2(mv[6], mv[7]);
        } else { prow = TT + (pp - 16); }
        *(u32x4*)(KF + ((size_t)bh * SKV + prow) * 128 + 8 * j) = wk;
        *(u32x4*)(VF + ((size_t)bh * SKV + prow) * 128 + 8 * j) = wv;
    }
}

__device__ __forceinline__ unsigned rt2_pk(unsigned H, float ha, float hb, unsigned G) { const f32x2 o = ((f32x2){bflo(H), bfhi(H)} + (f32x2){ha, hb}) * (f32x2){bflo(G), bfhi(G)}; return pk2(o.x, o.y); }
constexpr int R_XC = 0, R_AS = 17408, R_US = R_AS + 33792, R_SEG = R_US + 33792, R_ST = R_SEG + 4096, R_CW = R_ST + 1024, R_END = R_CW + 2560;
__device__ __forceinline__ bf16x8 rnn_ld_row(const bf16_t* XRb, const bf16_t* XRMn, int pidx, int coff) {
    bf16x8 z = {0, 0, 0, 0, 0, 0, 0, 0};
    if (pidx < 0 || pidx >= TT) return z;
    if (pidx < NMETA) return *(const bf16x8*)(XRMn + pidx * 1024 + coff);
    return *(const bf16x8*)(XRb + (size_t)(pidx - NMETA) * 1024 + coff);
}
__device__ __forceinline__ void rnn_item(const P& p, unsigned char* ldsg, int b, int n) {
    unsigned char* ws = p.ws;
    const int tid = threadIdx.x, lane = tid & 63, w = tid >> 6, fr = lane & 15, fq = lane >> 4;
    bf16_t* XC = (bf16_t*)(ldsg + R_XC); float* AS = (float*)(ldsg + R_AS); float* US = (float*)(ldsg + R_US);
    float* SEG = (float*)(ldsg + R_SEG); float* ST = (float*)(ldsg + R_ST); float* CW = (float*)(ldsg + R_CW);
    const bf16_t* XRb = (const bf16_t*)(ws + WS_XR) + (size_t)b * SEQ * 1024 + 128 * n;
    const bf16_t* XRMn = (const bf16_t*)(ws + WS_XRM) + 128 * n;
    bf16_t* HF = (bf16_t*)(ws + WS_HF) + (size_t)b * SEQ * 1024 + 128 * n;
    const bf16_t* GG = (const bf16_t*)(ws + WS_GG) + (size_t)b * SEQ * 1024 + 128 * n;
    bf16_t* RT = (bf16_t*)(ws + WS_RT) + (size_t)b * SEQ * 1024 + 128 * n;
    const bf16_t* WG = (const bf16_t*)(ws + WS_WG);
    const int tg0 = tid >> 4, coff0 = 8 * (tid & 15);
    float cwr[5][8];
#pragma unroll
    for (int q = 0; q < 4; ++q) { const f32x4 a = *(const f32x4*)(p.conv_w + q * 1024 + 128 * n + coff0), b2 = *(const f32x4*)(p.conv_w + q * 1024 + 128 * n + coff0 + 4);
        cwr[q][0] = a[0]; cwr[q][1] = a[1]; cwr[q][2] = a[2]; cwr[q][3] = a[3]; cwr[q][4] = b2[0]; cwr[q][5] = b2[1]; cwr[q][6] = b2[2]; cwr[q][7] = b2[3]; }
    { const f32x4 a = *(const f32x4*)(p.conv_b + 128 * n + coff0), b2 = *(const f32x4*)(p.conv_b + 128 * n + coff0 + 4);
      cwr[4][0] = a[0]; cwr[4][1] = a[1]; cwr[4][2] = a[2]; cwr[4][3] = a[3]; cwr[4][4] = b2[0]; cwr[4][5] = b2[1]; cwr[4][6] = b2[2]; cwr[4][7] = b2[3]; }
    for (int dir = 0; dir < 2; ++dir) {
        bf16x8 bfr[2][4];
#pragma unroll
        for (int gate = 0; gate < 2; ++gate)
#pragma unroll
            for (int ks = 0; ks < 4; ++ks) bfr[gate][ks] = *(const bf16x8*)(WG + ((size_t)((dir * 2 + gate) * 8 + n) * 128 + 16 * w + fr) * 128 + 32 * ks + 8 * fq);
        float ba4[4], bx4[4], ls4[4];
#pragma unroll
        for (int r = 0; r < 4; ++r) { const int cgl = dir * 1024 + 128 * n + 16 * w + 4 * fq + r; ba4[r] = -1.4426950408889634f * p.rg_ba[cgl]; bx4[r] = -1.4426950408889634f * p.rg_bx[cgl];
            const float lam = p.rg_lam[cgl]; const float y = __builtin_amdgcn_exp2f(-1.4426950408889634f * lam);
            float l1p; if (y < 0.05f) l1p = y * (1.f + y * (-0.5f + y * (1.f / 3 + y * (-0.25f + y * (0.2f + y * (-1.f / 6)))))); else l1p = __logf(1.f + y);
            ls4[r] = -8.f * 1.4426950408889634f * l1p; }
        if (tid < 128) ST[tid] = 0.f;
        __syncthreads();
        const int nch = dir == 0 ? 33 : 32;
        bf16x8 rows[5];
        { const int ci0 = dir == 0 ? 0 : 32; const int p00 = ci0 == 0 ? -48 : 16 + 64 * (ci0 - 1);
#pragma unroll
          for (int q = 0; q < 5; ++q) rows[q] = rnn_ld_row(XRb, XRMn, p00 + 2 * tg0 - 2 + q, coff0); }
        for (int c = 0; c < nch; ++c) {
            const int ci = dir == 0 ? c : 32 - c; const int p0 = ci == 0 ? -48 : 16 + 64 * (ci - 1);
            const int tq = tid;
            const int lane = tq & 63, w = tq >> 6, fr = lane & 15, fq = lane >> 4, tg = tq >> 4, coff = 8 * (tq & 15), ch = tq & 127, sg = tq >> 7, otok = tq >> 3, ocol = 16 * (tq & 7);
            { f32x2 xf[5][4];
#pragma unroll
              for (int q = 0; q < 5; ++q) { const u32x4 rw = __builtin_bit_cast(u32x4, rows[q]);
                  xf[q][0] = (f32x2){bflo(rw.x), bfhi(rw.x)}; xf[q][1] = (f32x2){bflo(rw.y), bfhi(rw.y)}; xf[q][2] = (f32x2){bflo(rw.z), bfhi(rw.z)}; xf[q][3] = (f32x2){bflo(rw.w), bfhi(rw.w)}; }
              unsigned w0v[4], w1v[4];
#pragma unroll
              for (int e2 = 0; e2 < 4; ++e2) { const f32x2 w0 = {cwr[0][2 * e2], cwr[0][2 * e2 + 1]}, w1 = {cwr[1][2 * e2], cwr[1][2 * e2 + 1]}, w2 = {cwr[2][2 * e2], cwr[2][2 * e2 + 1]}, w3 = {cwr[3][2 * e2], cwr[3][2 * e2 + 1]}, cb = {cwr[4][2 * e2], cwr[4][2 * e2 + 1]};
                  const f32x2 o0 = w3 * xf[3][e2] + (w2 * xf[2][e2] + (w1 * xf[1][e2] + (w0 * xf[0][e2] + cb)));
                  const f32x2 o1 = w3 * xf[4][e2] + (w2 * xf[3][e2] + (w1 * xf[2][e2] + (w0 * xf[1][e2] + cb)));
                  w0v[e2] = pk2(o0.x, o0.y); w1v[e2] = pk2(o1.x, o1.y); }
              u32x4 a0, a1; a0.x = w0v[0]; a0.y = w0v[1]; a0.z = w0v[2]; a0.w = w0v[3]; a1.x = w1v[0]; a1.y = w1v[1]; a1.z = w1v[2]; a1.w = w1v[3];
              *(u32x4*)(XC + (2 * tg) * 136 + coff) = a0; *(u32x4*)(XC + (2 * tg + 1) * 136 + coff) = a1; }
            if (c + 1 < nch) { const int cin = dir == 0 ? c + 1 : 32 - (c + 1); const int pn0 = cin == 0 ? -48 : 16 + 64 * (cin - 1);
                if (cin >= 2 && cin <= 31) {
                    const bf16_t* rp = XRb + (size_t)(pn0 - NMETA + 2 * tg - 2) * 1024 + coff;
#pragma unroll
                    for (int q = 0; q < 5; ++q) rows[q] = *(const bf16x8*)(rp + q * 1024);
                } else {
#pragma unroll
                    for (int q = 0; q < 5; ++q) rows[q] = rnn_ld_row(XRb, XRMn, pn0 + 2 * tg - 2 + q, coff); } }
            u32x4 hfp[2], ggp[2];
            if (dir == 1) { const size_t ro = (size_t)(p0 - NMETA + otok) * 1024 + ocol;
                hfp[0] = *(const u32x4*)(HF + ro); hfp[1] = *(const u32x4*)(HF + ro + 8); ggp[0] = *(const u32x4*)(GG + ro); ggp[1] = *(const u32x4*)(GG + ro + 8); }
            LBAR();
            f32x4 accA[4], accX[4];
#pragma unroll
            for (int tb = 0; tb < 4; ++tb) { accA[tb] = (f32x4){0.f, 0.f, 0.f, 0.f}; accX[tb] = accA[tb];
#pragma unroll
                for (int ks = 0; ks < 4; ++ks) { const bf16x8 yv = *(const bf16x8*)(XC + (16 * tb + fr) * 136 + 32 * ks + 8 * fq);
                    accA[tb] = __builtin_amdgcn_mfma_f32_16x16x32_bf16(bfr[0][ks], yv, accA[tb], 0, 0, 0);
                    accX[tb] = __builtin_amdgcn_mfma_f32_16x16x32_bf16(bfr[1][ks], yv, accX[tb], 0, 0, 0); } }
#pragma unroll
            for (int tb = 0; tb < 4; ++tb) { const int tok = 16 * tb + fr; const u32x2 xw = *(const u32x2*)(XC + tok * 136 + 16 * w + 4 * fq);
                f32x4 av, uv;
#pragma unroll
                for (int h2 = 0; h2 < 2; ++h2) { const unsigned xwh = h2 ? xw.y : xw.x; const f32x2 xc2 = {bflo(xwh), bfhi(xwh)};
                    const f32x2 pa = {accA[tb][2 * h2], accA[tb][2 * h2 + 1]}, px = {accX[tb][2 * h2], accX[tb][2 * h2 + 1]};
                    const f32x2 ta = pa * (f32x2){-1.4426950408889634f, -1.4426950408889634f} + (f32x2){ba4[2 * h2], ba4[2 * h2 + 1]};
                    const f32x2 tx = px * (f32x2){-1.4426950408889634f, -1.4426950408889634f} + (f32x2){bx4[2 * h2], bx4[2 * h2 + 1]};
                    const f32x2 da = (f32x2){__builtin_amdgcn_exp2f(ta.x), __builtin_amdgcn_exp2f(ta.y)} + (f32x2){1.f, 1.f};
                    const f32x2 di = (f32x2){__builtin_amdgcn_exp2f(tx.x), __builtin_amdgcn_exp2f(tx.y)} + (f32x2){1.f, 1.f};
                    const f32x2 rr = {__builtin_amdgcn_rcpf(da.x), __builtin_amdgcn_rcpf(da.y)}, ii = {__builtin_amdgcn_rcpf(di.x), __builtin_amdgcn_rcpf(di.y)};
                    const f32x2 la = rr * (f32x2){ls4[2 * h2], ls4[2 * h2 + 1]};
                    const f32x2 a2 = {__builtin_amdgcn_exp2f(la.x), __builtin_amdgcn_exp2f(la.y)};
                    const f32x2 om = (f32x2){1.f, 1.f} - a2 * a2;
                    const f32x2 sq = {__builtin_amdgcn_sqrtf(om.x), __builtin_amdgcn_sqrtf(om.y)};
                    const f32x2 u2 = sq * (ii * xc2);
                    av[2 * h2] = a2.x; av[2 * h2 + 1] = a2.y; uv[2 * h2] = u2.x; uv[2 * h2 + 1] = u2.y; }
                *(f32x4*)(AS + tok * 132 + 16 * w + 4 * fq) = av; *(f32x4*)(US + tok * 132 + 16 * w + 4 * fq) = uv; }
            if (ci == 0) {
#pragma unroll
                for (int tb = 0; tb < 3; ++tb) { const int tok = 16 * tb + fr; *(f32x4*)(AS + tok * 132 + 16 * w + 4 * fq) = (f32x4){1.f, 1.f, 1.f, 1.f}; *(f32x4*)(US + tok * 132 + 16 * w + 4 * fq) = (f32x4){0.f, 0.f, 0.f, 0.f}; } }
            LBAR();
            float hl[16], ac[16]; float hh = 0.f, aa = 1.f;
            const int tstep = dir == 0 ? 132 : -132; int sidx = (dir == 0 ? 16 * sg : 63 - 16 * sg) * 132 + ch;
#pragma unroll
            for (int i = 0; i < 16; ++i) { const float a = AS[sidx], u = US[sidx]; sidx += tstep; hh = a * hh + u; aa *= a; hl[i] = hh; ac[i] = aa; }
            SEG[sg * 128 + ch] = aa; SEG[512 + sg * 128 + ch] = hh;
            LBAR();
            float carry = ST[(c & 1) * 128 + ch];
#pragma unroll
            for (int s2 = 0; s2 < 3; ++s2) if (s2 < sg) carry = SEG[s2 * 128 + ch] * carry + SEG[512 + s2 * 128 + ch];
            if (sg == 3) ST[((c + 1) & 1) * 128 + ch] = aa * carry + hh;
            if (ci > 0) {
                int widx = (dir == 0 ? 16 * sg : 63 - 16 * sg) * 132 + ch;
#pragma unroll
                for (int i = 0; i < 16; i += 2) { const f32x2 hv = (f32x2){hl[i], hl[i + 1]} + (f32x2){ac[i], ac[i + 1]} * (f32x2){carry, carry};
                    AS[widx] = hv.x; AS[widx + tstep] = hv.y; widx += 2 * tstep; }
                LBAR();
                const size_t ro = (size_t)(p0 - NMETA + otok) * 1024 + ocol; const f32x4* hp = (const f32x4*)(AS + otok * 132 + ocol);
                const f32x4 h0 = hp[0], h1 = hp[1], h2 = hp[2], h3 = hp[3];
                if (dir == 0) {
                    u32x4 o0, o1; o0.x = pk2(h0[0], h0[1]); o0.y = pk2(h0[2], h0[3]); o0.z = pk2(h1[0], h1[1]); o0.w = pk2(h1[2], h1[3]);
                    o1.x = pk2(h2[0], h2[1]); o1.y = pk2(h2[2], h2[3]); o1.z = pk2(h3[0], h3[1]); o1.w = pk2(h3[2], h3[3]);
                    *(u32x4*)(HF + ro) = o0; *(u32x4*)(HF + ro + 8) = o1;
                } else {
#define RT2(H, HA, HB, G) rt2_pk(H, HA, HB, G)
                    u32x4 o0, o1; o0.x = RT2(hfp[0].x, h0[0], h0[1], ggp[0].x); o0.y = RT2(hfp[0].y, h0[2], h0[3], ggp[0].y); o0.z = RT2(hfp[0].z, h1[0], h1[1], ggp[0].z); o0.w = RT2(hfp[0].w, h1[2], h1[3], ggp[0].w);
                    o1.x = RT2(hfp[1].x, h2[0], h2[1], ggp[1].x); o1.y = RT2(hfp[1].y, h2[2], h2[3], ggp[1].y); o1.z = RT2(hfp[1].z, h3[0], h3[1], ggp[1].z); o1.w = RT2(hfp[1].w, h3[2], h3[3], ggp[1].w);
#undef RT2
                    *(u32x4*)(RT + ro) = o0; *(u32x4*)(RT + ro + 8) = o1;
                }
            }
        }
        __syncthreads();
    }
}

namespace att {
using bf16 = __hip_bfloat16;
constexpr int   D = 128, NW = 8, QBLK = 32, KVBLK = 64;
constexpr float SCALE = 0.088388347648318440f;
constexpr float THR = 8.f;
constexpr int SDEPTH = 2;
constexpr int NPADK = NPAD;
constexpr size_t SHM_V = KVBLK * D * 2, SHM_K = KVBLK * D * 2, SHM_ATTN = 2 * SHM_V + 2 * SHM_K + NW * 64 * 4;
using bf16x8 = __attribute__((ext_vector_type(8))) short;
using s16x4  = __attribute__((ext_vector_type(4))) short;
using f32x16 = __attribute__((ext_vector_type(16))) float;
using f32x8  = __attribute__((ext_vector_type(8))) float;
using u32x4  = __attribute__((ext_vector_type(4))) unsigned;
#define KSWZ(row, colB) ((row) * 256 + ((colB) ^ (((row) & 7) << 4)))
#define SBAR() __builtin_amdgcn_sched_barrier(0)
__device__ __forceinline__ int crow(int r, int hi) { return (r & 3) + 8 * (r >> 2) + 4 * hi; }
__device__ __forceinline__ unsigned cvtpk(float lo, float hi) {
  unsigned r; asm volatile("v_cvt_pk_bf16_f32 %0, %1, %2" : "=v"(r) : "v"(lo), "v"(hi)); return r;
}
template <typename TIn> struct Stage;
template <> struct Stage<bf16>  { using T = bf16x8;
  __device__ static __forceinline__ T ld8(const bf16* p) { return *reinterpret_cast<const bf16x8*>(p); }
  __device__ static __forceinline__ bf16x8 tobf(T x) { return x; } };
template <> struct Stage<float> { using T = f32x8;
  __device__ static __forceinline__ T ld8(const float* p) { return *reinterpret_cast<const f32x8*>(p); }
  __device__ static __forceinline__ bf16x8 tobf(T x) {
    u32x4 w = {cvtpk(x[0], x[1]), cvtpk(x[2], x[3]), cvtpk(x[4], x[5]), cvtpk(x[6], x[7])}; return *reinterpret_cast<bf16x8*>(&w); } };

__device__ __forceinline__ void partialSM(f32x16& p0, f32x16& p1, float& m_reg, float& mn, float& alpha) {
  constexpr float C = SCALE * 1.4426950408889634f;
  float pmax = p0[0]; for (int r = 1; r < 16; ++r) pmax = fmaxf(pmax, p0[r]); for (int r = 0; r < 16; ++r) pmax = fmaxf(pmax, p1[r]);
  { auto rr = __builtin_amdgcn_permlane32_swap(__float_as_uint(pmax), __float_as_uint(pmax), false, false);
    pmax = fmaxf(__uint_as_float(rr[0]), __uint_as_float(rr[1])); }
  if (__builtin_expect(__all(pmax - m_reg <= THR / SCALE), 1)) { mn = m_reg; alpha = 1.f; }
  else { mn = fmaxf(m_reg, pmax); alpha = __builtin_amdgcn_exp2f((m_reg - mn) * C); m_reg = mn; }
  float mnC = -mn * C;
  for (int r = 0; r < 16; ++r) p0[r] = fmaf(p0[r], C, mnC); for (int r = 0; r < 16; ++r) p1[r] = fmaf(p1[r], C, mnC);
  for (int r = 0; r < 16; ++r) p0[r] = __builtin_amdgcn_exp2f(p0[r]);
}
__device__ __forceinline__ void partialSM_fixed(f32x16& p0, f32x16& p1, float mnC) {
  constexpr float C = SCALE * 1.4426950408889634f;
  for (int r = 0; r < 16; ++r) p0[r] = fmaf(p0[r], C, mnC); for (int r = 0; r < 16; ++r) p1[r] = fmaf(p1[r], C, mnC);
  for (int r = 0; r < 16; ++r) p0[r] = __builtin_amdgcn_exp2f(p0[r]);
}
__device__ __forceinline__ void finishSM(f32x16& p0, f32x16& p1, float alpha, float& l_reg, bf16x8& pa0, bf16x8& pa1, bf16x8& pa2, bf16x8& pa3) {
  for (int r = 0; r < 16; ++r) p1[r] = __builtin_amdgcn_exp2f(p1[r]);
  float ps = 0; for (int r = 0; r < 16; ++r) ps += p0[r]; for (int r = 0; r < 16; ++r) ps += p1[r];
  { auto rr = __builtin_amdgcn_permlane32_swap(__float_as_uint(ps), __float_as_uint(ps), false, false);
    ps = __uint_as_float(rr[0]) + __uint_as_float(rr[1]); }
  l_reg = l_reg * alpha + ps;
#define PK4(P, BASE, OUT) do { unsigned a0 = cvtpk(P[BASE + 0], P[BASE + 1]), a1 = cvtpk(P[BASE + 2], P[BASE + 3]);   \
    unsigned b0 = cvtpk(P[BASE + 4], P[BASE + 5]), b1 = cvtpk(P[BASE + 6], P[BASE + 7]);                              \
    auto r0 = __builtin_amdgcn_permlane32_swap(a0, b0, false, false); auto r1 = __builtin_amdgcn_permlane32_swap(a1, b1, false, false); \
    u32x4 w = {r0[0], r1[0], r0[1], r1[1]}; OUT = *reinterpret_cast<bf16x8*>(&w); } while (0)
  PK4(p0, 0, pa0); PK4(p0, 8, pa1); PK4(p1, 0, pa2); PK4(p1, 8, pa3);
#undef PK4
}
__device__ __forceinline__ void qkt(f32x16& p0, f32x16& p1, const bf16* Ks, const bf16x8* qr, int r32, int hi) {
  p0 = f32x16{}; p1 = f32x16{};
  for (int d0 = 0; d0 < 8; ++d0) { int cb = (d0 * 16 + hi * 8) * 2;
    bf16x8 b0 = *reinterpret_cast<const bf16x8*>((const char*)Ks + KSWZ(r32, cb));
    bf16x8 b1 = *reinterpret_cast<const bf16x8*>((const char*)Ks + KSWZ(32 + r32, cb));
    p0 = __builtin_amdgcn_mfma_f32_32x32x16_bf16(b0, qr[d0], p0, 0, 0, 0);
    p1 = __builtin_amdgcn_mfma_f32_32x32x16_bf16(b1, qr[d0], p1, 0, 0, 0); }
}
__device__ __forceinline__ void qkt_ref(f32x16& p0, f32x16& p1, const bf16* Ks, const bf16x8* qr, int r32, int hi, const f32x16& cinit) {
  p0 = cinit; p1 = cinit;
  for (int d0 = 0; d0 < 8; ++d0) { int cb = (d0 * 16 + hi * 8) * 2;
    bf16x8 b0 = *reinterpret_cast<const bf16x8*>((const char*)Ks + KSWZ(r32, cb));
    bf16x8 b1 = *reinterpret_cast<const bf16x8*>((const char*)Ks + KSWZ(32 + r32, cb));
    p0 = __builtin_amdgcn_mfma_f32_32x32x16_bf16(b0, qr[d0], p0, 0, 0, 0);
    p1 = __builtin_amdgcn_mfma_f32_32x32x16_bf16(b1, qr[d0], p1, 0, 0, 0); }
}
__device__ __forceinline__ void partialSM_ref(f32x16& p0) { for (int r = 0; r < 16; ++r) p0[r] = __builtin_amdgcn_exp2f(p0[r]); }
typedef __bf16 bf16x2_t __attribute__((ext_vector_type(2)));
__device__ __forceinline__ float dot2_ones(unsigned w, float acc) { return __builtin_amdgcn_fdot2_f32_bf16(__builtin_bit_cast(bf16x2_t, w), __builtin_bit_cast(bf16x2_t, 0x3f803f80u), acc, false); }
__device__ __forceinline__ void finishSM_ref(f32x16& p0, f32x16& p1, float& lpart, bf16x8& pa0, bf16x8& pa1, bf16x8& pa2, bf16x8& pa3) {
  for (int r = 0; r < 16; ++r) p1[r] = __builtin_amdgcn_exp2f(p1[r]);
#define PK4D(P, BASE, OUT) do { unsigned a0 = cvtpk(P[BASE + 0], P[BASE + 1]), a1 = cvtpk(P[BASE + 2], P[BASE + 3]);   \
    unsigned b0 = cvtpk(P[BASE + 4], P[BASE + 5]), b1 = cvtpk(P[BASE + 6], P[BASE + 7]);                              \
    auto r0 = __builtin_amdgcn_permlane32_swap(a0, b0, false, false); auto r1 = __builtin_amdgcn_permlane32_swap(a1, b1, false, false); \
    u32x4 w = {r0[0], r1[0], r0[1], r1[1]}; OUT = *reinterpret_cast<bf16x8*>(&w);                                     \
      \
    lpart = dot2_ones(w.x, lpart); lpart = dot2_ones(w.y, lpart); lpart = dot2_ones(w.z, lpart); lpart = dot2_ones(w.w, lpart); } while (0)
  PK4D(p0, 0, pa0); PK4D(p0, 8, pa1); PK4D(p1, 0, pa2); PK4D(p1, 8, pa3);
#undef PK4D
}
__device__ __forceinline__ int v_st(int k, int c) { const int kk = (k & ~0xC) | ((k & 4) << 1) | ((k & 8) >> 1); return ((kk >> 3) * 4 + (c >> 5)) * 512 + ((kk & 7) * 32 + (c & 31)) * 2; }
__device__ __forceinline__ int v_rd_base(int lane) { return ((lane & 3) << 3) | (((lane >> 2) & 3) << 6) | (((lane >> 4) & 1) << 5) | (((lane >> 5) & 1) << 8); }
constexpr int v_rd_off(int d0, int ks, int half) { return d0 * 512 + ks * 4096 + half * 2048; }
template <int OFF> __device__ __forceinline__ s16x4 tr_read(int vb) {
  s16x4 r; asm volatile("ds_read_b64_tr_b16 %0, %1 offset:%2" : "=&v"(r) : "v"(vb), "i"(OFF) : "memory"); return r;
}
template <int D0> __device__ __forceinline__ void pv_one(f32x16& od, int vb, bf16x8 pa0, bf16x8 pa1, bf16x8 pa2, bf16x8 pa3) {
  const s16x4 l0 = tr_read<v_rd_off(D0, 0, 0)>(vb), h0 = tr_read<v_rd_off(D0, 0, 1)>(vb), l1 = tr_read<v_rd_off(D0, 1, 0)>(vb), h1 = tr_read<v_rd_off(D0, 1, 1)>(vb);
  const s16x4 l2 = tr_read<v_rd_off(D0, 2, 0)>(vb), h2 = tr_read<v_rd_off(D0, 2, 1)>(vb), l3 = tr_read<v_rd_off(D0, 3, 0)>(vb), h3 = tr_read<v_rd_off(D0, 3, 1)>(vb);
  asm volatile("s_waitcnt lgkmcnt(0)" ::: "memory"); SBAR();
#define PK(L, H) (bf16x8){L[0], L[1], L[2], L[3], H[0], H[1], H[2], H[3]}
  od = __builtin_amdgcn_mfma_f32_32x32x16_bf16(pa0, PK(l0, h0), od, 0, 0, 0);
  od = __builtin_amdgcn_mfma_f32_32x32x16_bf16(pa1, PK(l1, h1), od, 0, 0, 0);
  od = __builtin_amdgcn_mfma_f32_32x32x16_bf16(pa2, PK(l2, h2), od, 0, 0, 0);
  od = __builtin_amdgcn_mfma_f32_32x32x16_bf16(pa3, PK(l3, h3), od, 0, 0, 0);
#undef PK
}
template <int D0> __device__ __forceinline__ void pv_first(f32x16& od, int vb, bf16x8 pa0) {
  const s16x4 l0 = tr_read<v_rd_off(D0, 0, 0)>(vb), h0 = tr_read<v_rd_off(D0, 0, 1)>(vb);
  asm volatile("s_waitcnt lgkmcnt(0)" ::: "memory"); SBAR();
  od = __builtin_amdgcn_mfma_f32_32x32x16_bf16(pa0, (bf16x8){l0[0], l0[1], l0[2], l0[3], h0[0], h0[1], h0[2], h0[3]}, od, 0, 0, 0);
}
__device__ __forceinline__ void pv_d0_first(f32x16* o, int vb, bf16x8 pa0) { pv_first<0>(o[0], vb, pa0); pv_first<1>(o[1], vb, pa0); pv_first<2>(o[2], vb, pa0); pv_first<3>(o[3], vb, pa0); }
__device__ __forceinline__ void pv_d0(f32x16* o, int vb, bf16x8 pa0, bf16x8 pa1, bf16x8 pa2, bf16x8 pa3) {
  pv_one<0>(o[0], vb, pa0, pa1, pa2, pa3); pv_one<1>(o[1], vb, pa0, pa1, pa2, pa3); pv_one<2>(o[2], vb, pa0, pa1, pa2, pa3); pv_one<3>(o[3], vb, pa0, pa1, pa2, pa3);
}

constexpr int LDQ = 1024, LDK = 128;
constexpr int OS_OFF = (int)SHM_ATTN, OS_WAVE = 32 * 136 * 2;
template <bool FIXED>
__device__ __forceinline__ void attn_unit(const bf16* __restrict__ Qb, const bf16* __restrict__ Kh, const bf16* __restrict__ Vh,
                                          const unsigned short* __restrict__ GAb, const unsigned short* __restrict__ RTb, unsigned short* __restrict__ MIXb,
                                          const float* __restrict__ qg, const float* __restrict__ ROPE, int s_base, int seq, char* lds, float mfix) {
  using St = Stage<bf16>;
  int tid_o = threadIdx.x; asm volatile("" : "+v"(tid_o));
  const int tid = tid_o, wid = tid >> 6, lane = tid & 63, r32 = lane & 31, hi = lane >> 5;
  bf16* V_lds = (bf16*)lds; bf16* K_lds = (bf16*)(lds + 2 * SHM_V);
  float* ws = (float*)(lds + 2 * SHM_V + 2 * SHM_K) + wid * 64; float* li_l = ws; float* al_l = ws + 32;
  float m_reg = FIXED ? mfix : -1e30f, l_reg = 0; f32x16 o[4] = {}; bf16x8 qr[8];
  const float mfixC = -mfix * (SCALE * 1.4426950408889634f);
#define PSM(P0, P1, MN, AL) do { if constexpr (FIXED) { partialSM_ref(P0); AL = 1.f; MN = mfix; } else partialSM(P0, P1, m_reg, MN, AL); } while (0)
#define QKT(P0, P1, KS) qkt(P0, P1, KS, qr, r32, hi)
#define FSM(P0, P1, AL) do { if constexpr (FIXED) finishSM_ref(P0, P1, l_reg, pa0, pa1, pa2, pa3); else finishSM(P0, P1, AL, l_reg, pa0, pa1, pa2, pa3); } while (0)
  const int sr = tid >> 4, sc = (tid & 15) * 8, vst0 = v_st(sr, sc), vst1 = v_st(32 + sr, sc);
  const int vb0 = (int)(uintptr_t)V_lds + v_rd_base(lane);
  struct { typename St::T vs0, vs1, ks0, ks1; } sr_[SDEPTH];
#define SLOAD(i, k0) do { sr_[i].vs0 = St::ld8(&Vh[(long)((k0) + sr) * LDK + sc]); sr_[i].vs1 = St::ld8(&Vh[(long)((k0) + 32 + sr) * LDK + sc]); \
    sr_[i].ks0 = St::ld8(&Kh[(long)((k0) + sr) * LDK + sc]); sr_[i].ks1 = St::ld8(&Kh[(long)((k0) + 32 + sr) * LDK + sc]); } while (0)
#define SWRITE(b, i) do { *(bf16x8*)((char*)V_lds + (b) * SHM_V + vst0) = St::tobf(sr_[i].vs0);          \
    *(bf16x8*)((char*)V_lds + (b) * SHM_V + vst1) = St::tobf(sr_[i].vs1); int kc = sc * 2;               \
    *(bf16x8*)((char*)K_lds + (b) * SHM_K + KSWZ(sr, kc)) = St::tobf(sr_[i].ks0);                       \
    *(bf16x8*)((char*)K_lds + (b) * SHM_K + KSWZ(32 + sr, kc)) = St::tobf(sr_[i].ks1); } while (0)
#define SWAIT() do { if constexpr (SDEPTH == 2) asm volatile("s_waitcnt vmcnt(4)" ::: "memory"); else asm volatile("s_waitcnt vmcnt(0)" ::: "memory"); } while (0)
#define RESC(a) do { if (__any((a) < 1.f)) { if (hi == 0) al_l[r32] = (a); asm volatile("s_waitcnt lgkmcnt(0)" ::: "memory"); \
    for (int d = 0; d < 4; ++d) for (int r = 0; r < 16; ++r) o[d][r] *= al_l[crow(r, hi)]; } } while (0)
  f32x16 pA0, pA1, pB0, pB1; float mnA, mnB, alA, alB; bf16x8 pa0, pa1, pa2, pa3; const int NT = seq / KVBLK;
  constexpr int SE = 0, SO = SDEPTH - 1;
  SLOAD(SE, 0);
  {
    const bf16* Qw = Qb + (long)(wid * QBLK + r32) * LDQ + hi * 8;
    float xf[8][8]; float ss = 0.f;
#pragma unroll
    for (int d0 = 0; d0 < 8; ++d0) { const bf16x8 raw = *reinterpret_cast<const bf16x8*>(Qw + d0 * 16);
#pragma unroll
      for (int e = 0; e < 8; ++e) { xf[d0][e] = __uint_as_float((unsigned)(unsigned short)raw[e] << 16); ss += xf[d0][e] * xf[d0][e]; } }
    ss += __shfl_xor(ss, 32);
    const float rstd = __builtin_amdgcn_rsqf(ss * (1.f / 128.f) + 1e-6f) * (FIXED ? SCALE * 1.4426950408889634f : 1.f);
#pragma unroll
    for (int d0 = 0; d0 < 8; ++d0) { const float4 g0 = *reinterpret_cast<const float4*>(qg + d0 * 16 + hi * 8), g1 = *reinterpret_cast<const float4*>(qg + d0 * 16 + hi * 8 + 4);
      xf[d0][0] *= rstd * g0.x; xf[d0][1] *= rstd * g0.y; xf[d0][2] *= rstd * g0.z; xf[d0][3] *= rstd * g0.w;
      xf[d0][4] *= rstd * g1.x; xf[d0][5] *= rstd * g1.y; xf[d0][6] *= rstd * g1.z; xf[d0][7] *= rstd * g1.w; }
    const int s = s_base + wid * QBLK + r32;
#pragma unroll
    for (int ax = 0; ax < 2; ++ax) { const int pos = ax ? (s & 63) : (s >> 6);
#pragma unroll
      for (int dd = 0; dd < 2; ++dd) { const float4* cs = reinterpret_cast<const float4*>(ROPE + (pos * 32 + 16 * dd + 8 * hi) * 2); const int d1 = 4 * ax + dd, d2 = d1 + 2;
#pragma unroll
        for (int e2 = 0; e2 < 4; ++e2) { const float4 c4 = cs[e2];
          { const float x1 = xf[d1][2 * e2], x2 = xf[d2][2 * e2]; xf[d1][2 * e2] = x1 * c4.x - x2 * c4.y; xf[d2][2 * e2] = x2 * c4.x + x1 * c4.y; }
          { const float x1 = xf[d1][2 * e2 + 1], x2 = xf[d2][2 * e2 + 1]; xf[d1][2 * e2 + 1] = x1 * c4.z - x2 * c4.w; xf[d2][2 * e2 + 1] = x2 * c4.z + x1 * c4.w; } } } }
#pragma unroll
    for (int d0 = 0; d0 < 8; ++d0) { u32x4 w = {cvtpk(xf[d0][0], xf[d0][1]), cvtpk(xf[d0][2], xf[d0][3]), cvtpk(xf[d0][4], xf[d0][5]), cvtpk(xf[d0][6], xf[d0][7])}; qr[d0] = *reinterpret_cast<bf16x8*>(&w); }
  }
  asm volatile("s_waitcnt vmcnt(0)" ::: "memory"); SWRITE(0, SE); __syncthreads();
  QKT(pA0, pA1, K_lds); PSM(pA0, pA1, mnA, alA);
  SLOAD(SO, KVBLK); if constexpr (SDEPTH == 2) { if (2 < NT) SLOAD(SE, 2 * KVBLK); }
  SWAIT(); SWRITE(1, SO); __syncthreads();
  for (int j = 1; j + 1 < NT; j += 2) {
    SBAR(); QKT(pB0, pB1, (bf16*)((char*)K_lds + SHM_K));
    FSM(pA0, pA1, alA); SBAR();
    SLOAD(SO, (j + SDEPTH) * KVBLK); SBAR();
    pv_d0(o, vb0, pa0, pa1, pa2, pa3); PSM(pB0, pB1, mnB, alB);
    __syncthreads(); SWAIT(); SWRITE(0, SE);
    if constexpr (!FIXED) RESC(alB); __syncthreads();
    SBAR(); QKT(pA0, pA1, K_lds);
    FSM(pB0, pB1, alB); SBAR();
    if (SDEPTH == 1 || j + 3 < NT) SLOAD(SE, (j + 1 + SDEPTH) * KVBLK); SBAR();
    pv_d0(o, vb0 + (int)SHM_V, pa0, pa1, pa2, pa3); PSM(pA0, pA1, mnA, alA);
    __syncthreads(); SWAIT(); SWRITE(1, SO);
    if constexpr (!FIXED) RESC(alA); __syncthreads();
  }
  if (NT & 1) {
    if constexpr (FIXED) {
      static_assert(NPADK == 48, "tail mask written for 16 real keys in the last tile");
      for (int r = 8; r < 16; ++r) pA0[r] = 0.f; for (int r = 0; r < 16; ++r) pA1[r] = -1e30f; }
    SBAR(); FSM(pA0, pA1, alA); SBAR();
    if constexpr (FIXED) pv_d0_first(o, vb0, pa0); else pv_d0(o, vb0, pa0, pa1, pa2, pa3);
  } else {
  SBAR(); QKT(pB0, pB1, (bf16*)((char*)K_lds + SHM_K));
  FSM(pA0, pA1, alA); SBAR();
  pv_d0(o, vb0, pa0, pa1, pa2, pa3); PSM(pB0, pB1, mnB, alB);
  __syncthreads(); if constexpr (!FIXED) RESC(alB);
  FSM(pB0, pB1, alB); SBAR();
  pv_d0(o, vb0 + (int)SHM_V, pa0, pa1, pa2, pa3);
  }
  if constexpr (FIXED) { auto rr = __builtin_amdgcn_permlane32_swap(__float_as_uint(l_reg), __float_as_uint(l_reg), false, false); l_reg = __uint_as_float(rr[0]) + __uint_as_float(rr[1]); }
  if constexpr (!FIXED) { constexpr float C = SCALE * 1.4426950408889634f; l_reg -= (float)NPADK * __builtin_amdgcn_exp2f(-m_reg * C); }
  static_assert(!FIXED || true, "");
  int tid_e = tid; asm volatile("" : "+v"(tid_e)); const int lane_e = tid_e & 63, wid_e = tid_e >> 6;
  const int hi_e = lane_e >> 5, r32_e = lane_e & 31; float* li_e = (float*)(lds + 2 * SHM_V + 2 * SHM_K) + wid_e * 64;
  if (hi_e == 0) li_e[r32_e] = l_reg; asm volatile("s_waitcnt lgkmcnt(0)" ::: "memory");
  float rli[16];
#pragma unroll
  for (int r = 0; r < 16; ++r) rli[r] = __builtin_amdgcn_rcpf(li_e[crow(r, hi_e)]);
  unsigned short* osw = (unsigned short*)(lds + OS_OFF + wid_e * OS_WAVE);
#pragma unroll
  for (int r = 0; r < 16; ++r) { const int orow = crow(r, hi_e);
#pragma unroll
    for (int d0 = 0; d0 < 4; ++d0) { const float v = o[d0][r] * rli[r]; osw[orow * 136 + d0 * 32 + (lane_e & 31)] = (unsigned short)(cvtpk(v, v) & 0xffffu); } }
  asm volatile("s_waitcnt lgkmcnt(0)" ::: "memory");
#pragma unroll
  for (int k = 0; k < 8; ++k) { const int idx = k * 64 + lane_e, row = idx >> 4, chunk = idx & 15; const long go = (long)(wid_e * QBLK + row) * LDQ + chunk * 8;
    const u32x4 ov = *reinterpret_cast<const u32x4*>(osw + row * 136 + chunk * 8);
    const u32x4 ga = *reinterpret_cast<const u32x4*>(GAb + go), rt = *reinterpret_cast<const u32x4*>(RTb + go);
    u32x4 w;
#define MIX2(O, G, R) cvtpk(__uint_as_float((G) << 16) * __uint_as_float((O) << 16) + __uint_as_float((R) << 16), __uint_as_float((G) & 0xffff0000u) * __uint_as_float((O) & 0xffff0000u) + __uint_as_float((R) & 0xffff0000u))
    w.x = MIX2(ov.x, ga.x, rt.x); w.y = MIX2(ov.y, ga.y, rt.y); w.z = MIX2(ov.z, ga.z, rt.z); w.w = MIX2(ov.w, ga.w, rt.w);
#undef MIX2
    *reinterpret_cast<u32x4*>(MIXb + go) = w; }
  asm volatile("s_waitcnt lgkmcnt(0)" ::: "memory");
  __syncthreads();
#undef PSM
#undef QKT
#undef FSM
#undef SLOAD
#undef SWRITE
#undef SWAIT
#undef RESC
}
#undef KSWZ
#undef SBAR
}

#define RLX_AGENT __ATOMIC_RELAXED, __HIP_MEMORY_SCOPE_AGENT
#define XB_TMO      128
#define XB_XCNT(j)  (256  + 64 * (j))
#define XB_XSUB(j)  (1280 + 64 * (j))
#define XB_XGEN(j)  (2304 + 64 * (j))
#define XB_TOP      3328
#define XB_TOPGEN   3392
#define XCD_BAR_WORDS 3456
#define XB_SPIN_CAP (1u << 18)

__device__ __forceinline__ unsigned xb_ld(unsigned* p)              { return __hip_atomic_load(p, __ATOMIC_RELAXED, __HIP_MEMORY_SCOPE_AGENT); }
__device__ __forceinline__ unsigned xb_add(unsigned* p, unsigned v) { return __hip_atomic_fetch_add(p, v, __ATOMIC_RELAXED, __HIP_MEMORY_SCOPE_AGENT); }
__device__ __forceinline__ unsigned xb_xcc_id() { return (unsigned)__builtin_amdgcn_s_getreg((3 << 11) | 20) & 0xFu; }
#define XB_SPIN(cond, bar) do { unsigned _sp = 0; while (cond) { __builtin_amdgcn_s_sleep(1); \
    if ((++_sp & 255u) == 0u) { if (xb_ld(&(bar)[XB_TMO])) break; if (_sp > XB_SPIN_CAP) { atomicAdd(&(bar)[XB_TMO], 1u); break; } } } } while (0)

struct XcdBarrier {
    unsigned* bar; unsigned x;
    volatile LAS unsigned* st;
};

__device__ __forceinline__ XcdBarrier xcd_barrier_post(unsigned* bar, volatile LAS unsigned* st) {
    XcdBarrier b; b.bar = bar; b.x = xb_xcc_id(); b.st = st;
    if (threadIdx.x == 0) (void)xb_add(&bar[XB_XCNT(b.x)], 1u);
    return b;
}
__device__ __forceinline__ void xcd_barrier_complete(unsigned* bar, unsigned x, unsigned& nloc, unsigned& nx) {
    const unsigned G = gridDim.x * gridDim.y * gridDim.z;
    unsigned sum, cnt, mine, sp = 0u;
    for (;;) {
        sum = 0u; cnt = 0u; mine = 0u;
#pragma unroll
        for (unsigned j = 0; j < 16; ++j) { const unsigned c = xb_ld(&bar[XB_XCNT(j)]); sum += c; cnt += (c > 0u) ? 1u : 0u; mine = (j == x) ? c : mine; }
        if (sum == G) break;
        __builtin_amdgcn_s_sleep(1);
        if ((++sp & 255u) == 0u) { if (xb_ld(&bar[XB_TMO])) break; if (sp > XB_SPIN_CAP) { atomicAdd(&bar[XB_TMO], 1u); break; } }
    }
    nloc = mine > 0u ? mine : 1u; nx = cnt > 0u ? cnt : 1u;
}

__device__ __forceinline__ void xcd_barrier(const XcdBarrier& b) {
    asm volatile("s_waitcnt vmcnt(0)" ::: "memory");
    __syncthreads();
    if (threadIdx.x == 0) {
        unsigned* bar = b.bar;
        __builtin_amdgcn_s_waitcnt(0);
        unsigned nloc = b.st[0], nx = b.st[1];
        if (nloc == 0u) { xcd_barrier_complete(bar, b.x, nloc, nx); b.st[0] = nloc; b.st[1] = nx; }
        const unsigned old = xb_add(&bar[XB_XSUB(b.x)], 1u);
        const unsigned gen = old / nloc;
        if (old + 1u == (gen + 1u) * nloc) {
            __builtin_amdgcn_fence(__ATOMIC_RELEASE, "agent");
            asm volatile("s_waitcnt vmcnt(0)" ::: "memory");
            const unsigned og = xb_add(&bar[XB_TOP], 1u);
            const unsigned tg = og / nx;
            if (og + 1u == (tg + 1u) * nx) xb_add(&bar[XB_TOPGEN], 1u);
            else XB_SPIN(xb_ld(&bar[XB_TOPGEN]) == tg, bar);
            __builtin_amdgcn_fence(__ATOMIC_ACQUIRE, "agent");
            xb_add(&bar[XB_XGEN(b.x)], 1u);
            asm volatile("s_waitcnt vmcnt(0)" ::: "memory");
        } else {
            XB_SPIN(xb_ld(&bar[XB_XGEN(b.x)]) == gen, bar);
            __builtin_amdgcn_fence(__ATOMIC_ACQUIRE, "agent");
            asm volatile("s_waitcnt vmcnt(0)" ::: "memory");
        }
    }
    __syncthreads();
}

#ifndef MK_N_LAUNCHES
#define MK_N_LAUNCHES 1
#endif
constexpr int N_PHASES = 7;
#ifndef STAG4
#define STAG4 1000
#endif
#ifndef STAG6
#define STAG6 800
#endif
#define STAGGER(ticks) do { const unsigned long long t0_ = __builtin_amdgcn_s_memrealtime(); const unsigned long long dl_ = (unsigned long long)((bx >> 3) & 3) * (ticks); while (__builtin_amdgcn_s_memrealtime() - t0_ < dl_) __builtin_amdgcn_s_sleep(8); } while (0)
#ifndef PROBE_PHASE
#define PROBE_PHASE -1
#endif
#define REPS(k)
struct Args { const float* in[17]; float* out; unsigned char* ws; int ph_lo, ph_hi; };

template <class T> __device__ __forceinline__ T* as_global(T* v) { __attribute__((address_space(1))) T* g; asm volatile("" : "=s"(g) : "0"(v)); return (T*)g; }
__device__ __forceinline__ void load_P(P& p) {
    typedef __attribute__((address_space(4))) const unsigned char* kp_t; typedef __attribute__((address_space(4))) const float* const* kin_t;
    kp_t kp = (kp_t)__builtin_amdgcn_kernarg_segment_ptr(); asm volatile("" : "+s"(kp));
#define GPTR(T, v) (as_global<T>((T*)(v)))
    kin_t in = (kin_t)kp;
    p.x = GPTR(const float, in[0]); p.meta = GPTR(const float, in[1]); p.g1 = GPTR(const float, in[2]); p.w_in = GPTR(const float, in[3]); p.conv_w = GPTR(const float, in[4]); p.conv_b = GPTR(const float, in[5]);
    p.rg_wa = GPTR(const float, in[6]); p.rg_ba = GPTR(const float, in[7]); p.rg_wx = GPTR(const float, in[8]); p.rg_bx = GPTR(const float, in[9]); p.rg_lam = GPTR(const float, in[10]); p.qg = GPTR(const float, in[11]);
    p.kg = GPTR(const float, in[12]); p.w_out = GPTR(const float, in[13]); p.g2 = GPTR(const float, in[14]); p.w_fi = GPTR(const float, in[15]); p.w_fo = GPTR(const float, in[16]);
    p.out = GPTR(float, *(__attribute__((address_space(4))) float* const*)(kp + 136)); p.ws = GPTR(unsigned char, *(__attribute__((address_space(4))) unsigned char* const*)(kp + 144));
#undef GPTR
}
static_assert(sizeof(Args) == 160, "Args layout (17 input pointers, out, ws, two ints) is what load_P reads");
__global__ void __launch_bounds__(512, 2) fwd_mega(Args a) {
    extern __shared__ __attribute__((aligned(16))) unsigned char lds[];
    cg::grid_group grid = cg::this_grid();
    const int G = gridDim.x; const int bx = blockIdx.x; const int vcu = (G % 8 == 0) ? (bx % 8) * (G / 8) + bx / 8 : bx;
    unsigned char* ws = a.ws;
    const int lo = a.ph_lo, hi = a.ph_hi;
#ifndef PH_MASK
#define PH_MASK 127
#endif
#define IN(k) (((PH_MASK >> (k)) & 1) && lo <= (k) && (k) < hi)
#define SEAM(k) do { if (IN(k) && IN((k) + 1)) xcd_barrier(xbar); } while (0)
    PG8_LAS unsigned char* ldsl = (PG8_LAS unsigned char*)lds;
    volatile LAS unsigned* xst = (volatile LAS unsigned*)(ldsl + LDS_BYTES - 64);
    if (threadIdx.x == 0) { xst[0] = 0u; xst[1] = 0u; }
    __syncthreads();
    XcdBarrier xbar; xbar.bar = (unsigned*)ws + 4096; xbar.x = 0; xbar.st = nullptr;
    if (hi - lo > 1) {
        if (bx == 0) for (int i = threadIdx.x; i < XCD_BAR_WORDS; i += 512) __hip_atomic_store((unsigned*)ws + 4096 + i, 0u, __ATOMIC_RELAXED, __HIP_MEMORY_SCOPE_AGENT);
        grid.sync(); xbar = xcd_barrier_post((unsigned*)ws + 4096, xst); }

    if (IN(0)) { P p; load_P(p); p0_prologue(p, lds, vcu, G); }
    SEAM(0);
    if (IN(1)) REPS(1) {
        pg8::Gemm g{(const bf16_t*)(ws + WS_XN), (const bf16_t*)(ws + WS_WIN), M, NIN, 1024}; pg8::StaticOrder S; S.init(M, NIN, G, bx);
        Epi1 E{(bf16_t*)(ws + WS_Q), (bf16_t*)(ws + WS_KRAW), (bf16_t*)(ws + WS_VF), (bf16_t*)(ws + WS_XR), (bf16_t*)(ws + WS_GG), (bf16_t*)(ws + WS_GA)};
        pg8::gemm_phase<Epi1, pg8::StaticOrder, true, true>(ldsl, g, S, E);
    }
    SEAM(1);
    if (IN(2)) REPS(2) {
        P p; load_P(p);
        p2_kpass(p, vcu, G);
        __syncthreads();
        for (int it = bx; it < BATCH * 8; it += G) rnn_item(p, lds, it >> 3, it & 7);
    }
    SEAM(2);
    if (IN(3)) {
        P pq; load_P(pq);
        float gqa = 0.f, gka = 0.f;
        for (int i = 0; i < 128; ++i) { gqa = fmaxf(gqa, fabsf(pq.qg[i])); gka = fmaxf(gka, fabsf(pq.kg[i])); }
        const float mfix = __builtin_bit_cast(float, __builtin_amdgcn_readfirstlane(__builtin_bit_cast(int, 128.f * 1.02f * gqa * gka)));
        const bool fixed_ok = (mfix * 0.0883883476f <= 30.f) && (mfix > 0.f);
#define ATT_LOOP(FX) for (int i = 0;; ++i) { const int uid = i * G + vcu; if (uid >= BATCH * 2 * 32) break; \
            const int pr = uid >> 5, j = uid & 31, b = pr >> 1, kvh = pr & 1, h = kvh * 4 + (j >> 3), qb = j & 7; \
            const size_t qoff = ((size_t)b * SEQ + qb * 256) * 1024 + h * 128; const size_t koff = (size_t)(b * 2 + kvh) * SKV * 128; \
            att::attn_unit<FX>((const att::bf16*)(ws + WS_Q) + qoff, (const att::bf16*)(ws + WS_KF) + koff, (const att::bf16*)(ws + WS_VF) + koff, \
                           (const unsigned short*)(ws + WS_GA) + qoff, (const unsigned short*)(ws + WS_RT) + qoff, (unsigned short*)(ws + WS_Q) + qoff, \
                           pq.qg, (const float*)(ws + WS_ROPE), qb * 256, SKV_ATT, (char*)lds, mfix); }
        if (fixed_ok) { ATT_LOOP(true) } else { ATT_LOOP(false) }
#undef ATT_LOOP
    }
    SEAM(3);
    if (IN(4)) REPS(4) {
        pg8::Gemm g{(const bf16_t*)(ws + WS_Q), (const bf16_t*)(ws + WS_WOUT), M, 1024, 1024}; pg8::StaticOrder S; S.init(M, 1024, G, bx);
        P p; load_P(p);
        Epi2 E{p.x, p.out, (bf16_t*)(ws + WS_H1B), (float*)(ws + WS_SS)};
        pg8::gemm_phase<Epi2, pg8::StaticOrder, true, true>(ldsl, g, S, E);
    }
    SEAM(4);
    if (IN(5)) REPS(5) {
        pg8::Gemm g{(const bf16_t*)(ws + WS_H1B), (const bf16_t*)(ws + WS_WFI), M, 2 * DFF, 1024}; pg8::StaticOrder S; S.init(M, 2 * DFF, G, bx);
        Epi3 E{(const float*)(ws + WS_SS), (bf16_t*)(ws + WS_ACT), {}};
        pg8::gemm_phase<Epi3, pg8::StaticOrder, true, true>(ldsl, g, S, E);
    }
    SEAM(5);
    if (IN(6)) {
        pg8::Gemm g{(const bf16_t*)(ws + WS_ACT), (const bf16_t*)(ws + WS_WFO), M, 1024, DFF}; pg8::StaticOrder S; S.init(M, 1024, G, bx);
        P p; load_P(p);
        Epi4 E{(const bf16_t*)(ws + WS_H1B), p.out};
        pg8::gemm_phase<Epi4, pg8::StaticOrder, true, true>(ldsl, g, S, E);
    }
#undef IN
#undef SEAM
}

extern "C" void kernel_launch(void* const* d_in, const int* in_sizes, int n_in, void* d_out, int out_size, void* d_ws, size_t ws_size, hipStream_t stream) {
    static int grid = 0;
    if (grid == 0) {
        if (n_in != 17 || in_sizes[0] != M * DM || out_size != M * DM || ws_size < WS_END) {
            fprintf(stderr, "kernel_launch: shape mismatch n_in %d in0 %d out %d ws %zu (need %zu)\n", n_in, n_in > 0 ? in_sizes[0] : -1, out_size, ws_size, (size_t)WS_END); grid = -1; return; }
        int dev = 0, cus = 0, per_cu = 0;
        if (hipGetDevice(&dev) != hipSuccess || hipDeviceGetAttribute(&cus, hipDeviceAttributeMultiprocessorCount, dev) != hipSuccess) { grid = -1; return; }
        if (hipFuncSetAttribute((const void*)fwd_mega, hipFuncAttributeMaxDynamicSharedMemorySize, LDS_BYTES) != hipSuccess) { fprintf(stderr, "kernel_launch: hipFuncSetAttribute failed\n"); grid = -1; return; }
        if (hipOccupancyMaxActiveBlocksPerMultiprocessor(&per_cu, (const void*)fwd_mega, 512, LDS_BYTES) != hipSuccess || per_cu < 1) { fprintf(stderr, "kernel_launch: occupancy query says %d\n", per_cu); per_cu = 1; }
        (void)hipGetLastError();
        grid = cus * 1;
        fprintf(stderr, "kernel_launch: cus %d per_cu %d grid %d\n", cus, per_cu, grid);
    }
    if (grid < 0) return;
    Args a{};
    for (int i = 0; i < 17; ++i) a.in[i] = (const float*)d_in[i];
    a.out = (float*)d_out; a.ws = (unsigned char*)d_ws;
#if MK_N_LAUNCHES == 1
    a.ph_lo = 0; a.ph_hi = N_PHASES;
    void* args[] = {&a};
    hipError_t e = hipLaunchCooperativeKernel((const void*)fwd_mega, dim3(grid), dim3(512), args, LDS_BYTES, stream);
    if (e != hipSuccess) fprintf(stderr, "kernel_launch: cooperative launch failed: %s (grid %d)\n", hipGetErrorString(e), grid);
#else
    for (int ph = 0; ph < N_PHASES; ++ph) for (int rep = 0; rep < (ph == PROBE_PHASE ? 2 : 1); ++rep) { a.ph_lo = ph; a.ph_hi = ph + 1;
        hipLaunchKernelGGL(fwd_mega, dim3(grid), dim3(512), LDS_BYTES, stream, a);
        const hipError_t le = hipPeekAtLastError(); if (le != hipSuccess) { fprintf(stderr, "kernel_launch: launch %d failed: %s\n", ph, hipGetErrorName(le)); break; } }
#endif
}
```
